# Optimizing an MI355X kernel written in HIP

```python
import numpy as np
import jax, jax.numpy as jnp
from jax import lax

D_MODEL = 2048
BATCH = 2
SEQ = 4096
DEPTH = 4

N_MIXERS = 4
HEAD_DIM = 128
N_HEADS = D_MODEL // HEAD_DIM
ROT_DIM = HEAD_DIM // 4
ROPE_THETA = 500000.0
NORM_EPS = 1e-6
D_FF = 4 * D_MODEL
PLE_DIM = 256

MOBA_BLOCK = 256
MOBA_TOPK = 3
MOBA_QCHUNK = 32

POOL_WINDOWS = (2, 4, 8, 16)
POOL_GROUP = D_MODEL // len(POOL_WINDOWS)

NSA_KV_GROUPS = 4
NSA_Q_PER_KV = N_HEADS // NSA_KV_GROUPS
NSA_CMP_LEN = 32
NSA_CMP_STRIDE = 16
NSA_SLC_LEN = 64
NSA_SLC_TOPK = 16
NSA_WINDOW = 512
NSA_QCHUNK = 64
NSA_KV_WIDTH = NSA_KV_GROUPS * HEAD_DIM

CONV_WIDTH = 3

N_LAYERS_MOBA = (DEPTH + 3) // 4
N_LAYERS_POOL = (DEPTH + 2) // 4
N_LAYERS_NSA = (DEPTH + 1) // 4
N_LAYERS_CONV = DEPTH // 4

kernel_name = "hybrid_moba_pool_nsa_conv_trunk"


def rmsnorm(x, gain):
    xf = x.astype(jnp.float32)
    y = xf * lax.rsqrt(jnp.mean(xf * xf, axis=-1, keepdims=True) + NORM_EPS)
    return (y * gain.astype(jnp.float32)).astype(x.dtype)


def partial_rope(x, positions):
    half = ROT_DIM // 2
    freqs = jnp.float32(ROPE_THETA) ** (-jnp.arange(half, dtype=jnp.float32) * 2.0 / ROT_DIM)
    ang = positions.astype(jnp.float32)[..., None] * freqs
    cos = jnp.cos(ang)[:, :, None, :]
    sin = jnp.sin(ang)[:, :, None, :]
    xr = x[..., :ROT_DIM].astype(jnp.float32)
    x1, x2 = xr[..., :half], xr[..., half:]
    rot = jnp.concatenate([x1 * cos - x2 * sin, x2 * cos + x1 * sin], axis=-1).astype(x.dtype)
    return jnp.concatenate([rot, x[..., ROT_DIM:]], axis=-1)


def masked_softmax(logits, mask):
    s = jnp.where(mask, logits.astype(jnp.float32), -jnp.inf)
    m = jnp.max(s, axis=-1, keepdims=True)
    m = jnp.where(jnp.isfinite(m), m, 0.0)
    e = jnp.where(mask, jnp.exp(s - m), 0.0)
    return e / jnp.maximum(jnp.sum(e, axis=-1, keepdims=True), jnp.finfo(jnp.float32).tiny)


def moba_mixer(xn, positions, w_qkv, q_gain, k_gain, w_o):
    B, S, _ = xn.shape
    H, hd, L = N_HEADS, HEAD_DIM, MOBA_BLOCK
    qkv = (xn @ w_qkv).reshape(B, S, 3, H, hd)
    q = partial_rope(rmsnorm(qkv[:, :, 0], q_gain), positions)
    k = partial_rope(rmsnorm(qkv[:, :, 1], k_gain), positions)
    v = qkv[:, :, 2]
    q, k, v = (t.transpose(0, 2, 1, 3) for t in (q, k, v))
    nb = -(-S // L)
    pad = nb * L - S
    kp = jnp.pad(k, ((0, 0), (0, 0), (0, pad), (0, 0)))
    vp = jnp.pad(v, ((0, 0), (0, 0), (0, pad), (0, 0)))
    kb = kp.reshape(B, H, nb, L, hd)
    vb = vp.reshape(B, H, nb, L, hd)
    k_mean = jnp.mean(kb.astype(jnp.float32), axis=3).astype(k.dtype)
    n_sel = min(MOBA_TOPK, nb)
    scale = HEAD_DIM ** -0.5
    bi = jnp.arange(B)[:, None, None, None]
    hi = jnp.arange(H)[None, :, None, None]
    blk_ids = jnp.arange(nb)
    in_blk = jnp.arange(L)
    Qc = MOBA_QCHUNK

    def chunk(c):
        q0 = c * Qc
        t = q0 + jnp.arange(Qc)
        own = q0 // L
        qc = lax.dynamic_slice_in_dim(q, q0, Qc, axis=2)
        gate = jnp.einsum('bhqd,bhnd->bhqn', qc, k_mean).astype(jnp.float32)
        gate = jnp.where(blk_ids < own, gate, -jnp.inf)
        _, sel = lax.top_k(gate, n_sel)
        sel_ok = jnp.arange(n_sel) < own
        k_sel = kb[bi, hi, sel]
        v_sel = vb[bi, hi, sel]
        s_sel = jnp.einsum('bhqd,bhqnld->bhqnl', qc, k_sel).astype(jnp.float32) * scale
        k_own = lax.dynamic_slice_in_dim(kp, own * L, L, axis=2)
        v_own = lax.dynamic_slice_in_dim(vp, own * L, L, axis=2)
        s_own = jnp.einsum('bhqd,bhld->bhql', qc, k_own).astype(jnp.float32) * scale
        own_ok = (own * L + in_blk)[None, :] <= t[:, None]
        logits = jnp.concatenate([s_sel.reshape(B, H, Qc, n_sel * L), s_own], axis=-1)
        sel_mask = jnp.broadcast_to(jnp.repeat(sel_ok, L)[None, :], (Qc, n_sel * L))
        mask = jnp.concatenate([sel_mask, own_ok], axis=-1)
        probs = masked_softmax(logits, mask).astype(v.dtype)
        p_sel = probs[..., :n_sel * L].reshape(B, H, Qc, n_sel, L)
        p_own = probs[..., n_sel * L:]
        return (jnp.einsum('bhqnl,bhqnld->bhqd', p_sel, v_sel)
                + jnp.einsum('bhql,bhld->bhqd', p_own, v_own))

    o = lax.map(chunk, jnp.arange(S // Qc))
    o = o.transpose(1, 0, 3, 2, 4).reshape(B, S, H * hd)
    return o @ w_o


def pool_mixer(xn, w_groups, scale):
    B, S, D = xn.shape
    xf = xn.astype(jnp.float32)
    cs = jnp.concatenate([jnp.zeros((B, 1, D), jnp.float32), lax.cumsum(xf, axis=1)], axis=1)
    hi = jnp.arange(1, S + 1)
    outs = []
    for g, w in enumerate(POOL_WINDOWS):
        sl = slice(g * POOL_GROUP, (g + 1) * POOL_GROUP)
        lo = jnp.maximum(hi - w, 0)
        cnt = (hi - lo).astype(jnp.float32)[None, :, None]
        mean = (cs[:, hi, sl] - cs[:, lo, sl]) / cnt
        outs.append((mean - xf[:, :, sl]).astype(xn.dtype) @ w_groups[g])
    return jnp.concatenate(outs, axis=-1) * scale


def nsa_mixer(xn, positions, w_q, w_kv, q_gain, k_gain, cmp_pos, cmp_w1, cmp_w2, w_gate, w_o):
    B, S, _ = xn.shape
    G, R, hd, H = NSA_KV_GROUPS, NSA_Q_PER_KV, HEAD_DIM, N_HEADS
    scale = HEAD_DIM ** -0.5
    q = rmsnorm((xn @ w_q).reshape(B, S, H, hd), q_gain)
    q_cmp = q.reshape(B, S, G, R, hd)
    q_rot = partial_rope(q, positions).reshape(B, S, G, R, hd)
    kv = (xn @ w_kv).reshape(B, S, 6, G, hd)
    k_slc = partial_rope(rmsnorm(kv[:, :, 2], k_gain[1]), positions)
    v_slc = kv[:, :, 3]
    k_win = partial_rope(rmsnorm(kv[:, :, 4], k_gain[2]), positions)
    v_win = kv[:, :, 5]

    n_cmp = (S - NSA_CMP_LEN) // NSA_CMP_STRIDE + 1
    starts = np.arange(n_cmp) * NSA_CMP_STRIDE
    idx = starts[:, None] + np.arange(NSA_CMP_LEN)[None, :]

    def compress(t, pos, w1, w2):
        blk = t[:, idx] + pos[None, None, :, None, :]
        blk = blk.transpose(0, 1, 3, 2, 4).reshape(B, n_cmp, G, NSA_CMP_LEN * hd)
        return jax.nn.gelu(blk @ w1) @ w2

    k_cmp = rmsnorm(compress(kv[:, :, 0], cmp_pos[0], cmp_w1[0], cmp_w2[0]), k_gain[0])
    v_cmp = compress(kv[:, :, 1], cmp_pos[1], cmp_w1[1], cmp_w2[1])
    t_all = jnp.arange(S)
    cmp_ok = jnp.asarray(starts + NSA_CMP_LEN - 1)[None, :] <= t_all[:, None]
    s_cmp = jnp.einsum('bsgrd,bngd->bgrsn', q_cmp, k_cmp).astype(jnp.float32) * scale
    p_cmp = masked_softmax(s_cmp, cmp_ok)
    o_cmp = jnp.einsum('bgrsn,bngd->bsgrd', p_cmp.astype(v_cmp.dtype), v_cmp)

    n_slc = S // NSA_SLC_LEN
    slc_lo = np.arange(n_slc) * NSA_SLC_LEN
    overlap = ((starts[:, None] < (slc_lo + NSA_SLC_LEN)[None, :])
               & (slc_lo[None, :] < (starts + NSA_CMP_LEN)[:, None])).astype(np.float32)
    imp = jnp.einsum('bgrsn,nj->bgsj', p_cmp, jnp.asarray(overlap))
    cur = t_all // NSA_SLC_LEN
    jb = jnp.arange(n_slc)
    forced = (jb[None, :] == cur[:, None]) | (jb[None, :] == 0)
    imp = jnp.where(forced, jnp.inf, jnp.where(jb[None, :] <= cur[:, None], imp, -jnp.inf))
    n_top = min(NSA_SLC_TOPK, n_slc)
    top_val, top_idx = lax.top_k(imp, n_top)
    top_ok = top_val > -jnp.inf

    k_slc_b = k_slc.reshape(B, n_slc, NSA_SLC_LEN, G, hd).transpose(0, 3, 1, 2, 4)
    v_slc_b = v_slc.reshape(B, n_slc, NSA_SLC_LEN, G, hd).transpose(0, 3, 1, 2, 4)
    W = NSA_WINDOW
    k_win_p = jnp.pad(k_win, ((0, 0), (W, 0), (0, 0), (0, 0)))
    v_win_p = jnp.pad(v_win, ((0, 0), (W, 0), (0, 0), (0, 0)))
    bi = jnp.arange(B)[:, None, None, None]
    gi = jnp.arange(G)[None, :, None, None]
    in_slc = jnp.arange(NSA_SLC_LEN)
    Qc = NSA_QCHUNK
    win_off = jnp.arange(Qc + W)

    def chunk(c):
        q0 = c * Qc
        t = q0 + jnp.arange(Qc)
        qc = lax.dynamic_slice_in_dim(q_rot, q0, Qc, axis=1)
        idx_c = lax.dynamic_slice_in_dim(top_idx, q0, Qc, axis=2)
        ok_c = lax.dynamic_slice_in_dim(top_ok, q0, Qc, axis=2)
        k_sel = k_slc_b[bi, gi, idx_c]
        v_sel = v_slc_b[bi, gi, idx_c]
        s = jnp.einsum('bqgrd,bgqnld->bgrqnl', qc, k_sel).astype(jnp.float32) * scale
        kpos = idx_c[..., None] * NSA_SLC_LEN + in_slc
        m = ok_c[..., None] & (kpos <= t[None, None, :, None, None])
        p = masked_softmax(s.reshape(B, G, R, Qc, n_top * NSA_SLC_LEN),
                           m[:, :, None].reshape(B, G, 1, Qc, n_top * NSA_SLC_LEN))
        o_s = jnp.einsum('bgrqnl,bgqnld->bqgrd',
                         p.reshape(B, G, R, Qc, n_top, NSA_SLC_LEN).astype(v_sel.dtype), v_sel)
        kw = lax.dynamic_slice_in_dim(k_win_p, q0, Qc + W, axis=1)
        vw = lax.dynamic_slice_in_dim(v_win_p, q0, Qc + W, axis=1)
        kpos_w = q0 - W + win_off
        dist = t[:, None] - kpos_w[None, :]
        wm = (kpos_w[None, :] >= 0) & (dist >= 0) & (dist < W)
        sw = jnp.einsum('bqgrd,bkgd->bgrqk', qc, kw).astype(jnp.float32) * scale
        pw = masked_softmax(sw, wm)
        o_w = jnp.einsum('bgrqk,bkgd->bqgrd', pw.astype(vw.dtype), vw)
        return o_s, o_w

    o_slc, o_win = lax.map(chunk, jnp.arange(S // Qc))
    o_slc = o_slc.transpose(1, 0, 2, 3, 4, 5).reshape(B, S, H, hd)
    o_win = o_win.transpose(1, 0, 2, 3, 4, 5).reshape(B, S, H, hd)
    gates = jax.nn.sigmoid(xn @ w_gate).reshape(B, S, H, 3)
    o = (gates[..., 0:1] * o_cmp.reshape(B, S, H, hd)
         + gates[..., 1:2] * o_slc + gates[..., 2:3] * o_win)
    return o.reshape(B, S, H * hd) @ w_o


def conv_mixer(xn, w_in, conv_w, conv_b, w_o):
    D = xn.shape[-1]
    bch = xn @ w_in
    b_gate, c_gate, h = bch[..., :D], bch[..., D:2 * D], bch[..., 2 * D:]
    u = c_gate * h
    conv = lax.conv_general_dilated(u, conv_w[:, None, :], window_strides=(1,),
                                    padding=[(CONV_WIDTH - 1, 0)],
                                    dimension_numbers=('NWC', 'WIO', 'NWC'),
                                    feature_group_count=D) + conv_b
    return (b_gate * conv) @ w_o


def squared_relu_mlp(xn, w1, w2):
    return jnp.square(jax.nn.relu(xn @ w1)) @ w2


def setup_inputs(seed: int = 0) -> dict:
    key = jax.random.key(seed)
    ks = iter(jax.random.split(key, 48))

    def nrm(shape, scale):
        return jax.random.normal(next(ks), shape, jnp.float32) * scale

    def gain(shape):
        return 1.0 + 0.02 * jax.random.normal(next(ks), shape, jnp.float32)

    D, hd = D_MODEL, HEAD_DIM
    NA, NP, NN, NC = N_LAYERS_MOBA, N_LAYERS_POOL, N_LAYERS_NSA, N_LAYERS_CONV
    return {
        "x": nrm((BATCH, SEQ, D), 1.0),
        "p": nrm((DEPTH, BATCH, SEQ, PLE_DIM), 1.0),
        "positions": jnp.broadcast_to(jnp.arange(SEQ, dtype=jnp.int32), (BATCH, SEQ)),
        "mixer_norm": gain((DEPTH, D)),
        "mlp_norm": gain((DEPTH, D)),
        "mlp_w1": nrm((DEPTH, D, D_FF), D ** -0.5),
        "mlp_w2": nrm((DEPTH, D_FF, D), 0.5 * D_FF ** -0.5),
        "ple_norm": gain((DEPTH, D)),
        "ple_gate": nrm((DEPTH, D, D), D ** -0.5),
        "ple_proj": nrm((DEPTH, PLE_DIM, D), 0.5 * PLE_DIM ** -0.5),
        "moba_w_qkv": nrm((NA, D, 3 * D), D ** -0.5),
        "moba_q_gain": gain((NA, hd)),
        "moba_k_gain": gain((NA, hd)),
        "moba_w_o": nrm((NA, D, D), D ** -0.5),
        "pool_w": nrm((NP, len(POOL_WINDOWS), POOL_GROUP, POOL_GROUP), POOL_GROUP ** -0.5),
        "pool_scale": gain((NP, D)),
        "nsa_w_q": nrm((NN, D, D), D ** -0.5),
        "nsa_w_kv": nrm((NN, D, 6 * NSA_KV_WIDTH), D ** -0.5),
        "nsa_q_gain": gain((NN, hd)),
        "nsa_k_gain": gain((NN, 3, hd)),
        "nsa_cmp_pos": nrm((NN, 2, NSA_CMP_LEN, hd), 0.1),
        "nsa_cmp_w1": nrm((NN, 2, NSA_CMP_LEN * hd, hd), (NSA_CMP_LEN * hd) ** -0.5),
        "nsa_cmp_w2": nrm((NN, 2, hd, hd), hd ** -0.5),
        "nsa_w_gate": nrm((NN, D, 3 * N_HEADS), D ** -0.5),
        "nsa_w_o": nrm((NN, D, D), D ** -0.5),
        "conv_w_in": nrm((NC, D, 3 * D), D ** -0.5),
        "conv_w": nrm((NC, CONV_WIDTH, D), CONV_WIDTH ** -0.5),
        "conv_b": nrm((NC, D), 0.01),
        "conv_w_o": nrm((NC, D, D), D ** -0.5),
    }


def reference(x, p, positions, mixer_norm, mlp_norm, mlp_w1, mlp_w2, ple_norm, ple_gate, ple_proj,
              moba_w_qkv, moba_q_gain, moba_k_gain, moba_w_o, pool_w, pool_scale,
              nsa_w_q, nsa_w_kv, nsa_q_gain, nsa_k_gain, nsa_cmp_pos, nsa_cmp_w1, nsa_cmp_w2,
              nsa_w_gate, nsa_w_o, conv_w_in, conv_w, conv_b, conv_w_o):
    h = x
    for i in range(DEPTH):
        kind, j = i % N_MIXERS, i // N_MIXERS
        xn = rmsnorm(h, mixer_norm[i])
        if kind == 0:
            mix = moba_mixer(xn, positions, moba_w_qkv[j], moba_q_gain[j], moba_k_gain[j], moba_w_o[j])
        elif kind == 1:
            mix = pool_mixer(xn, pool_w[j], pool_scale[j])
        elif kind == 2:
            mix = nsa_mixer(xn, positions, nsa_w_q[j], nsa_w_kv[j], nsa_q_gain[j], nsa_k_gain[j],
                            nsa_cmp_pos[j], nsa_cmp_w1[j], nsa_cmp_w2[j], nsa_w_gate[j], nsa_w_o[j])
        else:
            mix = conv_mixer(xn, conv_w_in[j], conv_w[j], conv_b[j], conv_w_o[j])
        h = h + mix
        h = h + squared_relu_mlp(rmsnorm(h, mlp_norm[i]), mlp_w1[i], mlp_w2[i])
        gate = jax.nn.sigmoid(rmsnorm(h, ple_norm[i]) @ ple_gate[i])
        h = h + gate * (p[i] @ ple_proj[i])
    return h
```

```cpp
#include <hip/hip_runtime.h>
#include <hip/hip_cooperative_groups.h>
#include <cstdio>
#include <cstdint>
namespace cg = cooperative_groups;
namespace pg8 {
#define PG8_LAS __attribute__((address_space(3)))
typedef unsigned short bf16_t;
typedef short bf16x8 __attribute__((ext_vector_type(8)));
typedef float f32x4 __attribute__((ext_vector_type(4)));
typedef unsigned u32x4 __attribute__((ext_vector_type(4)));
typedef unsigned u32x2_ __attribute__((ext_vector_type(2)));
constexpr int BM = 256, BK = 64, HALF = 128, HTB = HALF * BK * 2  , STAGE_BYTES = 8 * HTB, NXCD = 8, WGM = 8;

__host__ __device__ __forceinline__ int lds_byte(int r, int c) { const int st = (r >> 4) * 2 + (c >> 5), rr = r & 15, cc = c & 31, ob = rr * 64 + cc * 2; return st * 1024 + (ob ^ (((ob >> 9) & 1) << 5)); }
__host__ __device__ __forceinline__ void stage_rc(int b, int& R, int& C) { const int st = b / 1024, sb = b % 1024, swz = sb ^ (((sb >> 9) & 1) << 5); R = (st >> 1) * 16 + swz / 64; C = (st & 1) * 32 + (swz % 64) / 2; }
__host__ __device__ __forceinline__ int perm32(int rho) { const int n = rho >> 4, i = rho & 15; return 8 * (i >> 2) + 4 * n + (i & 3); }

struct Unit { int pm, pn; };
struct Gemm { const bf16_t* A; const bf16_t* Bt; int M, N, K, lda, ldb; };

struct StaticOrder {
    int nM, nN, nwg, G, c;
    __host__ __device__ void init(int M, int N, int G_, int c_) { nM = M / BM; nN = N / BM; nwg = nM * nN; G = G_; c = c_; }
    __host__ __device__ bool next(int i, Unit& u) const {
        const long L = (long)i * G + c; if (L >= nwg) return false;
        int wgid = (int)L; { const int q = nwg / NXCD, r = nwg % NXCD, xcd = wgid % NXCD, off = wgid / NXCD; wgid = (xcd < r ? xcd * (q + 1) : r * (q + 1) + (xcd - r) * q) + off; }
        const int nig = WGM * nN, gid = wgid / nig, fm = gid * WGM, gsz = (nM - fm) < WGM ? (nM - fm) : WGM;
        u.pm = fm + ((wgid % nig) % gsz); u.pn = (wgid % nig) / gsz; return true;
    }
    __device__ __forceinline__ void a_ready(const Unit&) const {}
    __device__ __forceinline__ void done(const Unit&) const {}
};

__device__ __forceinline__ unsigned cvt_pk_bf16(float lo, float hi) { unsigned r; asm volatile("v_cvt_pk_bf16_f32 %0, %1, %2" : "=v"(r) : "v"(lo), "v"(hi)); return r; }
typedef float f32x2 __attribute__((ext_vector_type(2)));
__device__ __forceinline__ f32x2 gelu_pk(f32x2 v) {
    const f32x2 av = __builtin_elementwise_abs(v), d = av * 0.2316418882f + 1.0f;
    f32x2 t; t.x = __builtin_amdgcn_rcpf(d.x); t.y = __builtin_amdgcn_rcpf(d.y);
    f32x2 q = t * 0.5307027145f + (-0.7265760135f); q = q * t + 0.7107068705f; q = q * t + (-0.142248368f); q = q * t + 0.127414796f; q = q * t;
    const f32x2 s = (v * v) * (-0.72134752044f);
    f32x2 e; e.x = __builtin_amdgcn_exp2f(s.x); e.y = __builtin_amdgcn_exp2f(s.y);
    const f32x2 m = v * (q * e), r = v - m;
    f32x2 o; o.x = v.x < 0.f ? m.x : r.x; o.y = v.y < 0.f ? m.y : r.y; return o;
}

template <int ACT  > struct EpiBf16 {
    static constexpr bool PERM = true, AFTER_DRAIN = false; static_assert(ACT == 0 || ACT == 1, "EpiBf16: ACT is 0 (none) or 1 (gelu_pk)");
    bf16_t* O; int ldc; const float* bias; int split_cols; size_t split_stride; float scale0;
    __device__ __forceinline__ void operator()(const f32x4 (&acc)[2][2][4][2], const Unit& u, int wr, int wc, int fr, int fq) const {
        const int row0 = u.pm * BM + wr * 64 + fr; int colt = u.pn * BM; bf16_t* base = O;
        float sc = 1.f; if (split_cols) { const int t = colt / split_cols; base += (size_t)t * split_stride; colt -= t * split_cols; if (t == 0) sc = scale0; }
        const int col0 = colt + wc * 32 + 8 * fq, bcol0 = u.pn * BM + wc * 32 + 8 * fq;
        f32x4 bv[2][2];
#pragma unroll
        for (int bj = 0; bj < 2; ++bj)
#pragma unroll
            for (int n = 0; n < 2; ++n) bv[bj][n] = bias ? *(const f32x4*)(bias + bcol0 + bj * HALF + 4 * n) : (f32x4){0.f, 0.f, 0.f, 0.f};
#pragma unroll
        for (int ai = 0; ai < 2; ++ai)
#pragma unroll
            for (int m = 0; m < 4; ++m) { bf16_t* rowp = base + (size_t)(row0 + ai * HALF + m * 16) * ldc + col0;
#pragma unroll
                for (int bj = 0; bj < 2; ++bj) { f32x4 v0 = acc[ai][bj][m][0] + bv[bj][0], v1 = acc[ai][bj][m][1] + bv[bj][1];
                    if (ACT == 1) { f32x2 a = gelu_pk((f32x2){v0[0], v0[1]}), b = gelu_pk((f32x2){v0[2], v0[3]}), c = gelu_pk((f32x2){v1[0], v1[1]}), d = gelu_pk((f32x2){v1[2], v1[3]});
                        v0 = (f32x4){a.x, a.y, b.x, b.y}; v1 = (f32x4){c.x, c.y, d.x, d.y}; }
                    v0 = v0 * sc; v1 = v1 * sc; u32x4 w; w.x = cvt_pk_bf16(v0[0], v0[1]); w.y = cvt_pk_bf16(v0[2], v0[3]); w.z = cvt_pk_bf16(v1[0], v1[1]); w.w = cvt_pk_bf16(v1[2], v1[3]);
                    *(u32x4*)(rowp + bj * HALF) = w; } }
    }
};
template <class Epi, class Sched, bool ALIGN_EPI = false, bool SP2 = false>
__device__ __forceinline__ void gemm_phase(PG8_LAS unsigned char* lds, const Gemm g, const Sched& S, const Epi& E) {
    int tid_ = threadIdx.x; asm volatile("" : "+v"(tid_)); const int tid = tid_, wid = __builtin_amdgcn_readfirstlane(tid >> 6), lane = tid & 63, wr = wid >> 2, wc = wid & 3, fr = lane & 15, fq = lane >> 4;
    const int K = g.K, nt = K / BK;
    unsigned voffA[2], voffB[2];
#pragma unroll
    for (int i = 0; i < 2; ++i) { int R, C; stage_rc(tid * 16 + i * 8192, R, C); const int Rb = Epi::PERM ? ((R & ~31) + perm32(R & 31)) : R;
        voffA[i] = (unsigned)(R * g.lda + C) * 2u; voffB[i] = (unsigned)(Rb * g.ldb + C) * 2u; }
    const size_t kstep = (size_t)(BK * 2);
    const size_t hstepA = (size_t)HALF * g.lda * 2, hstepB = (size_t)HALF * g.ldb * 2;
    const size_t tstepA = 2 * hstepA, tstepB = 2 * hstepB;
    const unsigned ldsw = (unsigned)wid * 1024u;
    const int aoff = lds_byte(wr * 64 + fr, fq * 8), boff = lds_byte(wc * 32 + fr, fq * 8);
#define PG8_SA(b, h) (((b) * 2 + (h)) * HTB)
#define PG8_SB(b, h) ((4 + (b) * 2 + (h)) * HTB)
#define PG8_STAGE(bufoff, gbase, voff) do { _Pragma("unroll") for (int _i = 0; _i < 2; ++_i) \
        __builtin_amdgcn_global_load_lds((const unsigned*)((const char*)(gbase) + (voff)[_i]), (PG8_LAS unsigned*)(lds + (bufoff) + ldsw + _i * 8192), 16, 0, 0); } while (0)
#define PG8_LDA(dst, b, h) do { _Pragma("unroll") for (int m = 0; m < 4; ++m) _Pragma("unroll") for (int k = 0; k < 2; ++k) dst[m][k] = *(const PG8_LAS bf16x8*)(lds + PG8_SA(b, h) + aoff + m * 2048 + k * 1024); } while (0)
#define PG8_LDB(dst, b, h) do { _Pragma("unroll") for (int n = 0; n < 2; ++n) _Pragma("unroll") for (int k = 0; k < 2; ++k) dst[n][k] = *(const PG8_LAS bf16x8*)(lds + PG8_SB(b, h) + boff + n * 2048 + k * 1024); } while (0)
#define PG8_MMA(ai, bj, At, Bt) do { __builtin_amdgcn_s_setprio(1); _Pragma("unroll") for (int m = 0; m < 4; ++m) _Pragma("unroll") for (int n = 0; n < 2; ++n) _Pragma("unroll") for (int k = 0; k < 2; ++k) \
        acc[ai][bj][m][n] = __builtin_amdgcn_mfma_f32_16x16x32_bf16(Bt[n][k], At[m][k], acc[ai][bj][m][n], 0, 0, 0); __builtin_amdgcn_s_setprio(0); } while (0)
#define PG8_WAIT_V(n) asm volatile("s_waitcnt vmcnt(" #n ")" ::: "memory")
#define PG8_WAIT_L(n) asm volatile("s_waitcnt lgkmcnt(" #n ")" ::: "memory")
#define PG8_BAR __builtin_amdgcn_s_barrier()
#define PG8_SCHED __builtin_amdgcn_sched_barrier(0)
    Unit cur, nxt; int ui = 0;
    if (!S.next(0, cur)) return;
    f32x4 acc[2][2][4][2];
#pragma unroll
    for (int a = 0; a < 2; ++a)
#pragma unroll
        for (int b = 0; b < 2; ++b)
#pragma unroll
            for (int m = 0; m < 4; ++m)
#pragma unroll
                for (int n = 0; n < 2; ++n) acc[a][b][m][n] = (f32x4){0.f, 0.f, 0.f, 0.f};
    bf16x8 At[4][2], B0[2][2], B1[2][2];
    const char* cA = (const char*)g.A + (size_t)cur.pm * tstepA; const char* cB = (const char*)g.Bt + (size_t)cur.pn * tstepB;
    S.a_ready(cur);
    if constexpr (SP2) {
        PG8_STAGE(PG8_SB(0, 0), cB, voffB); PG8_STAGE(PG8_SB(0, 1), cB + hstepB, voffB); PG8_STAGE(PG8_SA(0, 0), cA, voffA); PG8_STAGE(PG8_SA(0, 1), cA + hstepA, voffA);
        if (wr == 1) PG8_BAR;
        PG8_WAIT_V(2); PG8_BAR;
        PG8_STAGE(PG8_SB(1, 0), cB + kstep, voffB); PG8_STAGE(PG8_SA(1, 0), cA + kstep, voffA); PG8_STAGE(PG8_SB(1, 1), cB + hstepB + kstep, voffB);
        PG8_WAIT_V(6); PG8_BAR;
    } else {
        PG8_STAGE(PG8_SB(0, 0), cB, voffB); PG8_STAGE(PG8_SA(0, 0), cA, voffA); PG8_STAGE(PG8_SB(0, 1), cB + hstepB, voffB); PG8_STAGE(PG8_SA(0, 1), cA + hstepA, voffA);
        if (wr == 1) PG8_BAR;
        PG8_WAIT_V(4); PG8_BAR;
        PG8_STAGE(PG8_SB(1, 0), cB + kstep, voffB); PG8_STAGE(PG8_SA(1, 0), cA + kstep, voffA); PG8_STAGE(PG8_SB(1, 1), cB + hstepB + kstep, voffB);
        PG8_WAIT_V(6); PG8_BAR;
    }
    for (;;) {
        const bool has_next = S.next(ui + 1, nxt);
        E.pre(lds + STAGE_BYTES, cur, wr, fr, wid);
        const char* nA = has_next ? (const char*)g.A + (size_t)nxt.pm * tstepA : cA; const char* nB = has_next ? (const char*)g.Bt + (size_t)nxt.pn * tstepB : cB;
        for (int t = 0; t < nt; t += 2) {
            const bool last = (t == nt - 2);
            const char* a1 = cA + (size_t)(t + 1) * kstep;
            const char* a2 = last ? nA : cA + (size_t)(t + 2) * kstep; const char* b2 = last ? nB : cB + (size_t)(t + 2) * kstep;
            const char* a3 = a2 + kstep; const char* b3 = b2 + kstep;
            if (last && has_next) S.a_ready(nxt);
            if constexpr (SP2) {
            PG8_LDB(B0, 0, 0); PG8_LDB(B1, 0, 1); PG8_SCHED; PG8_LDA(At, 0, 0); PG8_STAGE(PG8_SA(1, 1), a1 + hstepA, voffA);
            PG8_WAIT_V(8); PG8_WAIT_L(0); PG8_BAR; PG8_MMA(0, 0, At, B0); PG8_MMA(0, 1, At, B1); PG8_BAR; PG8_SCHED;
            PG8_LDA(At, 0, 1); PG8_STAGE(PG8_SB(0, 0), b2, voffB); PG8_STAGE(PG8_SB(0, 1), b2 + hstepB, voffB); PG8_STAGE(PG8_SA(0, 0), a2, voffA);
            PG8_WAIT_V(8); PG8_WAIT_L(0); PG8_BAR; PG8_MMA(1, 0, At, B0); PG8_MMA(1, 1, At, B1); PG8_BAR; PG8_SCHED;
            PG8_LDB(B0, 1, 0); PG8_LDB(B1, 1, 1); PG8_SCHED; PG8_LDA(At, 1, 0); PG8_STAGE(PG8_SA(0, 1), a2 + hstepA, voffA);
            PG8_WAIT_V(8); PG8_WAIT_L(0); PG8_BAR; PG8_MMA(0, 0, At, B0); PG8_MMA(0, 1, At, B1); PG8_BAR; PG8_SCHED;
            PG8_LDA(At, 1, 1); PG8_STAGE(PG8_SB(1, 0), b3, voffB); PG8_STAGE(PG8_SB(1, 1), b3 + hstepB, voffB); PG8_STAGE(PG8_SA(1, 0), a3, voffA);
            PG8_WAIT_V(8); PG8_WAIT_L(0); PG8_BAR; PG8_MMA(1, 0, At, B0); PG8_MMA(1, 1, At, B1); PG8_BAR; PG8_SCHED;
            } else {
            PG8_LDB(B0, 0, 0); PG8_SCHED; PG8_LDA(At, 0, 0); PG8_STAGE(PG8_SA(1, 1), a1 + hstepA, voffA);
            PG8_WAIT_L(8); PG8_BAR; PG8_WAIT_L(0); PG8_MMA(0, 0, At, B0); PG8_BAR; PG8_SCHED;
            PG8_LDB(B1, 0, 1); PG8_STAGE(PG8_SB(0, 0), b2, voffB);
            PG8_BAR; PG8_WAIT_L(0); PG8_MMA(0, 1, At, B1); PG8_BAR;
            PG8_LDA(At, 0, 1); PG8_STAGE(PG8_SA(0, 0), a2, voffA);
            PG8_BAR; PG8_WAIT_L(0); PG8_MMA(1, 0, At, B0); PG8_BAR; PG8_SCHED;
            PG8_STAGE(PG8_SB(0, 1), b2 + hstepB, voffB);
            PG8_WAIT_V(6); PG8_BAR; PG8_MMA(1, 1, At, B1); PG8_BAR;
            PG8_LDB(B0, 1, 0); PG8_SCHED; PG8_LDA(At, 1, 0); PG8_STAGE(PG8_SA(0, 1), a2 + hstepA, voffA);
            PG8_WAIT_L(8); PG8_BAR; PG8_WAIT_L(0); PG8_MMA(0, 0, At, B0); PG8_BAR; PG8_SCHED;
            PG8_LDB(B1, 1, 1); PG8_STAGE(PG8_SB(1, 0), b3, voffB);
            PG8_BAR; PG8_WAIT_L(0); PG8_MMA(0, 1, At, B1); PG8_BAR;
            PG8_LDA(At, 1, 1); PG8_STAGE(PG8_SA(1, 0), a3, voffA);
            PG8_BAR; PG8_WAIT_L(0); PG8_MMA(1, 0, At, B0); PG8_BAR; PG8_SCHED;
            PG8_STAGE(PG8_SB(1, 1), b3 + hstepB, voffB);
            PG8_WAIT_V(6); PG8_BAR; PG8_MMA(1, 1, At, B1); PG8_BAR;
            }
        }
        if constexpr (ALIGN_EPI) { if (wr == 0) PG8_BAR; }
        if constexpr (!Epi::AFTER_DRAIN) { E(acc, cur, wr, wc, fr, fq, lds + STAGE_BYTES, wid, lane); S.done(cur); }
        if (!has_next) break;
#pragma unroll
        for (int a = 0; a < 2; ++a)
#pragma unroll
            for (int b = 0; b < 2; ++b)
#pragma unroll
                for (int m = 0; m < 4; ++m)
#pragma unroll
                    for (int n = 0; n < 2; ++n) acc[a][b][m][n] = (f32x4){0.f, 0.f, 0.f, 0.f};
        cur = nxt; cA = nA; cB = nB; ++ui;
        if constexpr (ALIGN_EPI) { if (wr == 1) PG8_BAR; }
    }
    PG8_WAIT_V(0);
    if constexpr (!ALIGN_EPI) { if (wr == 0) PG8_BAR; }
    PG8_BAR;
    if constexpr (Epi::AFTER_DRAIN) { E.fused(acc, cur, wr, wc, fr, fq, lds, wid, lane); S.done(cur); }
#undef PG8_SA
#undef PG8_SB
#undef PG8_STAGE
#undef PG8_LDA
#undef PG8_LDB
#undef PG8_MMA
#undef PG8_WAIT_V
#undef PG8_WAIT_L
#undef PG8_BAR
#undef PG8_SCHED
}
}
namespace pg8 {
constexpr float NORM_EPS_ = 1e-6f;
__device__ __forceinline__ void stat_dma(PG8_LAS unsigned char* spare, const unsigned* ss, const Unit& u, int wr, int fr, int wid) {
#pragma unroll
    for (int k = 0; k < 8; ++k)
        __builtin_amdgcn_global_load_lds(ss + (u.pm * BM + wr * 64 + fr + (k >> 2) * HALF + (k & 3) * 16), (PG8_LAS unsigned*)(spare + wid * 2048 + k * 256), 4, 0, 0);
}
__device__ __forceinline__ float stat_rstd(PG8_LAS unsigned char* spare, int wid, int lane, int k) {
    const unsigned v = *(const PG8_LAS unsigned*)(spare + wid * 2048 + k * 256 + lane * 4);
    return 1.0f / sqrtf((float)v * (1.f / (1024.f * 2048.f)) + NORM_EPS_);
}
template <int ACT  > struct EpiB {
    static constexpr bool PERM = true, AFTER_DRAIN = false;
    bf16_t* O; int ldc; const unsigned* ss;
    __device__ __forceinline__ void pre(PG8_LAS unsigned char* spare, const Unit& u, int wr, int fr, int wid) const { if (ss) stat_dma(spare, ss, u, wr, fr, wid); }
    __device__ __forceinline__ void operator()(const f32x4 (&acc)[2][2][4][2], const Unit& u, int wr, int wc, int fr, int fq, PG8_LAS unsigned char* spare, int wid, int lane) const {
        const int row0 = u.pm * BM + wr * 64 + fr, col0 = u.pn * BM + wc * 32 + 8 * fq;
#pragma unroll
        for (int ai = 0; ai < 2; ++ai)
#pragma unroll
            for (int m = 0; m < 4; ++m) { const int row = row0 + ai * HALF + m * 16; bf16_t* rowp = O + (size_t)row * ldc + col0;
                const float rs = ss ? stat_rstd(spare, wid, lane, ai * 4 + m) : 1.f;
#pragma unroll
                for (int bj = 0; bj < 2; ++bj) { f32x4 v0 = acc[ai][bj][m][0] * rs, v1 = acc[ai][bj][m][1] * rs;
                    if (ACT == 2) {
#pragma unroll
                        for (int e = 0; e < 4; ++e) { float a = v0[e] > 0.f ? v0[e] : 0.f; v0[e] = a * a; float b = v1[e] > 0.f ? v1[e] : 0.f; v1[e] = b * b; } }
                    u32x4 w; w.x = cvt_pk_bf16(v0[0], v0[1]); w.y = cvt_pk_bf16(v0[2], v0[3]); w.z = cvt_pk_bf16(v1[0], v1[1]); w.w = cvt_pk_bf16(v1[2], v1[3]);
                    *(u32x4*)(rowp + bj * HALF) = w; } }
    }
};
template <int MODE> struct EpiH {
    static constexpr bool PERM = true, AFTER_DRAIN = false;
    const float* base_f; const bf16_t* hb_in; float* out; const float* cscale; int col_off; const bf16_t* pp; const unsigned* ss_in; bf16_t* hb; unsigned* ss_out;
    __device__ __forceinline__ void pre(PG8_LAS unsigned char* spare, const Unit& u, int wr, int fr, int wid) const { if (ss_in) stat_dma(spare, ss_in, u, wr, fr, wid); }
    __device__ __forceinline__ void operator()(const f32x4 (&acc)[2][2][4][2], const Unit& u, int wr, int wc, int fr, int fq, PG8_LAS unsigned char* spare, int wid, int lane) const {
        const int row0 = u.pm * BM + wr * 64 + fr, col0 = col_off + u.pn * BM + wc * 32 + 8 * fq;
        unsigned sqv[8];
#pragma unroll
        for (int ai = 0; ai < 2; ++ai)
#pragma unroll
            for (int mp = 0; mp < 2; ++mp) {
                f32x4 bv[2][2][2]; u32x4 pw[2][2]; float rs[2] = {1.f, 1.f};
#pragma unroll
                for (int mm = 0; mm < 2; ++mm) { const int row = row0 + ai * HALF + (2 * mp + mm) * 16; const size_t ro = (size_t)row * 2048;
                    if (ss_in) { const float r_ = stat_rstd(spare, wid, lane, ai * 4 + 2 * mp + mm); rs[mm] = (MODE == 0) ? r_ * r_ : r_; }
#pragma unroll
                    for (int bj = 0; bj < 2; ++bj) { const int c = col0 + bj * HALF;
                        if (base_f) { bv[mm][bj][0] = *(const f32x4*)(base_f + ro + c); bv[mm][bj][1] = *(const f32x4*)(base_f + ro + c + 4); }
                        else { const u32x4 w = *(const u32x4*)(hb_in + ro + c);
                            bv[mm][bj][0] = (f32x4){__uint_as_float(w.x << 16), __uint_as_float(w.x & 0xffff0000u), __uint_as_float(w.y << 16), __uint_as_float(w.y & 0xffff0000u)};
                            bv[mm][bj][1] = (f32x4){__uint_as_float(w.z << 16), __uint_as_float(w.z & 0xffff0000u), __uint_as_float(w.w << 16), __uint_as_float(w.w & 0xffff0000u)}; }
                        pw[mm][bj] = (MODE == 1) ? *(const u32x4*)(pp + ro + c) : (u32x4){0u, 0u, 0u, 0u}; } }
#pragma unroll
                for (int mm = 0; mm < 2; ++mm) { const int m = 2 * mp + mm; const int row = row0 + ai * HALF + m * 16; const size_t ro = (size_t)row * 2048;
                    float sq = 0.f;
#pragma unroll
                    for (int bj = 0; bj < 2; ++bj) { const int c = col0 + bj * HALF; f32x4 v0 = acc[ai][bj][m][0], v1 = acc[ai][bj][m][1];
                        if (MODE == 0) { if (cscale) { v0 = v0 * *(const f32x4*)(cscale + c); v1 = v1 * *(const f32x4*)(cscale + c + 4); } v0 = v0 * rs[mm]; v1 = v1 * rs[mm]; }
                        else { const u32x4 w = pw[mm][bj];
                            const f32x4 p0 = {__uint_as_float(w.x << 16), __uint_as_float(w.x & 0xffff0000u), __uint_as_float(w.y << 16), __uint_as_float(w.y & 0xffff0000u)};
                            const f32x4 p1 = {__uint_as_float(w.z << 16), __uint_as_float(w.z & 0xffff0000u), __uint_as_float(w.w << 16), __uint_as_float(w.w & 0xffff0000u)};
#pragma unroll
                            for (int e = 0; e < 4; ++e) { v0[e] = p0[e] / (1.f + __expf(-v0[e] * rs[mm])); v1[e] = p1[e] / (1.f + __expf(-v1[e] * rs[mm])); } }
                        const f32x4 h0 = bv[mm][bj][0] + v0, h1 = bv[mm][bj][1] + v1;
                        if (out) { *(f32x4*)(out + ro + c) = h0; *(f32x4*)(out + ro + c + 4) = h1; }
                        if (hb) { u32x4 w2; w2.x = cvt_pk_bf16(h0[0], h0[1]); w2.y = cvt_pk_bf16(h0[2], h0[3]); w2.z = cvt_pk_bf16(h1[0], h1[1]); w2.w = cvt_pk_bf16(h1[2], h1[3]); *(u32x4*)(hb + ro + c) = w2;
                            const float r0 = __uint_as_float(w2.x << 16), r1 = __uint_as_float(w2.x & 0xffff0000u), r2 = __uint_as_float(w2.y << 16), r3 = __uint_as_float(w2.y & 0xffff0000u);
                            const float r4 = __uint_as_float(w2.z << 16), r5 = __uint_as_float(w2.z & 0xffff0000u), r6 = __uint_as_float(w2.w << 16), r7 = __uint_as_float(w2.w & 0xffff0000u);
                            sq += ((r0 * r0 + r1 * r1) + (r2 * r2 + r3 * r3)) + ((r4 * r4 + r5 * r5) + (r6 * r6 + r7 * r7)); } }
                    sq += __shfl_xor(sq, 16); sq += __shfl_xor(sq, 32); sqv[ai * 4 + m] = __float2uint_rn(sq * 1024.f);
                }
            }
        if (ss_out) {
#pragma unroll
            for (int j = 0; j < 2; ++j) { const unsigned v = fq == 0 ? sqv[4 * j] : (fq == 1 ? sqv[4 * j + 1] : (fq == 2 ? sqv[4 * j + 2] : sqv[4 * j + 3]));
                atomicAdd(ss_out + row0 + j * HALF + fq * 16, v); }
        }
    }
};
}
using pg8::bf16_t; using pg8::bf16x8; using pg8::f32x4; using pg8::u32x4;
typedef float f32x16 __attribute__((ext_vector_type(16)));
typedef short s16x4 __attribute__((ext_vector_type(4)));
typedef unsigned u32x2 __attribute__((ext_vector_type(2)));
#define LAS __attribute__((address_space(3)))
constexpr int NB = 2, S = 4096, T = NB * S, D = 2048, FF = 8192, NH = 16, HD = 128;
constexpr int NQ_LD = 5376, MQ_LD = 6144;
constexpr float EPS = 1e-6f;
constexpr size_t MiB = 1u << 20;
constexpr size_t WS_W1T = 0, WS_W2T = 128 * MiB, WS_PGT = 256 * MiB, WS_PPT = 288 * MiB, WS_MQKV = 292 * MiB, WS_MWO = 316 * MiB, WS_POOL = 324 * MiB,
                 WS_NQKV = 326 * MiB, WS_NWO = 347 * MiB, WS_CW1 = 355 * MiB, WS_CIN = 357 * MiB, WS_CWO = 381 * MiB, WS_PB = 389 * MiB, WS_XN = 405 * MiB,
                 WS_OB = 437 * MiB, WS_PP = 469 * MiB, WS_BIG = 501 * MiB, WS_KMEAN = 629 * MiB, WS_KC = 630 * MiB, WS_VC = 631 * MiB, WS_CTL = 632 * MiB, WS_SS = 632 * MiB + 65536, WS_HB1 = 633 * MiB, WS_SSP = 665 * MiB, WS_END = 678 * MiB;
constexpr int LDS_BYTES = 155648;
constexpr int NWAVES = 8, NTHREADS = 512;

struct Params { const void* in[29]; float* out; unsigned char* ws; };

__device__ __forceinline__ float bflo(unsigned w) { return __uint_as_float(w << 16); }
__device__ __forceinline__ float bfhi(unsigned w) { return __uint_as_float(w & 0xffff0000u); }
__device__ __forceinline__ float bf1(bf16_t b) { return __uint_as_float((unsigned)b << 16); }
__device__ __forceinline__ unsigned pk2(float lo, float hi) { return pg8::cvt_pk_bf16(lo, hi); }
__device__ __forceinline__ bf16_t f2bf1(float f) { return (bf16_t)(pk2(f, 0.f) & 0xffffu); }
__device__ __forceinline__ float wave_sum(float v) {
#pragma unroll
    for (int o = 1; o < 64; o <<= 1) v += __shfl_xor(v, o);
    return v;
}
__device__ __forceinline__ bf16x8 pack8(f32x4 a, f32x4 b) { u32x4 w = {pk2(a[0], a[1]), pk2(a[2], a[3]), pk2(b[0], b[1]), pk2(b[2], b[3])}; return __builtin_bit_cast(bf16x8, w); }
__device__ __forceinline__ float sigmoidf_(float x) { return 1.f / (1.f + __expf(-x)); }

struct CJob { const float* W; bf16_t* WT; const float* gain; int K, N, row_off, item; };
__device__ __forceinline__ void tr_load(const CJob& J, int lane, float (&tv)[32]) {
    const int nblk = J.N / 32, kb = J.item / nblk, nb = J.item % nblk, k0 = 64 * kb, n0 = 32 * nb;
#pragma unroll
    for (int i = 0; i < 32; ++i) { const int kk = 2 * i + (lane >> 5); tv[i] = __builtin_nontemporal_load(J.W + (size_t)(k0 + kk) * J.N + n0 + (lane & 31)); }
}
__device__ __forceinline__ void tr_store(const CJob& J, int lane, const float (&tv)[32], float* scr) {
    const int nblk = J.N / 32, kb = J.item / nblk, nb = J.item % nblk, k0 = 64 * kb, n0 = 32 * nb;
#pragma unroll
    for (int i = 0; i < 32; ++i) { const int kk = 2 * i + (lane >> 5); scr[kk * 33 + (lane & 31)] = J.gain ? tv[i] * J.gain[k0 + kk] : tv[i]; }
    asm volatile("s_waitcnt lgkmcnt(0)" ::: "memory");
    const int c = lane & 7;
#pragma unroll
    for (int j = 0; j < 4; ++j) { const int n = (lane >> 3) + 8 * j; const float* s = scr + (8 * c) * 33 + n;
        u32x4 o; o.x = pk2(s[0 * 33], s[1 * 33]); o.y = pk2(s[2 * 33], s[3 * 33]); o.z = pk2(s[4 * 33], s[5 * 33]); o.w = pk2(s[6 * 33], s[7 * 33]);
        *(u32x4*)(J.WT + (size_t)(J.row_off + n0 + n) * J.K + k0 + 8 * c) = o; }
    asm volatile("s_waitcnt lgkmcnt(0)" ::: "memory");
}
#define CJOB(src, Kk, Nn, dst, roff, gn) if (!found) { const int ni_ = ((Kk) / 64) * ((Nn) / 32); if (r < ni_) { J.W = (const float*)(src); J.WT = (bf16_t*)(dst); J.gain = (const float*)(gn); J.K = (Kk); J.N = (Nn); J.row_off = (roff); J.item = r; found = true; } else r -= ni_; }
#define CJOB_LAYER(i) CJOB((const float*)P.in[5] + (size_t)(i) * D * FF, D, FF, ws + WS_W1T + (size_t)(i) * 32 * MiB, 0, (const float*)P.in[4] + (size_t)(i) * D) \
                      CJOB((const float*)P.in[6] + (size_t)(i) * D * FF, FF, D, ws + WS_W2T + (size_t)(i) * 32 * MiB, 0, nullptr) \
                      CJOB((const float*)P.in[8] + (size_t)(i) * D * D, D, D, ws + WS_PGT + (size_t)(i) * 8 * MiB, 0, (const float*)P.in[7] + (size_t)(i) * D) \
                      CJOB((const float*)P.in[9] + (size_t)(i) * 256 * D, 256, D, ws + WS_PPT + (size_t)(i) * 1 * MiB, 0, nullptr)
constexpr int NITEMS_CONV = 4 * (8192 + 8192 + 2048 + 256) + 6144 + 2048 + 4 * 128 + 2048 + 3072 + 2048 + 2 * 256 + 6144 + 2048;
__device__ __forceinline__ CJob conv_resolve(const Params& P, int it) {
    unsigned char* ws = P.ws; CJob J; J.W = nullptr; J.WT = nullptr; J.gain = nullptr; J.K = 64; J.N = 32; J.row_off = 0; J.item = 0;
    int r = it; bool found = false;
    CJOB_LAYER(0) CJOB_LAYER(1) CJOB_LAYER(2) CJOB_LAYER(3)
    CJOB(P.in[10], D, 3 * D, ws + WS_MQKV, 0, (const float*)P.in[3])
    CJOB(P.in[13], D, D, ws + WS_MWO, 0, nullptr)
    CJOB((const float*)P.in[14] + 0 * 512 * 512, 512, 512, ws + WS_POOL + 0 * 512 * 512 * 2, 0, nullptr)
    CJOB((const float*)P.in[14] + 1 * 512 * 512, 512, 512, ws + WS_POOL + 1 * 512 * 512 * 2, 0, nullptr)
    CJOB((const float*)P.in[14] + 2 * 512 * 512, 512, 512, ws + WS_POOL + 2 * 512 * 512 * 2, 0, nullptr)
    CJOB((const float*)P.in[14] + 3 * 512 * 512, 512, 512, ws + WS_POOL + 3 * 512 * 512 * 2, 0, nullptr)
    CJOB(P.in[16], D, D, ws + WS_NQKV, 0, (const float*)P.in[3] + 2 * D)
    CJOB(P.in[17], D, 3072, ws + WS_NQKV, 2048, (const float*)P.in[3] + 2 * D)
    CJOB(P.in[24], D, D, ws + WS_NWO, 0, nullptr)
    CJOB((const float*)P.in[21] + 0 * 4096 * 128, 4096, 128, ws + WS_CW1 + 0 * 128 * 4096 * 2, 0, nullptr)
    CJOB((const float*)P.in[21] + 1 * 4096 * 128, 4096, 128, ws + WS_CW1 + 1 * 128 * 4096 * 2, 0, nullptr)
    CJOB(P.in[25], D, 3 * D, ws + WS_CIN, 0, (const float*)P.in[3] + 3 * D)
    CJOB(P.in[28], D, D, ws + WS_CWO, 0, nullptr)
    return J;
}
__device__ __forceinline__ void phase_convert(const Params& P, char* lds, int gw, int NGW, int gtid, int NT, int wid, int lane) {
    asm volatile("" : "+v"(lane));
    unsigned char* ws = P.ws;
    float* scr = (float*)(lds + wid * 17408);
    for (int it = 2 * gw; it < NITEMS_CONV; it += 2 * NGW) {
        const CJob J0 = conv_resolve(P, it); const bool two = (it + 1 < NITEMS_CONV); const CJob J1 = conv_resolve(P, two ? it + 1 : it);
        float tv0[32], tv1[32];
        tr_load(J0, lane, tv0); tr_load(J1, lane, tv1);
        tr_store(J0, lane, tv0, scr);
        if (two) tr_store(J1, lane, tv1, scr);
    }
    { const float* Wg = (const float*)P.in[23]; bf16_t* dst = (bf16_t*)(ws + WS_NQKV) + (size_t)5120 * D;
      for (int idx = gtid; idx < 256 * D; idx += NT) { const int n = idx >> 11, k = idx & 2047; dst[idx] = (n < 48) ? f2bf1(Wg[(size_t)k * 48 + n] * ((const float*)P.in[3])[2 * D + k]) : (bf16_t)0; } }
    { const float* x = (const float*)P.in[0]; bf16_t* hb = (bf16_t*)(ws + WS_XN); unsigned* ss0 = (unsigned*)(ws + WS_SS);
      for (int m = gw; m < T; m += NGW) {
          const f32x4* xr = (const f32x4*)(x + (size_t)m * D) + lane; u32x2* o8 = (u32x2*)(hb + (size_t)m * D) + lane; float s = 0.f;
#pragma unroll
          for (int j = 0; j < 8; ++j) { const f32x4 v = xr[64 * j]; s += (v[0] * v[0] + v[1] * v[1]) + (v[2] * v[2] + v[3] * v[3]); u32x2 o; o.x = pk2(v[0], v[1]); o.y = pk2(v[2], v[3]); o8[64 * j] = o; }
          s = wave_sum(s); if (lane == 0) ss0[m] = __float2uint_rn(s * 1024.f); } }
    { const f32x4* ps = (const f32x4*)P.in[1]; u32x2* pd = (u32x2*)(ws + WS_PB);
      for (int idx = gtid; idx < 4 * T * 256 / 4; idx += NT) { const f32x4 v = ps[idx]; u32x2 o; o.x = pk2(v[0], v[1]); o.y = pk2(v[2], v[3]); pd[idx] = o; } }
}

__device__ __forceinline__ void phase_rms(const float* src, const float* gain, bf16_t* dst, int gw, int NGW, int lane) {
    asm volatile("" : "+v"(lane));
    for (int m = gw; m < T; m += NGW) {
        const f32x4* xr = (const f32x4*)(src + (size_t)m * D) + lane;
        f32x4 v[8]; float s = 0.f;
#pragma unroll
        for (int j = 0; j < 8; ++j) { v[j] = xr[64 * j]; s += (v[j][0] * v[j][0] + v[j][1] * v[j][1]) + (v[j][2] * v[j][2] + v[j][3] * v[j][3]); }
        const float rstd = 1.0f / sqrtf(wave_sum(s) * (1.f / D) + EPS);
        u32x2* o8 = (u32x2*)(dst + (size_t)m * D) + lane;
#pragma unroll
        for (int j = 0; j < 8; ++j) { const f32x4 g = ((const f32x4*)gain)[lane + 64 * j]; u32x2 o; o.x = pk2(v[j][0] * rstd * g[0], v[j][1] * rstd * g[1]); o.y = pk2(v[j][2] * rstd * g[2], v[j][3] * rstd * g[3]); o8[64 * j] = o; }
    }
}

template <class Epi>
__device__ __forceinline__ void gemm_run(char* lds, const bf16_t* A, int lda, const bf16_t* Bt, int ldb, int M, int N, int K, int G, int c, const Epi& E) {
    pg8::Gemm g{A, Bt, M, N, K, lda, ldb}; pg8::StaticOrder So; So.init(M, N, G, c);
    pg8::gemm_phase<Epi, pg8::StaticOrder, true, true>((PG8_LAS unsigned char*)lds, g, So, E);
}

__device__ __forceinline__ void rope_cs(int pos, int lane, float (&cs)[2], float (&sn)[2]) {
#pragma unroll
    for (int e = 0; e < 2; ++e) {
        const int i = 2 * (lane & 7) + e;
        const float freq = __builtin_amdgcn_exp2f(-(float)i * (18.931568569324174f / 16.0f));
        const float ang = (float)pos * freq;
        const double rev = (double)ang * 0.15915494309189535;
        const float fr = (float)(rev - floor(rev));
        cs[e] = __builtin_amdgcn_cosf(fr); sn[e] = __builtin_amdgcn_sinf(fr);
    }
}
__device__ __forceinline__ void head_norm_rope(unsigned w, const float* gain, int lane, const float (&cs)[2], const float (&sn)[2], float& n0, float& n1, float& r0, float& r1) {
    const float x0 = bflo(w), x1 = bfhi(w);
    const float ss = wave_sum(x0 * x0 + x1 * x1);
    const float rstd = 1.0f / sqrtf(ss * (1.f / HD) + EPS);
    n0 = x0 * rstd * gain[2 * lane]; n1 = x1 * rstd * gain[2 * lane + 1];
    const float p0 = __shfl_xor(n0, 8), p1 = __shfl_xor(n1, 8);
    r0 = n0; r1 = n1;
    if (lane < 8) { r0 = n0 * cs[0] - p0 * sn[0]; r1 = n1 * cs[1] - p1 * sn[1]; }
    else if (lane < 16) { r0 = n0 * cs[0] + p0 * sn[0]; r1 = n1 * cs[1] + p1 * sn[1]; }
}
__device__ __forceinline__ void phase_moba_prep(const Params& P, char* lds, int bid, int G, int tid, int wid, int lane) {
    asm volatile("" : "+v"(tid)); asm volatile("" : "+v"(lane));
    bf16_t* BIG = (bf16_t*)(P.ws + WS_BIG); float* KMEAN = (float*)(P.ws + WS_KMEAN);
    const int* pos = (const int*)P.in[2]; const float* qg = (const float*)P.in[11]; const float* kg = (const float*)P.in[12];
    float* red = (float*)(lds);
    for (int u = bid; u < NB * 16 * NH; u += G) {
        const int h = u & 15, blk = (u >> 4) & 15, b = u >> 8;
        float ks0 = 0.f, ks1 = 0.f;
        unsigned qwv[32], kwv[32];
#pragma unroll
        for (int i = 0; i < 32; ++i) { const size_t row = (size_t)(b * S + blk * 256 + wid * 32 + i);
            qwv[i] = *((const unsigned*)(BIG + row * MQ_LD + h * HD) + lane); kwv[i] = *((const unsigned*)(BIG + row * MQ_LD + D + h * HD) + lane); }
#pragma unroll
        for (int i = 0; i < 32; ++i) {
            const int row = b * S + blk * 256 + wid * 32 + i;
            float cs[2], sn[2]; rope_cs(pos[row], lane, cs, sn);
            unsigned* qp = (unsigned*)(BIG + (size_t)row * MQ_LD + h * HD) + lane;
            unsigned* kp = (unsigned*)(BIG + (size_t)row * MQ_LD + D + h * HD) + lane;
            const unsigned qw = qwv[i], kw = kwv[i];
            float n0, n1, r0, r1;
            head_norm_rope(qw, qg, lane, cs, sn, n0, n1, r0, r1); *qp = pk2(r0, r1);
            head_norm_rope(kw, kg, lane, cs, sn, n0, n1, r0, r1); *kp = pk2(r0, r1);
            ks0 += r0; ks1 += r1;
        }
        red[wid * 128 + 2 * lane] = ks0; red[wid * 128 + 2 * lane + 1] = ks1;
        __syncthreads();
        if (tid < 128) { float s = 0.f;
#pragma unroll
            for (int w = 0; w < 8; ++w) s += red[w * 128 + tid];
            KMEAN[(size_t)((b * NH + h) * 16 + blk) * HD + tid] = s * (1.f / 256.f); }
        __syncthreads();
    }
}

__device__ __forceinline__ void phase_nsa_norm(const Params& P, int gw, int NGW, int lane) {
    asm volatile("" : "+v"(lane));
    bf16_t* BIG = (bf16_t*)(P.ws + WS_BIG); bf16_t* QROT = (bf16_t*)(P.ws + WS_PP);
    const int* pos = (const int*)P.in[2]; const float* qg = (const float*)P.in[18]; const float* kg = (const float*)P.in[19];
    for (int row = gw; row < T; row += NGW) {
        float cs[2], sn[2]; rope_cs(pos[row], lane, cs, sn);
        bf16_t* base = BIG + (size_t)row * NQ_LD;
        unsigned qv[16], k1v[4], k2v[4];
#pragma unroll
        for (int hh = 0; hh < NH; ++hh) qv[hh] = *((const unsigned*)(base + hh * HD) + lane);
#pragma unroll
        for (int g = 0; g < 4; ++g) { k1v[g] = *((const unsigned*)(base + D + 2 * 512 + g * HD) + lane); k2v[g] = *((const unsigned*)(base + D + 4 * 512 + g * HD) + lane); }
#pragma unroll
        for (int hh = 0; hh < NH; ++hh) {
            unsigned* qp = (unsigned*)(base + hh * HD) + lane; float n0, n1, r0, r1;
            head_norm_rope(qv[hh], qg, lane, cs, sn, n0, n1, r0, r1);
            *qp = pk2(n0, n1);
        }
#pragma unroll
        for (int g = 0; g < 4; ++g) {
            unsigned* kp = (unsigned*)(base + D + 2 * 512 + g * HD) + lane; float n0, n1, r0, r1;
            head_norm_rope(k1v[g], kg + 1 * HD, lane, cs, sn, n0, n1, r0, r1); *kp = pk2(r0, r1);
            unsigned* kq = (unsigned*)(base + D + 4 * 512 + g * HD) + lane;
            head_norm_rope(k2v[g], kg + 2 * HD, lane, cs, sn, n0, n1, r0, r1); *kq = pk2(r0, r1);
        }
    }
}

__device__ __forceinline__ void phase_nsa_compress(const Params& P, char* lds, int bid, int G, int tid, int wid, int lane) {
    asm volatile("" : "+v"(tid)); asm volatile("" : "+v"(lane));
    const bf16_t* BIG = (const bf16_t*)(P.ws + WS_BIG); const bf16_t* CW1 = (const bf16_t*)(P.ws + WS_CW1);
    const float* cpos = (const float*)P.in[20]; const float* w2 = (const float*)P.in[22]; const float* kg0 = (const float*)P.in[19];
    float* red = (float*)lds;
    float* h1s = (float*)(lds + 65536);
    const int fr = lane & 15, fq = lane >> 4;
    for (int u = bid; u < 256; u += G) {
        const int ng = u & 15, j = (u >> 4) & 1, g = (u >> 5) & 3, b = u >> 7;
        const int n = 16 * ng + fr;
        f32x4 acc[8];
#pragma unroll
        for (int i = 0; i < 8; ++i) acc[i] = (f32x4){0.f, 0.f, 0.f, 0.f};
        for (int l = 4 * wid; l < 4 * wid + 4; ++l) {
            int tokl = 16 * n + l; tokl = tokl > S - 1 ? S - 1 : tokl;
            const bf16_t* rowp = BIG + (size_t)(b * S + tokl) * NQ_LD + D + j * 512 + g * HD;
            const float* pp = cpos + (size_t)(j * 32 + l) * HD;
#pragma unroll
            for (int dd = 0; dd < 4; ++dd) {
                const int d = dd * 32 + 8 * fq;
                const u32x4 raw = *(const u32x4*)(rowp + d);
                const f32x4 pa = *(const f32x4*)(pp + d), pb = *(const f32x4*)(pp + d + 4);
                f32x4 a0 = {bflo(raw.x) + pa[0], bfhi(raw.x) + pa[1], bflo(raw.y) + pa[2], bfhi(raw.y) + pa[3]};
                f32x4 a1 = {bflo(raw.z) + pb[0], bfhi(raw.z) + pb[1], bflo(raw.w) + pb[2], bfhi(raw.w) + pb[3]};
                const bf16x8 Af = pack8(a0, a1);
                const int k0 = l * HD + dd * 32 + 8 * fq;
#pragma unroll
                for (int ns = 0; ns < 8; ++ns) {
                    const bf16x8 Bw = *(const bf16x8*)(CW1 + (size_t)(j * 128 + ns * 16 + fr) * 4096 + k0);
                    acc[ns] = __builtin_amdgcn_mfma_f32_16x16x32_bf16(Bw, Af, acc[ns], 0, 0, 0);
                }
            }
        }
#pragma unroll
        for (int ns = 0; ns < 8; ++ns) *(f32x4*)(red + (size_t)(wid * 16 + fr) * 128 + ns * 16 + 4 * fq) = acc[ns];
        __syncthreads();
        const int m = tid >> 5, c4 = (tid & 31) * 4;
        { f32x4 s = {0.f, 0.f, 0.f, 0.f};
#pragma unroll
          for (int w = 0; w < 8; ++w) s = s + *(const f32x4*)(red + (size_t)(w * 16 + m) * 128 + c4);
#pragma unroll
          for (int e = 0; e < 4; ++e) { const float x = s[e]; const float uu = 0.7978845608028654f * (x + 0.044715f * x * x * x); const float th = 1.f - 2.f / (__expf(2.f * uu) + 1.f); s[e] = 0.5f * x * (1.f + th); }
          *(f32x4*)(h1s + m * 128 + c4) = s; }
        __syncthreads();
        f32x4 o = {0.f, 0.f, 0.f, 0.f};
        const float* w2j = w2 + (size_t)j * 128 * 128 + c4;
#pragma unroll 16
        for (int k = 0; k < 128; ++k) { const float hv = h1s[m * 128 + k]; const f32x4 wv = *(const f32x4*)(w2j + (size_t)k * 128); o = o + wv * hv; }
        if (j == 0) {
            float ss = (o[0] * o[0] + o[1] * o[1]) + (o[2] * o[2] + o[3] * o[3]);
#pragma unroll
            for (int sh = 1; sh < 32; sh <<= 1) ss += __shfl_xor(ss, sh);
            const float rstd = 1.0f / sqrtf(ss * (1.f / HD) + EPS);
            const f32x4 gn = *(const f32x4*)(kg0 + c4);
            o = o * rstd * gn;
        }
        const int nn = 16 * ng + m;
        if (nn >= 255) o = (f32x4){0.f, 0.f, 0.f, 0.f};
        bf16_t* dst = (bf16_t*)(P.ws + (j == 0 ? WS_KC : WS_VC)) + (size_t)((b * 4 + g) * 256 + nn) * HD + c4;
        u32x2 ow; ow.x = pk2(o[0], o[1]); ow.y = pk2(o[2], o[3]); *(u32x2*)dst = ow;
        __syncthreads();
    }
}

__device__ __forceinline__ f32x4 ld4bf(const bf16_t* p) { const u32x2 w = *(const u32x2*)p; return (f32x4){bflo(w.x), bfhi(w.x), bflo(w.y), bfhi(w.y)}; }
__device__ __forceinline__ void phase_pool_prep(const bf16_t* hsrc, const unsigned* ssq, const float* gain, bf16_t* OB, char* lds, int bid, int G, int tid, int wid, int lane) {
    asm volatile("" : "+v"(tid)); asm volatile("" : "+v"(lane));
    float* rs = (float*)lds;
    for (int u = bid; u < T / 32; u += G) {
        const int b = u / (S / 32), s0 = (u % (S / 32)) * 32;
        if (tid < 47) { const int s = s0 - 15 + tid; rs[tid] = (s >= 0) ? 1.0f / sqrtf((float)ssq[b * S + s] * (1.f / (1024.f * 2048.f)) + EPS) : 0.f; }
        __syncthreads();
        const int col = tid * 4, w = 2 << (tid >> 7);
        const f32x4 gn = *(const f32x4*)(gain + col);
        for (int rr = 0; rr < 32; ++rr) {
            const int s = s0 + rr; const int lo = (s + 1 - w) > 0 ? (s + 1 - w) : 0; const float inv = 1.0f / (float)(s + 1 - lo);
            f32x4 a = {0.f, 0.f, 0.f, 0.f};
            for (int sp = lo; sp <= s; ++sp) a = a + ld4bf(hsrc + (size_t)(b * S + sp) * D + col) * rs[sp - s0 + 15];
            const f32x4 xs = ld4bf(hsrc + (size_t)(b * S + s) * D + col) * rs[rr + 15];
            const f32x4 dv = (a * inv - xs) * gn;
            u32x2 ow; ow.x = pk2(dv[0], dv[1]); ow.y = pk2(dv[2], dv[3]);
            *(u32x2*)(OB + (size_t)(b * S + s) * D + col) = ow;
        }
        __syncthreads();
    }
}

__device__ __forceinline__ void phase_conv_elem(const Params& P, int gtid, int NT) {
    asm volatile("" : "+v"(gtid));
    const bf16_t* BIG = (const bf16_t*)(P.ws + WS_BIG); bf16_t* OB = (bf16_t*)(P.ws + WS_OB);
    const float* cw = (const float*)P.in[26]; const float* cb = (const float*)P.in[27];
    for (int it = gtid; it < T * 256; it += NT) {
        const int row = it >> 8, c8 = (it & 255) * 8, s = row & (S - 1);
        const bf16_t* base = BIG + (size_t)row * MQ_LD + c8;
        float u[3][8];
#pragma unroll
        for (int j = 0; j < 3; ++j) {
            const int back = 2 - j;
            if (s >= back) { const u32x4 cw4 = *(const u32x4*)(base - (size_t)back * MQ_LD + D), hw4 = *(const u32x4*)(base - (size_t)back * MQ_LD + 2 * D);
                u[j][0] = bflo(cw4.x) * bflo(hw4.x); u[j][1] = bfhi(cw4.x) * bfhi(hw4.x); u[j][2] = bflo(cw4.y) * bflo(hw4.y); u[j][3] = bfhi(cw4.y) * bfhi(hw4.y);
                u[j][4] = bflo(cw4.z) * bflo(hw4.z); u[j][5] = bfhi(cw4.z) * bfhi(hw4.z); u[j][6] = bflo(cw4.w) * bflo(hw4.w); u[j][7] = bfhi(cw4.w) * bfhi(hw4.w); }
            else {
#pragma unroll
                for (int e = 0; e < 8; ++e) u[j][e] = 0.f; }
        }
        const u32x4 bw4 = *(const u32x4*)base;
        float bv[8] = {bflo(bw4.x), bfhi(bw4.x), bflo(bw4.y), bfhi(bw4.y), bflo(bw4.z), bfhi(bw4.z), bflo(bw4.w), bfhi(bw4.w)};
        float y[8];
#pragma unroll
        for (int e = 0; e < 8; ++e) { const int c = c8 + e; y[e] = bv[e] * (cw[c] * u[0][e] + cw[D + c] * u[1][e] + cw[2 * D + c] * u[2][e] + cb[c]); }
        u32x4 ow = {pk2(y[0], y[1]), pk2(y[2], y[3]), pk2(y[4], y[5]), pk2(y[6], y[7])};
        *(u32x4*)(OB + (size_t)row * D + c8) = ow;
    }
}
namespace at {
constexpr float SCALE = 0.08838834764831845f;
constexpr float C2 = 1.4426950408889634f * SCALE;
constexpr int OFF_V = 0, OFF_K = 16384, KVBUF = 32768  , OFF_WS = 65536, OFF_IMP = 67584, OFF_SELM = 83968, OFF_Q = 86016;
#define KSWZ(row, colB) ((row) * 256 + ((colB) ^ (((row) & 7) << 4)))
#define SBAR() __builtin_amdgcn_sched_barrier(0)
__device__ __forceinline__ int v_st(int k, int c) { const int kk = (k & ~0xC) | ((k & 4) << 1) | ((k & 8) >> 1); return ((kk >> 3) * 4 + (c >> 5)) * 512 + ((kk & 7) * 32 + (c & 31)) * 2; }
__device__ __forceinline__ int v_rd_base(int lane) { return ((lane & 3) << 3) | (((lane >> 2) & 3) << 6) | (((lane >> 4) & 1) << 5) | (((lane >> 5) & 1) << 8); }
constexpr int v_rd_off(int d0, int ks, int half) { return d0 * 512 + ks * 4096 + half * 2048; }
__device__ __forceinline__ int crow(int r, int hi) { return (r & 3) + 8 * (r >> 2) + 4 * hi; }
__device__ __forceinline__ unsigned cvtpk(float lo, float hi) { unsigned r; asm volatile("v_cvt_pk_bf16_f32 %0, %1, %2" : "=v"(r) : "v"(lo), "v"(hi)); return r; }

__device__ __forceinline__ void mask_tile(f32x16& p0, f32x16& p1, int dq, unsigned W, bool rowok) {
    const float NEG = -__builtin_inff();
#pragma unroll
    for (int r = 0; r < 16; ++r) {
        const int c = (r & 3) + 8 * (r >> 2);
        if (!rowok || (unsigned)(dq - c) >= W) p0[r] = NEG;
        if (!rowok || (unsigned)(dq - c - 32) >= W) p1[r] = NEG;
    }
}
__device__ __forceinline__ float rowmax32(const f32x16& p0, const f32x16& p1) {
    float pmax = p0[0];
#pragma unroll
    for (int r = 1; r < 16; ++r) pmax = fmaxf(pmax, p0[r]);
#pragma unroll
    for (int r = 0; r < 16; ++r) pmax = fmaxf(pmax, p1[r]);
    auto rr = __builtin_amdgcn_permlane32_swap(__float_as_uint(pmax), __float_as_uint(pmax), false, false);
    return fmaxf(__uint_as_float(rr[0]), __uint_as_float(rr[1]));
}
__device__ __forceinline__ float rowsum32(const f32x16& p0, const f32x16& p1) {
    float ps = 0.f;
#pragma unroll
    for (int r = 0; r < 16; ++r) ps += p0[r];
#pragma unroll
    for (int r = 0; r < 16; ++r) ps += p1[r];
    auto rr = __builtin_amdgcn_permlane32_swap(__float_as_uint(ps), __float_as_uint(ps), false, false);
    return __uint_as_float(rr[0]) + __uint_as_float(rr[1]);
}
__device__ __forceinline__ void pack_p(const f32x16& p0, const f32x16& p1, bf16x8& pa0, bf16x8& pa1, bf16x8& pa2, bf16x8& pa3) {
#define PK4(P, B_, OUT) do { unsigned a0 = cvtpk(P[B_+0], P[B_+1]), a1 = cvtpk(P[B_+2], P[B_+3]);                          \
        unsigned b0 = cvtpk(P[B_+4], P[B_+5]), b1 = cvtpk(P[B_+6], P[B_+7]);                                             \
        auto r0 = __builtin_amdgcn_permlane32_swap(a0, b0, false, false); auto r1 = __builtin_amdgcn_permlane32_swap(a1, b1, false, false); \
        u32x4 w = {r0[0], r1[0], r0[1], r1[1]}; OUT = *reinterpret_cast<bf16x8*>(&w); } while (0)
    PK4(p0, 0, pa0); PK4(p0, 8, pa1); PK4(p1, 0, pa2); PK4(p1, 8, pa3);
#undef PK4
}
__device__ __forceinline__ void qkt(f32x16& p0, f32x16& p1, const char* K_lds, int r32, int hi, const char* Qw) {
    p0 = f32x16{}; p1 = f32x16{};
    int ko[4];
#pragma unroll
    for (int dd = 0; dd < 4; ++dd) ko[dd] = KSWZ(r32, (dd * 16 + hi * 8) * 2);
#pragma unroll
    for (int d0 = 0; d0 < 8; ++d0) { const int off = ko[d0 & 3] + (d0 >> 2) * 128; const char* a = K_lds + off;
        bf16x8 b0 = *reinterpret_cast<const bf16x8*>(a);
        bf16x8 b1 = *reinterpret_cast<const bf16x8*>(a + 32 * 256);
        bf16x8 q = *reinterpret_cast<const bf16x8*>(Qw + off);
        p0 = __builtin_amdgcn_mfma_f32_32x32x16_bf16(b0, q, p0, 0, 0, 0);
        p1 = __builtin_amdgcn_mfma_f32_32x32x16_bf16(b1, q, p1, 0, 0, 0); }
}
__device__ __forceinline__ void q_park(char* Qw, int r32, int hi, int d0, bf16x8 v) { *(bf16x8*)(Qw + KSWZ(r32, (d0 * 16 + hi * 8) * 2)) = v; }
__device__ __forceinline__ void pv_tile(f32x16 (&o)[4], int vb0, bf16x8 pa0, bf16x8 pa1, bf16x8 pa2, bf16x8 pa3) {
#define TRRD(dst, off) asm volatile("ds_read_b64_tr_b16 %0, %1 offset:%2" : "=&v"(dst) : "v"(vb0), "i"(off) : "memory")
#define PV_RD(S_, d0) do { constexpr int b_ = v_rd_off(d0, 0, 0); \
        TRRD(S_##l0, b_); TRRD(S_##h0, b_ + 2048); TRRD(S_##l1, b_ + 4096); TRRD(S_##h1, b_ + 6144); TRRD(S_##l2, b_ + 8192); TRRD(S_##h2, b_ + 10240); TRRD(S_##l3, b_ + 12288); TRRD(S_##h3, b_ + 14336); } while (0)
#define PV_MM(S_, d0) do { \
        o[d0] = __builtin_amdgcn_mfma_f32_32x32x16_bf16(pa0, (bf16x8){S_##l0[0], S_##l0[1], S_##l0[2], S_##l0[3], S_##h0[0], S_##h0[1], S_##h0[2], S_##h0[3]}, o[d0], 0, 0, 0);   \
        o[d0] = __builtin_amdgcn_mfma_f32_32x32x16_bf16(pa1, (bf16x8){S_##l1[0], S_##l1[1], S_##l1[2], S_##l1[3], S_##h1[0], S_##h1[1], S_##h1[2], S_##h1[3]}, o[d0], 0, 0, 0);   \
        o[d0] = __builtin_amdgcn_mfma_f32_32x32x16_bf16(pa2, (bf16x8){S_##l2[0], S_##l2[1], S_##l2[2], S_##l2[3], S_##h2[0], S_##h2[1], S_##h2[2], S_##h2[3]}, o[d0], 0, 0, 0);   \
        o[d0] = __builtin_amdgcn_mfma_f32_32x32x16_bf16(pa3, (bf16x8){S_##l3[0], S_##l3[1], S_##l3[2], S_##l3[3], S_##h3[0], S_##h3[1], S_##h3[2], S_##h3[3]}, o[d0], 0, 0, 0); } while (0)
#define LWAIT() do { asm volatile("s_waitcnt lgkmcnt(0)" ::: "memory"); SBAR(); } while (0)
    s16x4 Al0, Al1, Al2, Al3, Ah0, Ah1, Ah2, Ah3, Bl0, Bl1, Bl2, Bl3, Bh0, Bh1, Bh2, Bh3;
    PV_RD(A, 0); LWAIT();
    PV_RD(B, 1); SBAR(); PV_MM(A, 0); LWAIT();
    PV_RD(A, 2); SBAR(); PV_MM(B, 1); LWAIT();
    PV_RD(B, 3); SBAR(); PV_MM(A, 2); LWAIT();
    PV_MM(B, 3);
#undef LWAIT
#undef PV_MM
#undef PV_RD
#undef TRRD
}

template <int MODE>
__device__ __forceinline__ void attn_tiles(f32x16 (&o)[4], float& m_reg, float& l_reg, const char* Qw, const bf16_t* Kb, const bf16_t* Vb, int ldk,
                                           int t_lo, int t_hi, int tpos, unsigned long long sel, int own, float rl, char* lds, int tid, int wid, int lane) {
    asm volatile("" : "+v"(tid)); asm volatile("" : "+v"(lane));
    const int r32 = lane & 31, hi = lane >> 5;
    float* al_l = (float*)(lds + OFF_WS) + wid * 64;
    const int sr = tid >> 4, sc = (tid & 15) * 8;
    const int kws = KSWZ(sr, sc * 2), vst0 = v_st(sr, sc), vst1 = v_st(32 + sr, sc);
    const int vbase = (int)(uintptr_t)(lds + OFF_V) + v_rd_base(lane);
    bf16x8 sk0, sk1, sv0, sv1;
    sk0 = sk1 = sv0 = sv1 = (bf16x8){0, 0, 0, 0, 0, 0, 0, 0};
    float carry = 0.f;
#define LOADT(tt) do { const bf16_t* kp_ = Kb + (size_t)((tt) * 64 + sr) * ldk + sc; sk0 = *(const bf16x8*)kp_; sk1 = *(const bf16x8*)(kp_ + (size_t)32 * ldk); \
        if (MODE != 3) { const bf16_t* vp_ = Vb + (size_t)((tt) * 64 + sr) * ldk + sc; sv0 = *(const bf16x8*)vp_; sv1 = *(const bf16x8*)(vp_ + (size_t)32 * ldk); } } while (0)
#define WRITET(bo) do { *(bf16x8*)(lds + (bo) + OFF_K + kws) = sk0; *(bf16x8*)(lds + (bo) + OFF_K + kws + 32 * 256) = sk1; \
        if (MODE != 3) { *(bf16x8*)(lds + (bo) + OFF_V + vst0) = sv0; *(bf16x8*)(lds + (bo) + OFF_V + vst1) = sv1; } } while (0)
    if (t_lo < t_hi) { LOADT(t_lo); __syncthreads(); WRITET(0); if (t_lo + 1 < t_hi) LOADT(t_lo + 1); __syncthreads(); }
    if (wid >= 4) __builtin_amdgcn_s_setprio(1);
    for (int t = t_lo; t < t_hi; ++t) {
        const int bo = ((t - t_lo) & 1) * KVBUF;
        if (t + 1 < t_hi) { WRITET(bo ^ KVBUF); if (t + 2 < t_hi) LOADT(t + 2); }
        const char* K_lds = lds + bo + OFF_K; const int vb0 = vbase + bo;
        bool rowok = true, needm = true; unsigned Wm = 0x7fffffffu;
        if (MODE == 0) { const int kb = t >> 2; if (kb < own) { rowok = ((sel >> kb) & 1ull) != 0ull; needm = false; } else needm = ((t - 4 * own) * 64 + 63 > 32 * wid); }
        if (MODE == 1) { rowok = ((sel >> t) & 1ull) != 0ull; needm = (t == t_hi - 1); }
        if (MODE == 2) { Wm = 512u; needm = (t == t_hi - 1) || (t == t_hi - 9); }
        bool skipw = (MODE == 0) && ((t >> 2) >= own) && ((t - 4 * own) * 64 > 32 * wid + 31);
        if (MODE == 0 || MODE == 1) skipw = skipw || !__any(rowok);
        if (!skipw) {
        f32x16 p0, p1;
        qkt(p0, p1, K_lds, r32, hi, Qw);
        if (needm) mask_tile(p0, p1, tpos - t * 64 - 4 * hi, Wm, true);
        const float NEGINF = -__builtin_inff();
        if (MODE == 3) {
            const float pmax = rowmax32(p0, p1);
            const float mn = fmaxf(m_reg, pmax); const float alpha = __builtin_amdgcn_exp2f((m_reg - mn) * C2); m_reg = mn;
            const float mnL = -mn * C2;
#pragma unroll
            for (int r = 0; r < 16; ++r) { p0[r] = __builtin_amdgcn_exp2f(fmaf(p0[r], C2, mnL)); p1[r] = __builtin_amdgcn_exp2f(fmaf(p1[r], C2, mnL)); }
            l_reg = l_reg * alpha + rowsum32(p0, p1);
        } else if (MODE == 4) {
            const float mnL = -m_reg * C2;
#pragma unroll
            for (int r = 0; r < 16; ++r) { p0[r] = __builtin_amdgcn_exp2f(fmaf(p0[r], C2, mnL)) * rl; p1[r] = __builtin_amdgcn_exp2f(fmaf(p1[r], C2, mnL)) * rl; }
            float* impA = (float*)(lds + OFF_IMP + wid * 2048);
#pragma unroll
            for (int half = 0; half < 2; ++half)
#pragma unroll
                for (int rr = 0; rr < 4; ++rr) {
                    float a = half ? ((p1[4 * rr] + p1[4 * rr + 1]) + (p1[4 * rr + 2] + p1[4 * rr + 3])) : ((p0[4 * rr] + p0[4 * rr + 1]) + (p0[4 * rr + 2] + p0[4 * rr + 3]));
                    float bl = half ? p1[4 * rr + 3] : p0[4 * rr + 3];
                    a += __shfl_xor(a, 1); a += __shfl_xor(a, 2); bl += __shfl_xor(bl, 1); bl += __shfl_xor(bl, 2);
                    const float other = __shfl_xor(bl, 32);
                    const float add = hi ? other : carry;
                    carry = other;
                    const int j = 16 * t + 8 * half + 2 * rr + hi;
                    if ((r32 & 3) == 0) impA[(r32 >> 2) * 64 + j] = a + add;
                }
            bf16x8 pa0, pa1, pa2, pa3; pack_p(p0, p1, pa0, pa1, pa2, pa3);
            pv_tile(o, vb0, pa0, pa1, pa2, pa3);
        } else {
            float pmax = rowmax32(p0, p1); pmax = rowok ? pmax : NEGINF;
            float mn, alpha;
            if (__all((pmax - m_reg) * SCALE <= 8.f)) { mn = m_reg; alpha = 1.f; }
            else { mn = fmaxf(m_reg, pmax); alpha = __builtin_amdgcn_exp2f((m_reg - mn) * C2); m_reg = mn; }
            const float mnL = rowok ? -mn * C2 : NEGINF;
#pragma unroll
            for (int r = 0; r < 16; ++r) { p0[r] = __builtin_amdgcn_exp2f(fmaf(p0[r], C2, mnL)); p1[r] = __builtin_amdgcn_exp2f(fmaf(p1[r], C2, mnL)); }
            l_reg = l_reg * alpha + rowsum32(p0, p1);
            bf16x8 pa0, pa1, pa2, pa3; pack_p(p0, p1, pa0, pa1, pa2, pa3);
            if (__any(alpha < 1.f)) {
                if (hi == 0) al_l[r32] = alpha;
                asm volatile("s_waitcnt lgkmcnt(0)" ::: "memory");
#pragma unroll
                for (int r = 0; r < 16; ++r) { const float f = al_l[crow(r, hi)];
#pragma unroll
                    for (int d_ = 0; d_ < 4; ++d_) o[d_][r] *= f; }
            }
            pv_tile(o, vb0, pa0, pa1, pa2, pa3);
        }
        }
        __syncthreads();
    }
    __builtin_amdgcn_s_setprio(0);
#undef LOADT
#undef WRITET
}

template <bool NSA, bool ACCUM>
__device__ __forceinline__ void store_o(const f32x16 (&o)[4], float f, bf16_t* OB, size_t rowbase, int tok0, int hbase, char* lds, int wid, int lane) {
    asm volatile("" : "+v"(lane));
    const int r32 = lane & 31, hi = lane >> 5;
    float* li_l = (float*)(lds + OFF_WS) + wid * 64 + 32;
    if (hi == 0) li_l[r32] = f;
    asm volatile("s_waitcnt lgkmcnt(0)" ::: "memory");
    char* stg = lds + wid * 8192;
#pragma unroll
    for (int r = 0; r < 16; ++r) {
        const int rw = crow(r, hi); const float fr = li_l[rw];
#pragma unroll
        for (int d0 = 0; d0 < 4; ++d0) {
            const float v = o[d0][r] * fr; const float vn = __shfl_xor(v, 1);
            if ((r32 & 1) == 0) *(unsigned*)(stg + rw * 256 + (d0 * 32 + r32) * 2) = cvtpk(v, vn);
        }
    }
    asm volatile("s_waitcnt lgkmcnt(0)" ::: "memory");
#pragma unroll 2
    for (int i = 0; i < 8; ++i) {
        const int q = i * 64 + lane, row = q >> 4, ch = q & 15;
        u32x4 w = *(const u32x4*)(stg + row * 256 + ch * 16);
        const int tok = NSA ? tok0 + (row >> 2) : tok0 + row, hd = NSA ? hbase + (row & 3) : hbase;
        u32x4* gp = (u32x4*)(OB + (rowbase + tok) * D + hd * HD + ch * 8);
        if (ACCUM) { const u32x4 old = *gp;
            w.x = cvtpk(bflo(w.x) + bflo(old.x), bfhi(w.x) + bfhi(old.x)); w.y = cvtpk(bflo(w.y) + bflo(old.y), bfhi(w.y) + bfhi(old.y));
            w.z = cvtpk(bflo(w.z) + bflo(old.z), bfhi(w.z) + bfhi(old.z)); w.w = cvtpk(bflo(w.w) + bflo(old.w), bfhi(w.w) + bfhi(old.w)); }
        *gp = w;
    }
    asm volatile("s_waitcnt lgkmcnt(0)" ::: "memory");
}
}

__device__ __forceinline__ void moba_unit(const Params& P, int b, int h, int own, char* lds, int tid, int wid, int lane) {
    using namespace at;
    const bf16_t* BIG = (const bf16_t*)(P.ws + WS_BIG); const float* KMEAN = (const float*)(P.ws + WS_KMEAN); bf16_t* OB = (bf16_t*)(P.ws + WS_OB);
    const int r32 = lane & 31, hi = lane >> 5;
    const int tokl = own * 256 + wid * 32 + r32; const size_t row = (size_t)b * S + tokl;
    char* Qw = lds + OFF_Q + wid * 8192;
#pragma unroll
    for (int d0 = 0; d0 < 8; ++d0) q_park(Qw, r32, hi, d0, *(const bf16x8*)(BIG + row * MQ_LD + h * HD + d0 * 16 + hi * 8));
    char* K_lds = lds + OFF_K;
    { const int sr = tid >> 4, sc = (tid & 15) * 8; const int kws = KSWZ(sr, sc * 2);
      int zz_ = 0; asm volatile("" : "+v"(zz_));
      const u32x4 zq_ = {(unsigned)zz_, (unsigned)zz_, (unsigned)zz_, (unsigned)zz_};
      bf16x8 z0 = __builtin_bit_cast(bf16x8, zq_); const bf16x8 z1 = z0;
      if (sr < 16) { const float* km = KMEAN + (size_t)((b * NH + h) * 16 + sr) * HD + sc; z0 = pack8(*(const f32x4*)km, *(const f32x4*)(km + 4)); }
      __syncthreads();
      *(bf16x8*)(K_lds + kws) = z0; *(bf16x8*)(K_lds + kws + 32 * 256) = z1;
      __syncthreads(); }
    unsigned sel = 0u;
    { f32x16 p0, p1; qkt(p0, p1, K_lds, r32, hi, Qw);
      float g[16];
#pragma unroll
      for (int r = 0; r < 8; ++r) { const float mine = p0[r], other = __shfl_xor(mine, 32); const int nb = (r & 3) + 8 * (r >> 2);
          g[nb] = hi == 0 ? mine : other; g[nb + 4] = hi == 0 ? other : mine; }
      if (own <= 3) sel = (1u << own) - 1u;
      else {
#pragma unroll
          for (int pass = 0; pass < 3; ++pass) { float best = 0.f; int bi = -1;
#pragma unroll
              for (int n = 0; n < 16; ++n) { const bool cand = (n < own) && (((sel >> n) & 1u) == 0u); if (cand && (bi < 0 || g[n] > best)) { best = g[n]; bi = n; } }
              sel |= 1u << bi; }
      } }
    f32x16 o[4]; o[0] = f32x16{}; o[1] = f32x16{}; o[2] = f32x16{}; o[3] = f32x16{};
    float m_reg = -1e30f, l_reg = 0.f;
    const bf16_t* Kb = BIG + (size_t)b * S * MQ_LD + D + h * HD; const bf16_t* Vb = Kb + D;
    attn_tiles<0>(o, m_reg, l_reg, Qw, Kb, Vb, MQ_LD, 0, 4 * own + 4, tokl, (unsigned long long)sel, own, 0.f, lds, tid, wid, lane);
    store_o<false, false>(o, 1.f / l_reg, OB, (size_t)b * S, own * 256 + wid * 32, h, lds, wid, lane);
}
__device__ __forceinline__ void phase_moba_attn(const Params& P, char* lds, int bid, int G, int tid, int wid, int lane) {
    asm volatile("" : "+v"(tid)); asm volatile("" : "+v"(lane));
    for (int p0 = bid; p0 < NB * NH * 8; p0 += G) {
        int pr = p0; if (G == 256) { const int xcd = p0 & 7, slot = p0 >> 3; pr = (xcd * 4 + (slot >> 3)) * 8 + (slot & 7); }
        const int x = pr & 7, h = (pr >> 3) & 15, b = pr >> 7;
        moba_unit(P, b, h, 15 - x, lds, tid, wid, lane);
        moba_unit(P, b, h, x, lds, tid, wid, lane);
    }
}

__device__ __forceinline__ void nsa_unit(const Params& P, int b, int g, int c, char* lds, int tid, int wid, int lane) {
    using namespace at;
    const bf16_t* BIG = (const bf16_t*)(P.ws + WS_BIG); const bf16_t* QROT = (const bf16_t*)(P.ws + WS_PP); bf16_t* OB = (bf16_t*)(P.ws + WS_OB);
    const int r32 = lane & 31, hi = lane >> 5;
    const int tokl = 64 * c + 8 * wid + (r32 >> 2), head = 4 * g + (r32 & 3); const size_t row = (size_t)b * S + tokl;
    char* Qw = lds + OFF_Q + wid * 8192;
#pragma unroll
    for (int d0 = 0; d0 < 8; ++d0) q_park(Qw, r32, hi, d0, *(const bf16x8*)(BIG + row * NQ_LD + head * HD + d0 * 16 + hi * 8));
    f32x16 o[4]; o[0] = f32x16{}; o[1] = f32x16{}; o[2] = f32x16{}; o[3] = f32x16{};
    float m_reg = -1e30f, l_reg = 0.f;
    const bf16_t* Kc = (const bf16_t*)(P.ws + WS_KC) + (size_t)(b * 4 + g) * 256 * HD; const bf16_t* Vc = (const bf16_t*)(P.ws + WS_VC) + (size_t)(b * 4 + g) * 256 * HD;
    const int tq = (tokl - 31) >> 4;
    const int ncmp = ((4 * c + 2) >> 6) + 1;
    attn_tiles<3>(o, m_reg, l_reg, Qw, Kc, Vc, HD, 0, ncmp, tq, 0ull, 0, 0.f, lds, tid, wid, lane);
    const float rl = l_reg > 0.f ? 1.f / l_reg : 0.f;
    attn_tiles<4>(o, m_reg, l_reg, Qw, Kc, Vc, HD, 0, ncmp, tq, 0ull, 0, rl, lds, tid, wid, lane);
    store_o<true, false>(o, sigmoidf_(bf1(BIG[row * NQ_LD + 5120 + head * 3 + 0])), OB, (size_t)b * S, 64 * c + 8 * wid, 4 * g, lds, wid, lane);
    unsigned long long sel;
    { float* impA = (float*)(lds + OFF_IMP + wid * 2048);
      unsigned long long* selm = (unsigned long long*)(lds + OFF_SELM + wid * 64);
      asm volatile("s_waitcnt lgkmcnt(0)" ::: "memory");
      const float INF = __builtin_inff();
      for (int tk = 0; tk < 8; ++tk) {
          float val = impA[tk * 64 + lane];
          if (lane == 0 || lane == c) val = INF; else if (lane > c) val = -INF;
          const unsigned u_ = __float_as_uint(val); const unsigned key = (u_ & 0x80000000u) ? ~u_ : (u_ | 0x80000000u);
          unsigned thr = 0u;
#pragma unroll
          for (int bit = 31; bit >= 0; --bit) { const unsigned cand = thr | (1u << bit); if (__popcll(__ballot(key >= cand)) >= 16) thr = cand; }
          const unsigned long long gt_ = __ballot(key > thr), eq_ = __ballot(key == thr);
          const int need = 16 - __popcll(gt_), eqrank = __popcll(eq_ & ((1ull << lane) - 1ull));
          const bool s = ((key > thr) || (key == thr && eqrank < need)) && (val > -INF);
          const unsigned long long mk = __ballot(s);
          if (lane == 0) selm[tk] = mk;
      }
      asm volatile("s_waitcnt lgkmcnt(0)" ::: "memory");
      sel = selm[r32 >> 2]; }
    {
      const int pos_ = ((const int*)P.in[2])[row];
      const u32x4 w1 = *(const u32x4*)(Qw + KSWZ(r32, (0 * 16 + hi * 8) * 2)), w2 = *(const u32x4*)(Qw + KSWZ(r32, (1 * 16 + hi * 8) * 2));
      float x1[8] = {bflo(w1.x), bfhi(w1.x), bflo(w1.y), bfhi(w1.y), bflo(w1.z), bfhi(w1.z), bflo(w1.w), bfhi(w1.w)};
      float x2[8] = {bflo(w2.x), bfhi(w2.x), bflo(w2.y), bfhi(w2.y), bflo(w2.z), bfhi(w2.z), bflo(w2.w), bfhi(w2.w)};
#pragma unroll
      for (int j = 0; j < 8; ++j) { const int i_ = hi * 8 + j;
          const float freq = __builtin_amdgcn_exp2f(-(float)i_ * (18.931568569324174f / 16.0f));
          const float ang = (float)pos_ * freq; const double rev = (double)ang * 0.15915494309189535; const float fr_ = (float)(rev - floor(rev));
          const float c_ = __builtin_amdgcn_cosf(fr_), s_ = __builtin_amdgcn_sinf(fr_);
          const float a1 = x1[j], a2 = x2[j]; x1[j] = a1 * c_ - a2 * s_; x2[j] = a2 * c_ + a1 * s_; }
      q_park(Qw, r32, hi, 0, pack8((f32x4){x1[0], x1[1], x1[2], x1[3]}, (f32x4){x1[4], x1[5], x1[6], x1[7]}));
      q_park(Qw, r32, hi, 1, pack8((f32x4){x2[0], x2[1], x2[2], x2[3]}, (f32x4){x2[4], x2[5], x2[6], x2[7]})); }
    o[0] = f32x16{}; o[1] = f32x16{}; o[2] = f32x16{}; o[3] = f32x16{}; m_reg = -1e30f; l_reg = 0.f;
    const bf16_t* kvb = BIG + (size_t)b * S * NQ_LD + D + g * HD;
    attn_tiles<1>(o, m_reg, l_reg, Qw, kvb + 2 * 512, kvb + 3 * 512, NQ_LD, 0, c + 1, tokl, sel, 0, 0.f, lds, tid, wid, lane);
    store_o<true, true>(o, sigmoidf_(bf1(BIG[row * NQ_LD + 5120 + head * 3 + 1])) / l_reg, OB, (size_t)b * S, 64 * c + 8 * wid, 4 * g, lds, wid, lane);
    o[0] = f32x16{}; o[1] = f32x16{}; o[2] = f32x16{}; o[3] = f32x16{}; m_reg = -1e30f; l_reg = 0.f;
    attn_tiles<2>(o, m_reg, l_reg, Qw, kvb + 4 * 512, kvb + 5 * 512, NQ_LD, (c > 8 ? c - 8 : 0), c + 1, tokl, 0ull, 0, 0.f, lds, tid, wid, lane);
    store_o<true, true>(o, sigmoidf_(bf1(BIG[row * NQ_LD + 5120 + head * 3 + 2])) / l_reg, OB, (size_t)b * S, 64 * c + 8 * wid, 4 * g, lds, wid, lane);
}
__device__ __forceinline__ void phase_nsa_attn(const Params& P, char* lds, int bid, int G, int tid, int wid, int lane) {
    asm volatile("" : "+v"(tid)); asm volatile("" : "+v"(lane));
    for (int p0 = bid; p0 < NB * 4 * 32; p0 += G) {
        int pr = p0; if (G == 256) { const int xcd = p0 & 7, slot = p0 >> 3; pr = xcd * 32 + slot; }
        const int x = pr & 31, g = (pr >> 5) & 3, b = pr >> 7;
        nsa_unit(P, b, g, 63 - x, lds, tid, wid, lane);
        nsa_unit(P, b, g, x, lds, tid, wid, lane);
    }
}
typedef unsigned v4u __attribute__((ext_vector_type(4)));
#define XB_TMO      128
#define XB_XCNT(j)  (256  + 64 * (j))
#define XB_XSUB(j)  (1280 + 64 * (j))
#define XB_XGEN(j)  (2304 + 64 * (j))
#define XB_TOP      3328
#define XB_TOPGEN   3392
#define XCD_BAR_WORDS 3456
#define XB_SPIN_CAP (1u << 18)

__device__ __forceinline__ unsigned xb_ld(unsigned* p)              { return __hip_atomic_load(p, __ATOMIC_RELAXED, __HIP_MEMORY_SCOPE_AGENT); }
__device__ __forceinline__ unsigned xb_add(unsigned* p, unsigned v) { return __hip_atomic_fetch_add(p, v, __ATOMIC_RELAXED, __HIP_MEMORY_SCOPE_AGENT); }
__device__ __forceinline__ unsigned xb_xcc_id() { return (unsigned)__builtin_amdgcn_s_getreg((3 << 11) | 20) & 0xFu; }
#define XB_SPIN(cond, bar) do { unsigned _sp = 0; while (cond) { __builtin_amdgcn_s_sleep(1); \
    if ((++_sp & 255u) == 0u) { if (xb_ld(&(bar)[XB_TMO])) break; if (_sp > XB_SPIN_CAP) { atomicAdd(&(bar)[XB_TMO], 1u); break; } } } } while (0)

struct XcdBarrier {
    unsigned* bar; unsigned x;
    volatile LAS unsigned* st;
};

__device__ __forceinline__ XcdBarrier xcd_barrier_post(unsigned* bar, volatile LAS unsigned* st) {
    XcdBarrier b; b.bar = bar; b.x = xb_xcc_id(); b.st = st;
    if (threadIdx.x == 0) (void)xb_add(&bar[XB_XCNT(b.x)], 1u);
    return b;
}
__device__ __forceinline__ void xcd_barrier_complete(unsigned* bar, unsigned x, unsigned& nloc, unsigned& nx) {
    const unsigned G = gridDim.x * gridDim.y * gridDim.z;
    unsigned sum, cnt, mine, sp = 0u;
    for (;;) {
        sum = 0u; cnt = 0u; mine = 0u;
#pragma unroll
        for (unsigned j = 0; j < 16; ++j) { const unsigned c = xb_ld(&bar[XB_XCNT(j)]); sum += c; cnt += (c > 0u) ? 1u : 0u; mine = (j == x) ? c : mine; }
        if (sum == G) break;
        __builtin_amdgcn_s_sleep(1);
        if ((++sp & 255u) == 0u) { if (xb_ld(&bar[XB_TMO])) break; if (sp > XB_SPIN_CAP) { atomicAdd(&bar[XB_TMO], 1u); break; } }
    }
    nloc = mine > 0u ? mine : 1u; nx = cnt > 0u ? cnt : 1u;
}

__device__ __forceinline__ void xcd_barrier(const XcdBarrier& b) {
    asm volatile("s_waitcnt vmcnt(0)" ::: "memory");
    __syncthreads();
    if (threadIdx.x == 0) {
        unsigned* bar = b.bar;
        __builtin_amdgcn_s_waitcnt(0);
        unsigned nloc = b.st[0], nx = b.st[1];
        if (nloc == 0u) { xcd_barrier_complete(bar, b.x, nloc, nx); b.st[0] = nloc; b.st[1] = nx; }
        const unsigned old = xb_add(&bar[XB_XSUB(b.x)], 1u);
        const unsigned gen = old / nloc;
        if (old + 1u == (gen + 1u) * nloc) {
            __builtin_amdgcn_fence(__ATOMIC_RELEASE, "agent");
            asm volatile("s_waitcnt vmcnt(0)" ::: "memory");
            const unsigned og = xb_add(&bar[XB_TOP], 1u);
            const unsigned tg = og / nx;
            if (og + 1u == (tg + 1u) * nx) xb_add(&bar[XB_TOPGEN], 1u);
            else XB_SPIN(xb_ld(&bar[XB_TOPGEN]) == tg, bar);
            __builtin_amdgcn_fence(__ATOMIC_ACQUIRE, "agent");
            xb_add(&bar[XB_XGEN(b.x)], 1u);
            asm volatile("s_waitcnt vmcnt(0)" ::: "memory");
        } else {
            XB_SPIN(xb_ld(&bar[XB_XGEN(b.x)]) == gen, bar);
            __builtin_amdgcn_fence(__ATOMIC_ACQUIRE, "agent");
            asm volatile("s_waitcnt vmcnt(0)" ::: "memory");
        }
    }
    __syncthreads();
}

__global__ void __launch_bounds__(NTHREADS, 2) trunk_fwd(Params P) {
    extern __shared__ __attribute__((aligned(16))) unsigned char lds_raw[];
    char* lds = (char*)lds_raw;
    cg::grid_group grid = cg::this_grid();
    const int tid = threadIdx.x, lane = tid & 63, wid = __builtin_amdgcn_readfirstlane(tid >> 6);
    const int bid = blockIdx.x, G = gridDim.x;
    const int gw = bid * NWAVES + wid, NGW = G * NWAVES, NT = G * NTHREADS;
#define TID_FRESH() ({ int t_ = tid; asm volatile("" : "+v"(t_)); t_; })
    unsigned char* ws = P.ws;
    const float* x = (const float*)P.in[0];
    float* out = P.out;
    bf16_t* XN = (bf16_t*)(ws + WS_XN); bf16_t* OB = (bf16_t*)(ws + WS_OB); bf16_t* PPB = (bf16_t*)(ws + WS_PP); bf16_t* BIG = (bf16_t*)(ws + WS_BIG);

    volatile LAS unsigned* bst = (volatile LAS unsigned*)((LAS unsigned char*)lds_raw + LDS_BYTES - 16);
    if (tid == 0) { bst[0] = 0u; bst[1] = 0u; }
    __syncthreads();
    const XcdBarrier bar = xcd_barrier_post((unsigned*)(ws + WS_CTL), bst);
#define GSYNC() do { XcdBarrier b2_ = bar; asm volatile("" : "+s"(b2_.x)); xcd_barrier(b2_); } while (0)
    phase_convert(P, lds, gw, NGW, bid * NTHREADS + TID_FRESH(), NT, wid, lane);
    __syncthreads();
    if (P.out == nullptr) grid.sync();
    GSYNC();

    bf16_t* hbc = XN;
    bf16_t* hbo = (bf16_t*)(ws + WS_HB1);
    unsigned* SS = (unsigned*)(ws + WS_SS);
    for (int i = 0; i < 4; ++i) {
        if (i == 1) {
            phase_pool_prep(hbc, SS + (size_t)(3 * i) * T, (const float*)P.in[3] + (size_t)i * D, OB, lds, bid, G, tid, wid, lane);
            GSYNC();
            for (int gq = 0; gq < 4; ++gq) {
                pg8::EpiH<0> E{nullptr, hbc, nullptr, (const float*)P.in[15], gq * 512, nullptr, nullptr, hbc, SS + (size_t)(3 * i + 1) * T};
                gemm_run(lds, OB + gq * 512, D, (const bf16_t*)(ws + WS_POOL) + (size_t)gq * 512 * 512, 512, T, 512, 512, G, (bid + gq * (G / 4)) % G, E);
            }
            GSYNC();
        } else {
            { const bf16_t* Wt = (const bf16_t*)(ws + (i == 0 ? WS_MQKV : (i == 2 ? WS_NQKV : WS_CIN))); const int N = (i == 2) ? NQ_LD : MQ_LD;
              pg8::EpiB<0> E{BIG, N, SS + (size_t)(3 * i) * T};
              gemm_run(lds, hbc, D, Wt, D, T, N, D, G, bid, E); }
            GSYNC();
            if (i == 0) {
                phase_moba_prep(P, lds, bid, G, tid, wid, lane);
                GSYNC();
                phase_moba_attn(P, lds, bid, G, tid, wid, lane);
            } else if (i == 2) {
                phase_nsa_norm(P, gw, NGW, lane);
                phase_nsa_compress(P, lds, bid, G, tid, wid, lane);
                GSYNC();
                phase_nsa_attn(P, lds, bid, G, tid, wid, lane);
            } else {
                phase_conv_elem(P, bid * NTHREADS + TID_FRESH(), NT);
            }
            __syncthreads();
            GSYNC();
            { const bf16_t* Wt = (const bf16_t*)(ws + (i == 0 ? WS_MWO : (i == 2 ? WS_NWO : WS_CWO)));
              pg8::EpiH<0> E{(i == 0) ? x : nullptr, hbc, nullptr, nullptr, 0, nullptr, nullptr, hbc, SS + (size_t)(3 * i + 1) * T};
              gemm_run(lds, OB, D, Wt, D, T, D, D, G, bid, E); }
            GSYNC();
        }
        { pg8::EpiB<2> E{BIG, FF, nullptr};
          gemm_run(lds, hbc, D, (const bf16_t*)(ws + WS_W1T + (size_t)i * 32 * MiB), D, T, FF, D, G, bid, E); }
        { pg8::EpiB<0> E{PPB, D, nullptr};
          gemm_run(lds, (const bf16_t*)(ws + WS_PB) + (size_t)i * T * 256, 256, (const bf16_t*)(ws + WS_PPT + (size_t)i * 1 * MiB), 256, T, D, 256, G, bid, E); }
        GSYNC();
        { pg8::EpiH<0> E{nullptr, hbc, nullptr, nullptr, 0, nullptr, SS + (size_t)(3 * i + 1) * T, hbc, SS + (size_t)(3 * i + 2) * T};
          gemm_run(lds, BIG, FF, (const bf16_t*)(ws + WS_W2T + (size_t)i * 32 * MiB), FF, T, D, FF, G, bid, E); }
        GSYNC();
        { pg8::EpiH<1> E{nullptr, hbc, (i == 3) ? out : nullptr, nullptr, 0, PPB, SS + (size_t)(3 * i + 2) * T, (i < 3) ? hbo : nullptr, (i < 3) ? SS + (size_t)(3 * i + 3) * T : nullptr};
          gemm_run(lds, hbc, D, (const bf16_t*)(ws + WS_PGT + (size_t)i * 8 * MiB), D, T, D, D, G, bid, E); }
        if (i < 3) { GSYNC(); bf16_t* tsw = hbc; hbc = hbo; hbo = tsw; }
    }
}

extern "C" void kernel_launch(void* const* d_in, const int* in_sizes, int n_in, void* d_out, int out_size, void* d_ws, size_t ws_size, hipStream_t stream) {
    static int grid = 0;
    if (grid == 0) {
        if (n_in != 29 || out_size != T * D || ws_size < WS_END) { fprintf(stderr, "kernel_launch: unexpected problem (n_in %d, out %d, ws %zu)\n", n_in, out_size, ws_size); grid = -1; return; }
        int dev = 0, cus = 0, per_cu = 0;
        hipGetDevice(&dev);
        hipDeviceGetAttribute(&cus, hipDeviceAttributeMultiprocessorCount, dev);
        hipFuncSetAttribute((const void*)trunk_fwd, hipFuncAttributeMaxDynamicSharedMemorySize, LDS_BYTES);
        hipOccupancyMaxActiveBlocksPerMultiprocessor(&per_cu, (const void*)trunk_fwd, NTHREADS, LDS_BYTES);
        (void)hipGetLastError();
        if (per_cu < 1) { fprintf(stderr, "kernel_launch: occupancy query says %d blocks per CU\n", per_cu); per_cu = 1; }
        grid = cus;
        fprintf(stderr, "kernel_launch: cus %d per_cu %d grid %d\n", cus, per_cu, grid);
    }
    if (grid < 0) return;
    if (hipMemsetAsync((char*)d_ws + WS_CTL, 0, 1048576, stream) != hipSuccess) { fprintf(stderr, "kernel_launch: memset failed\n"); return; }
    Params p{};
    for (int i = 0; i < 29; ++i) p.in[i] = d_in[i];
    p.out = (float*)d_out; p.ws = (unsigned char*)d_ws;
    void* args[] = {&p};
    hipError_t e = hipLaunchCooperativeKernel((const void*)trunk_fwd, dim3(grid), dim3(NTHREADS), args, LDS_BYTES, stream);
    if (e != hipSuccess) fprintf(stderr, "cooperative launch failed: %s (grid %d)\n", hipGetErrorString(e), grid);
}
```

```cpp
#include <hip/hip_runtime.h>
#include <hip/hip_cooperative_groups.h>
#include <cstdio>
#include <cstdint>
namespace cg = cooperative_groups;
namespace pg8 {
#define PG8_LAS __attribute__((address_space(3)))
typedef unsigned short bf16_t;
typedef short bf16x8 __attribute__((ext_vector_type(8)));
typedef float f32x4 __attribute__((ext_vector_type(4)));
typedef unsigned u32x4 __attribute__((ext_vector_type(4)));
typedef unsigned u32x2_ __attribute__((ext_vector_type(2)));
constexpr int BM = 256, BK = 64, HALF = 128, HTB = HALF * BK * 2  , STAGE_BYTES = 8 * HTB, NXCD = 8, WGM = 8;

__host__ __device__ __forceinline__ int lds_byte(int r, int c) { const int st = (r >> 4) * 2 + (c >> 5), rr = r & 15, cc = c & 31, ob = rr * 64 + cc * 2; return st * 1024 + (ob ^ (((ob >> 9) & 1) << 5)); }
__host__ __device__ __forceinline__ void stage_rc(int b, int& R, int& C) { const int st = b / 1024, sb = b % 1024, swz = sb ^ (((sb >> 9) & 1) << 5); R = (st >> 1) * 16 + swz / 64; C = (st & 1) * 32 + (swz % 64) / 2; }
__host__ __device__ __forceinline__ int perm32(int rho) { const int n = rho >> 4, i = rho & 15; return 8 * (i >> 2) + 4 * n + (i & 3); }

struct Unit { int pm, pn; };
struct Gemm { const bf16_t* A; const bf16_t* Bt; int M, N, K, lda, ldb; };

struct StaticOrder {
    int nM, nN, nwg, G, c;
    __host__ __device__ void init(int M, int N, int G_, int c_) { nM = M / BM; nN = N / BM; nwg = nM * nN; G = G_; c = c_; }
    __host__ __device__ bool next(int i, Unit& u) const {
        const long L = (long)i * G + c; if (L >= nwg) return false;
        int wgid = (int)L; { const int q = nwg / NXCD, r = nwg % NXCD, xcd = wgid % NXCD, off = wgid / NXCD; wgid = (xcd < r ? xcd * (q + 1) : r * (q + 1) + (xcd - r) * q) + off; }
        const int nig = WGM * nN, gid = wgid / nig, fm = gid * WGM, gsz = (nM - fm) < WGM ? (nM - fm) : WGM;
        u.pm = fm + ((wgid % nig) % gsz); u.pn = (wgid % nig) / gsz; return true;
    }
    __device__ __forceinline__ void a_ready(const Unit&) const {}
    __device__ __forceinline__ void done(const Unit&) const {}
};

__device__ __forceinline__ unsigned cvt_pk_bf16(float lo, float hi) { unsigned r; asm volatile("v_cvt_pk_bf16_f32 %0, %1, %2" : "=v"(r) : "v"(lo), "v"(hi)); return r; }
typedef float f32x2 __attribute__((ext_vector_type(2)));
__device__ __forceinline__ f32x2 gelu_pk(f32x2 v) {
    const f32x2 av = __builtin_elementwise_abs(v), d = av * 0.2316418882f + 1.0f;
    f32x2 t; t.x = __builtin_amdgcn_rcpf(d.x); t.y = __builtin_amdgcn_rcpf(d.y);
    f32x2 q = t * 0.5307027145f + (-0.7265760135f); q = q * t + 0.7107068705f; q = q * t + (-0.142248368f); q = q * t + 0.127414796f; q = q * t;
    const f32x2 s = (v * v) * (-0.72134752044f);
    f32x2 e; e.x = __builtin_amdgcn_exp2f(s.x); e.y = __builtin_amdgcn_exp2f(s.y);
    const f32x2 m = v * (q * e), r = v - m;
    f32x2 o; o.x = v.x < 0.f ? m.x : r.x; o.y = v.y < 0.f ? m.y : r.y; return o;
}

template <int ACT  > struct EpiBf16 {
    static constexpr bool PERM = true, AFTER_DRAIN = false; static_assert(ACT == 0 || ACT == 1, "EpiBf16: ACT is 0 (none) or 1 (gelu_pk)");
    bf16_t* O; int ldc; const float* bias; int split_cols; size_t split_stride; float scale0;
    __device__ __forceinline__ void operator()(const f32x4 (&acc)[2][2][4][2], const Unit& u, int wr, int wc, int fr, int fq) const {
        const int row0 = u.pm * BM + wr * 64 + fr; int colt = u.pn * BM; bf16_t* base = O;
        float sc = 1.f; if (split_cols) { const int t = colt / split_cols; base += (size_t)t * split_stride; colt -= t * split_cols; if (t == 0) sc = scale0; }
        const int col0 = colt + wc * 32 + 8 * fq, bcol0 = u.pn * BM + wc * 32 + 8 * fq;
        f32x4 bv[2][2];
#pragma unroll
        for (int bj = 0; bj < 2; ++bj)
#pragma unroll
            for (int n = 0; n < 2; ++n) bv[bj][n] = bias ? *(const f32x4*)(bias + bcol0 + bj * HALF + 4 * n) : (f32x4){0.f, 0.f, 0.f, 0.f};
#pragma unroll
        for (int ai = 0; ai < 2; ++ai)
#pragma unroll
            for (int m = 0; m < 4; ++m) { bf16_t* rowp = base + (size_t)(row0 + ai * HALF + m * 16) * ldc + col0;
#pragma unroll
                for (int bj = 0; bj < 2; ++bj) { f32x4 v0 = acc[ai][bj][m][0] + bv[bj][0], v1 = acc[ai][bj][m][1] + bv[bj][1];
                    if (ACT == 1) { f32x2 a = gelu_pk((f32x2){v0[0], v0[1]}), b = gelu_pk((f32x2){v0[2], v0[3]}), c = gelu_pk((f32x2){v1[0], v1[1]}), d = gelu_pk((f32x2){v1[2], v1[3]});
                        v0 = (f32x4){a.x, a.y, b.x, b.y}; v1 = (f32x4){c.x, c.y, d.x, d.y}; }
                    v0 = v0 * sc; v1 = v1 * sc; u32x4 w; w.x = cvt_pk_bf16(v0[0], v0[1]); w.y = cvt_pk_bf16(v0[2], v0[3]); w.z = cvt_pk_bf16(v1[0], v1[1]); w.w = cvt_pk_bf16(v1[2], v1[3]);
                    *(u32x4*)(rowp + bj * HALF) = w; } }
    }
};
template <class Epi, class Sched, bool ALIGN_EPI = false, bool SP2 = false>
__device__ __forceinline__ void gemm_phase(PG8_LAS unsigned char* lds, const Gemm g, const Sched& S, const Epi& E) {
    int tid_ = threadIdx.x; asm volatile("" : "+v"(tid_)); const int tid = tid_, wid = __builtin_amdgcn_readfirstlane(tid >> 6), lane = tid & 63, wr = wid >> 2, wc = wid & 3, fr = lane & 15, fq = lane >> 4;
    const int K = g.K, nt = K / BK;
    unsigned voffA[2], voffB[2];
#pragma unroll
    for (int i = 0; i < 2; ++i) { int R, C; stage_rc(tid * 16 + i * 8192, R, C); const int Rb = Epi::PERM ? ((R & ~31) + perm32(R & 31)) : R;
        voffA[i] = (unsigned)(R * g.lda + C) * 2u; voffB[i] = (unsigned)(Rb * g.ldb + C) * 2u; }
    const size_t kstep = (size_t)(BK * 2);
    const size_t hstepA = (size_t)HALF * g.lda * 2, hstepB = (size_t)HALF * g.ldb * 2;
    const size_t tstepA = 2 * hstepA, tstepB = 2 * hstepB;
    const unsigned ldsw = (unsigned)wid * 1024u;
    const int aoff = lds_byte(wr * 64 + fr, fq * 8), boff = lds_byte(wc * 32 + fr, fq * 8);
#define PG8_SA(b, h) (((b) * 2 + (h)) * HTB)
#define PG8_SB(b, h) ((4 + (b) * 2 + (h)) * HTB)
#define PG8_STAGE(bufoff, gbase, voff) do { _Pragma("unroll") for (int _i = 0; _i < 2; ++_i) \
        __builtin_amdgcn_global_load_lds((const unsigned*)((const char*)(gbase) + (voff)[_i]), (PG8_LAS unsigned*)(lds + (bufoff) + ldsw + _i * 8192), 16, 0, 0); } while (0)
#define PG8_LDA(dst, b, h) do { _Pragma("unroll") for (int m = 0; m < 4; ++m) _Pragma("unroll") for (int k = 0; k < 2; ++k) dst[m][k] = *(const PG8_LAS bf16x8*)(lds + PG8_SA(b, h) + aoff + m * 2048 + k * 1024); } while (0)
#define PG8_LDB(dst, b, h) do { _Pragma("unroll") for (int n = 0; n < 2; ++n) _Pragma("unroll") for (int k = 0; k < 2; ++k) dst[n][k] = *(const PG8_LAS bf16x8*)(lds + PG8_SB(b, h) + boff + n * 2048 + k * 1024); } while (0)
#define PG8_MMA(ai, bj, At, Bt) do { __builtin_amdgcn_s_setprio(1); _Pragma("unroll") for (int m = 0; m < 4; ++m) _Pragma("unroll") for (int n = 0; n < 2; ++n) _Pragma("unroll") for (int k = 0; k < 2; ++k) \
        acc[ai][bj][m][n] = __builtin_amdgcn_mfma_f32_16x16x32_bf16(Bt[n][k], At[m][k], acc[ai][bj][m][n], 0, 0, 0); __builtin_amdgcn_s_setprio(0); } while (0)
#define PG8_WAIT_V(n) asm volatile("s_waitcnt vmcnt(" #n ")" ::: "memory")
#define PG8_WAIT_L(n) asm volatile("s_waitcnt lgkmcnt(" #n ")" ::: "memory")
#define PG8_BAR __builtin_amdgcn_s_barrier()
#define PG8_SCHED __builtin_amdgcn_sched_barrier(0)
    Unit cur, nxt; int ui = 0;
    if (!S.next(0, cur)) return;
    f32x4 acc[2][2][4][2];
#pragma unroll
    for (int a = 0; a < 2; ++a)
#pragma unroll
        for (int b = 0; b < 2; ++b)
#pragma unroll
            for (int m = 0; m < 4; ++m)
#pragma unroll
                for (int n = 0; n < 2; ++n) acc[a][b][m][n] = (f32x4){0.f, 0.f, 0.f, 0.f};
    bf16x8 At[4][2], B0[2][2], B1[2][2];
    const char* cA = (const char*)g.A + (size_t)cur.pm * tstepA; const char* cB = (const char*)g.Bt + (size_t)cur.pn * tstepB;
    S.a_ready(cur);
    if constexpr (SP2) {
        PG8_STAGE(PG8_SB(0, 0), cB, voffB); PG8_STAGE(PG8_SB(0, 1), cB + hstepB, voffB); PG8_STAGE(PG8_SA(0, 0), cA, voffA); PG8_STAGE(PG8_SA(0, 1), cA + hstepA, voffA);
        if (wr == 1) PG8_BAR;
        PG8_WAIT_V(2); PG8_BAR;
        PG8_STAGE(PG8_SB(1, 0), cB + kstep, voffB); PG8_STAGE(PG8_SA(1, 0), cA + kstep, voffA); PG8_STAGE(PG8_SB(1, 1), cB + hstepB + kstep, voffB);
        PG8_WAIT_V(6); PG8_BAR;
    } else {
        PG8_STAGE(PG8_SB(0, 0), cB, voffB); PG8_STAGE(PG8_SA(0, 0), cA, voffA); PG8_STAGE(PG8_SB(0, 1), cB + hstepB, voffB); PG8_STAGE(PG8_SA(0, 1), cA + hstepA, voffA);
        if (wr == 1) PG8_BAR;
        PG8_WAIT_V(4); PG8_BAR;
        PG8_STAGE(PG8_SB(1, 0), cB + kstep, voffB); PG8_STAGE(PG8_SA(1, 0), cA + kstep, voffA); PG8_STAGE(PG8_SB(1, 1), cB + hstepB + kstep, voffB);
        PG8_WAIT_V(6); PG8_BAR;
    }
    for (;;) {
        const bool has_next = S.next(ui + 1, nxt);
        E.pre(lds + STAGE_BYTES, cur, wr, fr, wid);
        const char* nA = has_next ? (const char*)g.A + (size_t)nxt.pm * tstepA : cA; const char* nB = has_next ? (const char*)g.Bt + (size_t)nxt.pn * tstepB : cB;
        for (int t = 0; t < nt; t += 2) {
            const bool last = (t == nt - 2);
            const char* a1 = cA + (size_t)(t + 1) * kstep;
            const char* a2 = last ? nA : cA + (size_t)(t + 2) * kstep; const char* b2 = last ? nB : cB + (size_t)(t + 2) * kstep;
            const char* a3 = a2 + kstep; const char* b3 = b2 + kstep;
            if (last && has_next) S.a_ready(nxt);
            if constexpr (SP2) {
            PG8_LDB(B0, 0, 0); PG8_LDB(B1, 0, 1); PG8_SCHED; PG8_LDA(At, 0, 0); PG8_STAGE(PG8_SA(1, 1), a1 + hstepA, voffA);
            PG8_WAIT_V(8); PG8_WAIT_L(0); PG8_BAR; PG8_MMA(0, 0, At, B0); PG8_MMA(0, 1, At, B1); PG8_BAR; PG8_SCHED;
            PG8_LDA(At, 0, 1); PG8_STAGE(PG8_SB(0, 0), b2, voffB); PG8_STAGE(PG8_SB(0, 1), b2 + hstepB, voffB); PG8_STAGE(PG8_SA(0, 0), a2, voffA);
            PG8_WAIT_V(8); PG8_WAIT_L(0); PG8_BAR; PG8_MMA(1, 0, At, B0); PG8_MMA(1, 1, At, B1); PG8_BAR; PG8_SCHED;
            PG8_LDB(B0, 1, 0); PG8_LDB(B1, 1, 1); PG8_SCHED; PG8_LDA(At, 1, 0); PG8_STAGE(PG8_SA(0, 1), a2 + hstepA, voffA);
            PG8_WAIT_V(8); PG8_WAIT_L(0); PG8_BAR; PG8_MMA(0, 0, At, B0); PG8_MMA(0, 1, At, B1); PG8_BAR; PG8_SCHED;
            PG8_LDA(At, 1, 1); PG8_STAGE(PG8_SB(1, 0), b3, voffB); PG8_STAGE(PG8_SB(1, 1), b3 + hstepB, voffB); PG8_STAGE(PG8_SA(1, 0), a3, voffA);
            PG8_WAIT_V(8); PG8_WAIT_L(0); PG8_BAR; PG8_MMA(1, 0, At, B0); PG8_MMA(1, 1, At, B1); PG8_BAR; PG8_SCHED;
            } else {
            PG8_LDB(B0, 0, 0); PG8_SCHED; PG8_LDA(At, 0, 0); PG8_STAGE(PG8_SA(1, 1), a1 + hstepA, voffA);
            PG8_WAIT_L(8); PG8_BAR; PG8_WAIT_L(0); PG8_MMA(0, 0, At, B0); PG8_BAR; PG8_SCHED;
            PG8_LDB(B1, 0, 1); PG8_STAGE(PG8_SB(0, 0), b2, voffB);
            PG8_BAR; PG8_WAIT_L(0); PG8_MMA(0, 1, At, B1); PG8_BAR;
            PG8_LDA(At, 0, 1); PG8_STAGE(PG8_SA(0, 0), a2, voffA);
            PG8_BAR; PG8_WAIT_L(0); PG8_MMA(1, 0, At, B0); PG8_BAR; PG8_SCHED;
            PG8_STAGE(PG8_SB(0, 1), b2 + hstepB, voffB);
            PG8_WAIT_V(6); PG8_BAR; PG8_MMA(1, 1, At, B1); PG8_BAR;
            PG8_LDB(B0, 1, 0); PG8_SCHED; PG8_LDA(At, 1, 0); PG8_STAGE(PG8_SA(0, 1), a2 + hstepA, voffA);
            PG8_WAIT_L(8); PG8_BAR; PG8_WAIT_L(0); PG8_MMA(0, 0, At, B0); PG8_BAR; PG8_SCHED;
            PG8_LDB(B1, 1, 1); PG8_STAGE(PG8_SB(1, 0), b3, voffB);
            PG8_BAR; PG8_WAIT_L(0); PG8_MMA(0, 1, At, B1); PG8_BAR;
            PG8_LDA(At, 1, 1); PG8_STAGE(PG8_SA(1, 0), a3, voffA);
            PG8_BAR; PG8_WAIT_L(0); PG8_MMA(1, 0, At, B0); PG8_BAR; PG8_SCHED;
            PG8_STAGE(PG8_SB(1, 1), b3 + hstepB, voffB);
            PG8_WAIT_V(6); PG8_BAR; PG8_MMA(1, 1, At, B1); PG8_BAR;
            }
        }
        if constexpr (ALIGN_EPI) { if (wr == 0) PG8_BAR; }
        if constexpr (!Epi::AFTER_DRAIN) { E(acc, cur, wr, wc, fr, fq, lds + STAGE_BYTES, wid, lane); S.done(cur); }
        if (!has_next) break;
#pragma unroll
        for (int a = 0; a < 2; ++a)
#pragma unroll
            for (int b = 0; b < 2; ++b)
#pragma unroll
                for (int m = 0; m < 4; ++m)
#pragma unroll
                    for (int n = 0; n < 2; ++n) acc[a][b][m][n] = (f32x4){0.f, 0.f, 0.f, 0.f};
        cur = nxt; cA = nA; cB = nB; ++ui;
        if constexpr (ALIGN_EPI) { if (wr == 1) PG8_BAR; }
    }
    PG8_WAIT_V(0);
    if constexpr (!ALIGN_EPI) { if (wr == 0) PG8_BAR; }
    PG8_BAR;
    if constexpr (Epi::AFTER_DRAIN) { E.fused(acc, cur, wr, wc, fr, fq, lds, wid, lane); S.done(cur); }
#undef PG8_SA
#undef PG8_SB
#undef PG8_STAGE
#undef PG8_LDA
#undef PG8_LDB
#undef PG8_MMA
#undef PG8_WAIT_V
#undef PG8_WAIT_L
#undef PG8_BAR
#undef PG8_SCHED
}
}
namespace pg8 {
constexpr float NORM_EPS_ = 1e-6f;
__device__ __forceinline__ void stat_dma(PG8_LAS unsigned char* spare, const unsigned* ss, const Unit& u, int wr, int fr, int wid) {
#pragma unroll
    for (int k = 0; k < 8; ++k)
        __builtin_amdgcn_global_load_lds(ss + (u.pm * BM + wr * 64 + fr + (k >> 2) * HALF + (k & 3) * 16), (PG8_LAS unsigned*)(spare + wid * 2048 + k * 256), 4, 0, 0);
}
__device__ __forceinline__ float stat_rstd(PG8_LAS unsigned char* spare, int wid, int lane, int k) {
    const unsigned v = *(const PG8_LAS unsigned*)(spare + wid * 2048 + k * 256 + lane * 4);
    return 1.0f / sqrtf((float)v * (1.f / (1024.f * 2048.f)) + NORM_EPS_);
}
template <int ACT  > struct EpiB {
    static constexpr bool PERM = true, AFTER_DRAIN = false;
    bf16_t* O; int ldc; const unsigned* ss;
    __device__ __forceinline__ void pre(PG8_LAS unsigned char* spare, const Unit& u, int wr, int fr, int wid) const { if (ss) stat_dma(spare, ss, u, wr, fr, wid); }
    __device__ __forceinline__ void operator()(const f32x4 (&acc)[2][2][4][2], const Unit& u, int wr, int wc, int fr, int fq, PG8_LAS unsigned char* spare, int wid, int lane) const {
        const int row0 = u.pm * BM + wr * 64 + fr, col0 = u.pn * BM + wc * 32 + 8 * fq;
#pragma unroll
        for (int ai = 0; ai < 2; ++ai)
#pragma unroll
            for (int m = 0; m < 4; ++m) { const int row = row0 + ai * HALF + m * 16; bf16_t* rowp = O + (size_t)row * ldc + col0;
                const float rs = ss ? stat_rstd(spare, wid, lane, ai * 4 + m) : 1.f;
#pragma unroll
                for (int bj = 0; bj < 2; ++bj) { f32x4 v0 = acc[ai][bj][m][0] * rs, v1 = acc[ai][bj][m][1] * rs;
                    if (ACT == 2) {
#pragma unroll
                        for (int e = 0; e < 4; ++e) { float a = v0[e] > 0.f ? v0[e] : 0.f; v0[e] = a * a; float b = v1[e] > 0.f ? v1[e] : 0.f; v1[e] = b * b; } }
                    u32x4 w; w.x = cvt_pk_bf16(v0[0], v0[1]); w.y = cvt_pk_bf16(v0[2], v0[3]); w.z = cvt_pk_bf16(v1[0], v1[1]); w.w = cvt_pk_bf16(v1[2], v1[3]);
                    *(u32x4*)(rowp + bj * HALF) = w; } }
    }
};
template <int MODE> struct EpiH {
    static constexpr bool PERM = true, AFTER_DRAIN = false;
    const float* base_f; const bf16_t* hb_in; float* out; const float* cscale; int col_off; const bf16_t* pp; const unsigned* ss_in; bf16_t* hb; unsigned* ss_out;
    __device__ __forceinline__ void pre(PG8_LAS unsigned char* spare, const Unit& u, int wr, int fr, int wid) const { if (ss_in) stat_dma(spare, ss_in, u, wr, fr, wid); }
    __device__ __forceinline__ void operator()(const f32x4 (&acc)[2][2][4][2], const Unit& u, int wr, int wc, int fr, int fq, PG8_LAS unsigned char* spare, int wid, int lane) const {
        const int row0 = u.pm * BM + wr * 64 + fr, col0 = col_off + u.pn * BM + wc * 32 + 8 * fq;
        unsigned sqv[8];
#pragma unroll
        for (int ai = 0; ai < 2; ++ai)
#pragma unroll
            for (int mp = 0; mp < 2; ++mp) {
                f32x4 bv[2][2][2]; u32x4 pw[2][2]; float rs[2] = {1.f, 1.f};
#pragma unroll
                for (int mm = 0; mm < 2; ++mm) { const int row = row0 + ai * HALF + (2 * mp + mm) * 16; const size_t ro = (size_t)row * 2048;
                    if (ss_in) { const float r_ = stat_rstd(spare, wid, lane, ai * 4 + 2 * mp + mm); rs[mm] = (MODE == 0) ? r_ * r_ : r_; }
#pragma unroll
                    for (int bj = 0; bj < 2; ++bj) { const int c = col0 + bj * HALF;
                        if (base_f) { bv[mm][bj][0] = *(const f32x4*)(base_f + ro + c); bv[mm][bj][1] = *(const f32x4*)(base_f + ro + c + 4); }
                        else { const u32x4 w = *(const u32x4*)(hb_in + ro + c);
                            bv[mm][bj][0] = (f32x4){__uint_as_float(w.x << 16), __uint_as_float(w.x & 0xffff0000u), __uint_as_float(w.y << 16), __uint_as_float(w.y & 0xffff0000u)};
                            bv[mm][bj][1] = (f32x4){__uint_as_float(w.z << 16), __uint_as_float(w.z & 0xffff0000u), __uint_as_float(w.w << 16), __uint_as_float(w.w & 0xffff0000u)}; }
                        pw[mm][bj] = (MODE == 1) ? *(const u32x4*)(pp + ro + c) : (u32x4){0u, 0u, 0u, 0u}; } }
#pragma unroll
                for (int mm = 0; mm < 2; ++mm) { const int m = 2 * mp + mm; const int row = row0 + ai * HALF + m * 16; const size_t ro = (size_t)row * 2048;
                    float sq = 0.f;
#pragma unroll
                    for (int bj = 0; bj < 2; ++bj) { const int c = col0 + bj * HALF; f32x4 v0 = acc[ai][bj][m][0], v1 = acc[ai][bj][m][1];
                        if (MODE == 0) { if (cscale) { v0 = v0 * *(const f32x4*)(cscale + c); v1 = v1 * *(const f32x4*)(cscale + c + 4); } v0 = v0 * rs[mm]; v1 = v1 * rs[mm]; }
                        else { const u32x4 w = pw[mm][bj];
                            const f32x4 p0 = {__uint_as_float(w.x << 16), __uint_as_float(w.x & 0xffff0000u), __uint_as_float(w.y << 16), __uint_as_float(w.y & 0xffff0000u)};
                            const f32x4 p1 = {__uint_as_float(w.z << 16), __uint_as_float(w.z & 0xffff0000u), __uint_as_float(w.w << 16), __uint_as_float(w.w & 0xffff0000u)};
#pragma unroll
                            for (int e = 0; e < 4; ++e) { v0[e] = p0[e] / (1.f + __expf(-v0[e] * rs[mm])); v1[e] = p1[e] / (1.f + __expf(-v1[e] * rs[mm])); } }
                        const f32x4 h0 = bv[mm][bj][0] + v0, h1 = bv[mm][bj][1] + v1;
                        if (out) { *(f32x4*)(out + ro + c) = h0; *(f32x4*)(out + ro + c + 4) = h1; }
                        if (hb) { u32x4 w2; w2.x = cvt_pk_bf16(h0[0], h0[1]); w2.y = cvt_pk_bf16(h0[2], h0[3]); w2.z = cvt_pk_bf16(h1[0], h1[1]); w2.w = cvt_pk_bf16(h1[2], h1[3]); *(u32x4*)(hb + ro + c) = w2;
                            const float r0 = __uint_as_float(w2.x << 16), r1 = __uint_as_float(w2.x & 0xffff0000u), r2 = __uint_as_float(w2.y << 16), r3 = __uint_as_float(w2.y & 0xffff0000u);
                            const float r4 = __uint_as_float(w2.z << 16), r5 = __uint_as_float(w2.z & 0xffff0000u), r6 = __uint_as_float(w2.w << 16), r7 = __uint_as_float(w2.w & 0xffff0000u);
                            sq += ((r0 * r0 + r1 * r1) + (r2 * r2 + r3 * r3)) + ((r4 * r4 + r5 * r5) + (r6 * r6 + r7 * r7)); } }
                    sq += __shfl_xor(sq, 16); sq += __shfl_xor(sq, 32); sqv[ai * 4 + m] = __float2uint_rn(sq * 1024.f);
                }
            }
        if (ss_out) {
#pragma unroll
            for (int j = 0; j < 2; ++j) { const unsigned v = fq == 0 ? sqv[4 * j] : (fq == 1 ? sqv[4 * j + 1] : (fq == 2 ? sqv[4 * j + 2] : sqv[4 * j + 3]));
                atomicAdd(ss_out + row0 + j * HALF + fq * 16, v); }
        }
    }
};
}
using pg8::bf16_t; using pg8::bf16x8; using pg8::f32x4; using pg8::u32x4;
typedef float f32x16 __attribute__((ext_vector_type(16)));
typedef short s16x4 __attribute__((ext_vector_type(4)));
typedef unsigned u32x2 __attribute__((ext_vector_type(2)));
#define LAS __attribute__((address_space(3)))
constexpr int NB = 2, S = 4096, T = NB * S, D = 2048, FF = 8192, NH = 16, HD = 128;
constexpr int NQ_LD = 5376, MQ_LD = 6144;
constexpr float EPS = 1e-6f;
constexpr size_t MiB = 1u << 20;
constexpr size_t WS_W1T = 0, WS_W2T = 128 * MiB, WS_PGT = 256 * MiB, WS_PPT = 288 * MiB, WS_MQKV = 292 * MiB, WS_MWO = 316 * MiB, WS_POOL = 324 * MiB,
                 WS_NQKV = 326 * MiB, WS_NWO = 347 * MiB, WS_CW1 = 355 * MiB, WS_CIN = 357 * MiB, WS_CWO = 381 * MiB, WS_PB = 389 * MiB, WS_XN = 405 * MiB,
                 WS_OB = 437 * MiB, WS_PP = 469 * MiB, WS_BIG = 501 * MiB, WS_KMEAN = 629 * MiB, WS_KC = 630 * MiB, WS_VC = 631 * MiB, WS_CTL = 632 * MiB, WS_SS = 632 * MiB + 65536, WS_HB1 = 633 * MiB, WS_SSP = 665 * MiB, WS_END = 678 * MiB;
constexpr int LDS_BYTES = 155648;
constexpr int NWAVES = 8, NTHREADS = 512;

struct Params { const void* in[29]; float* out; unsigned char* ws; };

__device__ __forceinline__ float bflo(unsigned w) { return __uint_as_float(w << 16); }
__device__ __forceinline__ float bfhi(unsigned w) { return __uint_as_float(w & 0xffff0000u); }
__device__ __forceinline__ float bf1(bf16_t b) { return __uint_as_float((unsigned)b << 16); }
__device__ __forceinline__ unsigned pk2(float lo, float hi) { return pg8::cvt_pk_bf16(lo, hi); }
__device__ __forceinline__ bf16_t f2bf1(float f) { return (bf16_t)(pk2(f, 0.f) & 0xffffu); }
__device__ __forceinline__ float wave_sum(float v) {
#pragma unroll
    for (int o = 1; o < 64; o <<= 1) v += __shfl_xor(v, o);
    return v;
}
__device__ __forceinline__ bf16x8 pack8(f32x4 a, f32x4 b) { u32x4 w = {pk2(a[0], a[1]), pk2(a[2], a[3]), pk2(b[0], b[1]), pk2(b[2], b[3])}; return __builtin_bit_cast(bf16x8, w); }
__device__ __forceinline__ float sigmoidf_(float x) { return 1.f / (1.f + __expf(-x)); }

struct CJob { const float* W; bf16_t* WT; const float* gain; int K, N, row_off, item; };
__device__ __forceinline__ void tr_load(const CJob& J, int lane, float (&tv)[32]) {
    const int nblk = J.N / 32, kb = J.item / nblk, nb = J.item % nblk, k0 = 64 * kb, n0 = 32 * nb;
#pragma unroll
    for (int i = 0; i < 32; ++i) { const int kk = 2 * i + (lane >> 5); tv[i] = __builtin_nontemporal_load(J.W + (size_t)(k0 + kk) * J.N + n0 + (lane & 31)); }
}
__device__ __forceinline__ void tr_store(const CJob& J, int lane, const float (&tv)[32], float* scr) {
    const int nblk = J.N / 32, kb = J.item / nblk, nb = J.item % nblk, k0 = 64 * kb, n0 = 32 * nb;
#pragma unroll
    for (int i = 0; i < 32; ++i) { const int kk = 2 * i + (lane >> 5); scr[kk * 33 + (lane & 31)] = J.gain ? tv[i] * J.gain[k0 + kk] : tv[i]; }
    asm volatile("s_waitcnt lgkmcnt(0)" ::: "memory");
    const int c = lane & 7;
#pragma unroll
    for (int j = 0; j < 4; ++j) { const int n = (lane >> 3) + 8 * j; const float* s = scr + (8 * c) * 33 + n;
        u32x4 o; o.x = pk2(s[0 * 33], s[1 * 33]); o.y = pk2(s[2 * 33], s[3 * 33]); o.z = pk2(s[4 * 33], s[5 * 33]); o.w = pk2(s[6 * 33], s[7 * 33]);
        *(u32x4*)(J.WT + (size_t)(J.row_off + n0 + n) * J.K + k0 + 8 * c) = o; }
    asm volatile("s_waitcnt lgkmcnt(0)" ::: "memory");
}
#define CJOB(src, Kk, Nn, dst, roff, gn) if (!found) { const int ni_ = ((Kk) / 64) * ((Nn) / 32); if (r < ni_) { J.W = (const float*)(src); J.WT = (bf16_t*)(dst); J.gain = (const float*)(gn); J.K = (Kk); J.N = (Nn); J.row_off = (roff); J.item = r; found = true; } else r -= ni_; }
#define CJOB_LAYER(i) CJOB((const float*)P.in[5] + (size_t)(i) * D * FF, D, FF, ws + WS_W1T + (size_t)(i) * 32 * MiB, 0, (const float*)P.in[4] + (size_t)(i) * D) \
                      CJOB((const float*)P.in[6] + (size_t)(i) * D * FF, FF, D, ws + WS_W2T + (size_t)(i) * 32 * MiB, 0, nullptr) \
                      CJOB((const float*)P.in[8] + (size_t)(i) * D * D, D, D, ws + WS_PGT + (size_t)(i) * 8 * MiB, 0, (const float*)P.in[7] + (size_t)(i) * D) \
                      CJOB((const float*)P.in[9] + (size_t)(i) * 256 * D, 256, D, ws + WS_PPT + (size_t)(i) * 1 * MiB, 0, nullptr)
constexpr int NITEMS_CONV = 4 * (8192 + 8192 + 2048 + 256) + 6144 + 2048 + 4 * 128 + 2048 + 3072 + 2048 + 2 * 256 + 6144 + 2048;
__device__ __forceinline__ CJob conv_resolve(const Params& P, int it) {
    unsigned char* ws = P.ws; CJob J; J.W = nullptr; J.WT = nullptr; J.gain = nullptr; J.K = 64; J.N = 32; J.row_off = 0; J.item = 0;
    int r = it; bool found = false;
    CJOB_LAYER(0) CJOB_LAYER(1) CJOB_LAYER(2) CJOB_LAYER(3)
    CJOB(P.in[10], D, 3 * D, ws + WS_MQKV, 0, (const float*)P.in[3])
    CJOB(P.in[13], D, D, ws + WS_MWO, 0, nullptr)
    CJOB((const float*)P.in[14] + 0 * 512 * 512, 512, 512, ws + WS_POOL + 0 * 512 * 512 * 2, 0, nullptr)
    CJOB((const float*)P.in[14] + 1 * 512 * 512, 512, 512, ws + WS_POOL + 1 * 512 * 512 * 2, 0, nullptr)
    CJOB((const float*)P.in[14] + 2 * 512 * 512, 512, 512, ws + WS_POOL + 2 * 512 * 512 * 2, 0, nullptr)
    CJOB((const float*)P.in[14] + 3 * 512 * 512, 512, 512, ws + WS_POOL + 3 * 512 * 512 * 2, 0, nullptr)
    CJOB(P.in[16], D, D, ws + WS_NQKV, 0, (const float*)P.in[3] + 2 * D)
    CJOB(P.in[17], D, 3072, ws + WS_NQKV, 2048, (const float*)P.in[3] + 2 * D)
    CJOB(P.in[24], D, D, ws + WS_NWO, 0, nullptr)
    CJOB((const float*)P.in[21] + 0 * 4096 * 128, 4096, 128, ws + WS_CW1 + 0 * 128 * 4096 * 2, 0, nullptr)
    CJOB((const float*)P.in[21] + 1 * 4096 * 128, 4096, 128, ws + WS_CW1 + 1 * 128 * 4096 * 2, 0, nullptr)
    CJOB(P.in[25], D, 3 * D, ws + WS_CIN, 0, (const float*)P.in[3] + 3 * D)
    CJOB(P.in[28], D, D, ws + WS_CWO, 0, nullptr)
    return J;
}
__device__ __forceinline__ void phase_convert(const Params& P, char* lds, int gw, int NGW, int gtid, int NT, int wid, int lane) {
    asm volatile("" : "+v"(lane));
    unsigned char* ws = P.ws;
    float* scr = (float*)(lds + wid * 17408);
    for (int it = 2 * gw; it < NITEMS_CONV; it += 2 * NGW) {
        const CJob J0 = conv_resolve(P, it); const bool two = (it + 1 < NITEMS_CONV); const CJob J1 = conv_resolve(P, two ? it + 1 : it);
        float tv0[32], tv1[32];
        tr_load(J0, lane, tv0); tr_load(J1, lane, tv1);
        tr_store(J0, lane, tv0, scr);
        if (two) tr_store(J1, lane, tv1, scr);
    }
    { const float* Wg = (const float*)P.in[23]; bf16_t* dst = (bf16_t*)(ws + WS_NQKV) + (size_t)5120 * D;
      for (int idx = gtid; idx < 256 * D; idx += NT) { const int n = idx >> 11, k = idx & 2047; dst[idx] = (n < 48) ? f2bf1(Wg[(size_t)k * 48 + n] * ((const float*)P.in[3])[2 * D + k]) : (bf16_t)0; } }
    { const float* x = (const float*)P.in[0]; bf16_t* hb = (bf16_t*)(ws + WS_XN); unsigned* ss0 = (unsigned*)(ws + WS_SS);
      for (int m = gw; m < T; m += NGW) {
          const f32x4* xr = (const f32x4*)(x + (size_t)m * D) + lane; u32x2* o8 = (u32x2*)(hb + (size_t)m * D) + lane; float s = 0.f;
#pragma unroll
          for (int j = 0; j < 8; ++j) { const f32x4 v = xr[64 * j]; s += (v[0] * v[0] + v[1] * v[1]) + (v[2] * v[2] + v[3] * v[3]); u32x2 o; o.x = pk2(v[0], v[1]); o.y = pk2(v[2], v[3]); o8[64 * j] = o; }
          s = wave_sum(s); if (lane == 0) ss0[m] = __float2uint_rn(s * 1024.f); } }
    { const f32x4* ps = (const f32x4*)P.in[1]; u32x2* pd = (u32x2*)(ws + WS_PB);
      for (int idx = gtid; idx < 4 * T * 256 / 4; idx += NT) { const f32x4 v = ps[idx]; u32x2 o; o.x = pk2(v[0], v[1]); o.y = pk2(v[2], v[3]); pd[idx] = o; } }
}

__device__ __forceinline__ void phase_rms(const float* src, const float* gain, bf16_t* dst, int gw, int NGW, int lane) {
    asm volatile("" : "+v"(lane));
    for (int m = gw; m < T; m += NGW) {
        const f32x4* xr = (const f32x4*)(src + (size_t)m * D) + lane;
        f32x4 v[8]; float s = 0.f;
#pragma unroll
        for (int j = 0; j < 8; ++j) { v[j] = xr[64 * j]; s += (v[j][0] * v[j][0] + v[j][1] * v[j][1]) + (v[j][2] * v[j][2] + v[j][3] * v[j][3]); }
        const float rstd = 1.0f / sqrtf(wave_sum(s) * (1.f / D) + EPS);
        u32x2* o8 = (u32x2*)(dst + (size_t)m * D) + lane;
#pragma unroll
        for (int j = 0; j < 8; ++j) { const f32x4 g = ((const f32x4*)gain)[lane + 64 * j]; u32x2 o; o.x = pk2(v[j][0] * rstd * g[0], v[j][1] * rstd * g[1]); o.y = pk2(v[j][2] * rstd * g[2], v[j][3] * rstd * g[3]); o8[64 * j] = o; }
    }
}

template <class Epi>
__device__ __forceinline__ void gemm_run(char* lds, const bf16_t* A, int lda, const bf16_t* Bt, int ldb, int M, int N, int K, int G, int c, const Epi& E) {
    pg8::Gemm g{A, Bt, M, N, K, lda, ldb}; pg8::StaticOrder So; So.init(M, N, G, c);
    pg8::gemm_phase<Epi, pg8::StaticOrder, true, true>((PG8_LAS unsigned char*)lds, g, So, E);
}

__device__ __forceinline__ void rope_cs(int pos, int lane, float (&cs)[2], float (&sn)[2]) {
#pragma unroll
    for (int e = 0; e < 2; ++e) {
        const int i = 2 * (lane & 7) + e;
        const float freq = __builtin_amdgcn_exp2f(-(float)i * (18.931568569324174f / 16.0f));
        const float ang = (float)pos * freq;
        const double rev = (double)ang * 0.15915494309189535;
        const float fr = (float)(rev - floor(rev));
        cs[e] = __builtin_amdgcn_cosf(fr); sn[e] = __builtin_amdgcn_sinf(fr);
    }
}
__device__ __forceinline__ void head_norm_rope(unsigned w, const float* gain, int lane, const float (&cs)[2], const float (&sn)[2], float& n0, float& n1, float& r0, float& r1) {
    const float x0 = bflo(w), x1 = bfhi(w);
    const float ss = wave_sum(x0 * x0 + x1 * x1);
    const float rstd = 1.0f / sqrtf(ss * (1.f / HD) + EPS);
    n0 = x0 * rstd * gain[2 * lane]; n1 = x1 * rstd * gain[2 * lane + 1];
    const float p0 = __shfl_xor(n0, 8), p1 = __shfl_xor(n1, 8);
    r0 = n0; r1 = n1;
    if (lane < 8) { r0 = n0 * cs[0] - p0 * sn[0]; r1 = n1 * cs[1] - p1 * sn[1]; }
    else if (lane < 16) { r0 = n0 * cs[0] + p0 * sn[0]; r1 = n1 * cs[1] + p1 * sn[1]; }
}
__device__ __forceinline__ void phase_moba_prep(const Params& P, char* lds, int bid, int G, int tid, int wid, int lane) {
    asm volatile("" : "+v"(tid)); asm volatile("" : "+v"(lane));
    bf16_t* BIG = (bf16_t*)(P.ws + WS_BIG); float* KMEAN = (float*)(P.ws + WS_KMEAN);
    const int* pos = (const int*)P.in[2]; const float* qg = (const float*)P.in[11]; const float* kg = (const float*)P.in[12];
    float* red = (float*)(lds);
    const int sub = lane & 15, grp = lane >> 4;
    float qg8[8], kg8[8];
#pragma unroll
    for (int j = 0; j < 8; ++j) { qg8[j] = qg[8 * sub + j]; kg8[j] = kg[8 * sub + j]; }
    for (int u = bid; u < NB * 16 * NH; u += G) {
        const int h = u & 15, blk = (u >> 4) & 15, b = u >> 8;
        float ks[8];
#pragma unroll
        for (int j = 0; j < 8; ++j) ks[j] = 0.f;
        u32x4 qv[8], kv[8];
#pragma unroll
        for (int it = 0; it < 8; ++it) { const size_t row = (size_t)(b * S + blk * 256 + wid * 32 + it * 4 + grp);
            qv[it] = *(const u32x4*)(BIG + row * MQ_LD + h * HD + 8 * sub); kv[it] = *(const u32x4*)(BIG + row * MQ_LD + D + h * HD + 8 * sub); }
#pragma unroll
        for (int it = 0; it < 8; ++it) {
            const size_t row = (size_t)(b * S + blk * 256 + wid * 32 + it * 4 + grp);
            const int ps = pos[row];
            float cs[8], sn[8];
#pragma unroll
            for (int j = 0; j < 8; ++j) { const int i_ = 8 * (sub & 1) + j;
                const float freq = __builtin_amdgcn_exp2f(-(float)i_ * (18.931568569324174f / 16.0f));
                const float ang = (float)ps * freq; const double rev = (double)ang * 0.15915494309189535; const float fr_ = (float)(rev - floor(rev));
                cs[j] = __builtin_amdgcn_cosf(fr_); sn[j] = __builtin_amdgcn_sinf(fr_); }
#pragma unroll
            for (int which = 0; which < 2; ++which) {
                const u32x4 w = which ? kv[it] : qv[it];
                float x[8] = {bflo(w.x), bfhi(w.x), bflo(w.y), bfhi(w.y), bflo(w.z), bfhi(w.z), bflo(w.w), bfhi(w.w)};
                float ss = 0.f;
#pragma unroll
                for (int j = 0; j < 8; ++j) ss += x[j] * x[j];
                ss += __shfl_xor(ss, 1); ss += __shfl_xor(ss, 2); ss += __shfl_xor(ss, 4); ss += __shfl_xor(ss, 8);
                const float rstd = 1.0f / sqrtf(ss * (1.f / HD) + EPS);
                float y[8];
#pragma unroll
                for (int j = 0; j < 8; ++j) { y[j] = x[j] * rstd * (which ? kg8[j] : qg8[j]);
                    const float pr = __shfl_xor(y[j], 2);
                    const float rot = (sub < 2) ? (y[j] * cs[j] - pr * sn[j]) : (y[j] * cs[j] + pr * sn[j]);
                    y[j] = (sub < 4) ? rot : y[j]; }
                u32x4 ow = {pk2(y[0], y[1]), pk2(y[2], y[3]), pk2(y[4], y[5]), pk2(y[6], y[7])};
                *(u32x4*)(BIG + row * MQ_LD + (which ? D : 0) + h * HD + 8 * sub) = ow;
                if (which) {
#pragma unroll
                    for (int j = 0; j < 8; ++j) ks[j] += y[j]; }
            }
        }
#pragma unroll
        for (int j = 0; j < 8; ++j) { ks[j] += __shfl_xor(ks[j], 16); ks[j] += __shfl_xor(ks[j], 32); }
        if (grp == 0) {
#pragma unroll
            for (int j = 0; j < 8; ++j) red[wid * 128 + 8 * sub + j] = ks[j]; }
        __syncthreads();
        if (tid < 128) { float sm = 0.f;
#pragma unroll
            for (int w = 0; w < 8; ++w) sm += red[w * 128 + tid];
            KMEAN[(size_t)((b * NH + h) * 16 + blk) * HD + tid] = sm * (1.f / 256.f); }
        __syncthreads();
    }
}

__device__ __forceinline__ void phase_nsa_norm(const Params& P, int gw, int NGW, int lane) {
    asm volatile("" : "+v"(lane));
    bf16_t* BIG = (bf16_t*)(P.ws + WS_BIG); bf16_t* QROT = (bf16_t*)(P.ws + WS_PP);
    const int* pos = (const int*)P.in[2]; const float* qg = (const float*)P.in[18]; const float* kg = (const float*)P.in[19];
    for (int row = gw; row < T; row += NGW) {
        float cs[2], sn[2]; rope_cs(pos[row], lane, cs, sn);
        bf16_t* base = BIG + (size_t)row * NQ_LD;
        unsigned qv[16], k1v[4], k2v[4];
#pragma unroll
        for (int hh = 0; hh < NH; ++hh) qv[hh] = *((const unsigned*)(base + hh * HD) + lane);
#pragma unroll
        for (int g = 0; g < 4; ++g) { k1v[g] = *((const unsigned*)(base + D + 2 * 512 + g * HD) + lane); k2v[g] = *((const unsigned*)(base + D + 4 * 512 + g * HD) + lane); }
#pragma unroll
        for (int hh = 0; hh < NH; ++hh) {
            unsigned* qp = (unsigned*)(base + hh * HD) + lane; float n0, n1, r0, r1;
            head_norm_rope(qv[hh], qg, lane, cs, sn, n0, n1, r0, r1);
            *qp = pk2(n0, n1);
        }
#pragma unroll
        for (int g = 0; g < 4; ++g) {
            unsigned* kp = (unsigned*)(base + D + 2 * 512 + g * HD) + lane; float n0, n1, r0, r1;
            head_norm_rope(k1v[g], kg + 1 * HD, lane, cs, sn, n0, n1, r0, r1); *kp = pk2(r0, r1);
            unsigned* kq = (unsigned*)(base + D + 4 * 512 + g * HD) + lane;
            head_norm_rope(k2v[g], kg + 2 * HD, lane, cs, sn, n0, n1, r0, r1); *kq = pk2(r0, r1);
        }
    }
}

__device__ __forceinline__ void phase_nsa_compress(const Params& P, char* lds, int bid, int G, int tid, int wid, int lane) {
    asm volatile("" : "+v"(tid)); asm volatile("" : "+v"(lane));
    const bf16_t* BIG = (const bf16_t*)(P.ws + WS_BIG); const bf16_t* CW1 = (const bf16_t*)(P.ws + WS_CW1);
    const float* cpos = (const float*)P.in[20]; const float* w2 = (const float*)P.in[22]; const float* kg0 = (const float*)P.in[19];
    float* red = (float*)lds;
    float* h1s = (float*)(lds + 65536);
    const int fr = lane & 15, fq = lane >> 4;
    for (int u = bid; u < 256; u += G) {
        const int ng = u & 15, j = (u >> 4) & 1, g = (u >> 5) & 3, b = u >> 7;
        const int n = 16 * ng + fr;
        f32x4 acc[8];
#pragma unroll
        for (int i = 0; i < 8; ++i) acc[i] = (f32x4){0.f, 0.f, 0.f, 0.f};
        for (int l = 4 * wid; l < 4 * wid + 4; ++l) {
            int tokl = 16 * n + l; tokl = tokl > S - 1 ? S - 1 : tokl;
            const bf16_t* rowp = BIG + (size_t)(b * S + tokl) * NQ_LD + D + j * 512 + g * HD;
            const float* pp = cpos + (size_t)(j * 32 + l) * HD;
#pragma unroll
            for (int dd = 0; dd < 4; ++dd) {
                const int d = dd * 32 + 8 * fq;
                const u32x4 raw = *(const u32x4*)(rowp + d);
                const f32x4 pa = *(const f32x4*)(pp + d), pb = *(const f32x4*)(pp + d + 4);
                f32x4 a0 = {bflo(raw.x) + pa[0], bfhi(raw.x) + pa[1], bflo(raw.y) + pa[2], bfhi(raw.y) + pa[3]};
                f32x4 a1 = {bflo(raw.z) + pb[0], bfhi(raw.z) + pb[1], bflo(raw.w) + pb[2], bfhi(raw.w) + pb[3]};
                const bf16x8 Af = pack8(a0, a1);
                const int k0 = l * HD + dd * 32 + 8 * fq;
#pragma unroll
                for (int ns = 0; ns < 8; ++ns) {
                    const bf16x8 Bw = *(const bf16x8*)(CW1 + (size_t)(j * 128 + ns * 16 + fr) * 4096 + k0);
                    acc[ns] = __builtin_amdgcn_mfma_f32_16x16x32_bf16(Bw, Af, acc[ns], 0, 0, 0);
                }
            }
        }
#pragma unroll
        for (int ns = 0; ns < 8; ++ns) *(f32x4*)(red + (size_t)(wid * 16 + fr) * 128 + ns * 16 + 4 * fq) = acc[ns];
        __syncthreads();
        const int m = tid >> 5, c4 = (tid & 31) * 4;
        { f32x4 s = {0.f, 0.f, 0.f, 0.f};
#pragma unroll
          for (int w = 0; w < 8; ++w) s = s + *(const f32x4*)(red + (size_t)(w * 16 + m) * 128 + c4);
#pragma unroll
          for (int e = 0; e < 4; ++e) { const float x = s[e]; const float uu = 0.7978845608028654f * (x + 0.044715f * x * x * x); const float th = 1.f - 2.f / (__expf(2.f * uu) + 1.f); s[e] = 0.5f * x * (1.f + th); }
          *(f32x4*)(h1s + m * 128 + c4) = s; }
        __syncthreads();
        f32x4 o = {0.f, 0.f, 0.f, 0.f};
        const float* w2j = w2 + (size_t)j * 128 * 128 + c4;
#pragma unroll 16
        for (int k = 0; k < 128; ++k) { const float hv = h1s[m * 128 + k]; const f32x4 wv = *(const f32x4*)(w2j + (size_t)k * 128); o = o + wv * hv; }
        if (j == 0) {
            float ss = (o[0] * o[0] + o[1] * o[1]) + (o[2] * o[2] + o[3] * o[3]);
#pragma unroll
            for (int sh = 1; sh < 32; sh <<= 1) ss += __shfl_xor(ss, sh);
            const float rstd = 1.0f / sqrtf(ss * (1.f / HD) + EPS);
            const f32x4 gn = *(const f32x4*)(kg0 + c4);
            o = o * rstd * gn;
        }
        const int nn = 16 * ng + m;
        if (nn >= 255) o = (f32x4){0.f, 0.f, 0.f, 0.f};
        bf16_t* dst = (bf16_t*)(P.ws + (j == 0 ? WS_KC : WS_VC)) + (size_t)((b * 4 + g) * 256 + nn) * HD + c4;
        u32x2 ow; ow.x = pk2(o[0], o[1]); ow.y = pk2(o[2], o[3]); *(u32x2*)dst = ow;
        __syncthreads();
    }
}

__device__ __forceinline__ f32x4 ld4bf(const bf16_t* p) { const u32x2 w = *(const u32x2*)p; return (f32x4){bflo(w.x), bfhi(w.x), bflo(w.y), bfhi(w.y)}; }
__device__ __forceinline__ void phase_pool_prep(const bf16_t* hsrc, const unsigned* ssq, const float* gain, bf16_t* OB, char* lds, int bid, int G, int tid, int wid, int lane) {
    asm volatile("" : "+v"(tid)); asm volatile("" : "+v"(lane));
    float* rs = (float*)lds;
    for (int u = bid; u < T / 32; u += G) {
        const int b = u / (S / 32), s0 = (u % (S / 32)) * 32;
        if (tid < 47) { const int s = s0 - 15 + tid; rs[tid] = (s >= 0) ? 1.0f / sqrtf((float)ssq[b * S + s] * (1.f / (1024.f * 2048.f)) + EPS) : 0.f; }
        __syncthreads();
        const int col = tid * 4, w = 2 << (tid >> 7);
        const f32x4 gn = *(const f32x4*)(gain + col);
        for (int rr = 0; rr < 32; ++rr) {
            const int s = s0 + rr; const int lo = (s + 1 - w) > 0 ? (s + 1 - w) : 0; const float inv = 1.0f / (float)(s + 1 - lo);
            f32x4 a = {0.f, 0.f, 0.f, 0.f};
            for (int sp = lo; sp <= s; ++sp) a = a + ld4bf(hsrc + (size_t)(b * S + sp) * D + col) * rs[sp - s0 + 15];
            const f32x4 xs = ld4bf(hsrc + (size_t)(b * S + s) * D + col) * rs[rr + 15];
            const f32x4 dv = (a * inv - xs) * gn;
            u32x2 ow; ow.x = pk2(dv[0], dv[1]); ow.y = pk2(dv[2], dv[3]);
            *(u32x2*)(OB + (size_t)(b * S + s) * D + col) = ow;
        }
        __syncthreads();
    }
}

__device__ __forceinline__ void phase_conv_elem(const Params& P, int gtid, int NT) {
    asm volatile("" : "+v"(gtid));
    const bf16_t* BIG = (const bf16_t*)(P.ws + WS_BIG); bf16_t* OB = (bf16_t*)(P.ws + WS_OB);
    const float* cw = (const float*)P.in[26]; const float* cb = (const float*)P.in[27];
    for (int it = gtid; it < T * 256; it += NT) {
        const int row = it >> 8, c8 = (it & 255) * 8, s = row & (S - 1);
        const bf16_t* base = BIG + (size_t)row * MQ_LD + c8;
        float u[3][8];
#pragma unroll
        for (int j = 0; j < 3; ++j) {
            const int back = 2 - j;
            if (s >= back) { const u32x4 cw4 = *(const u32x4*)(base - (size_t)back * MQ_LD + D), hw4 = *(const u32x4*)(base - (size_t)back * MQ_LD + 2 * D);
                u[j][0] = bflo(cw4.x) * bflo(hw4.x); u[j][1] = bfhi(cw4.x) * bfhi(hw4.x); u[j][2] = bflo(cw4.y) * bflo(hw4.y); u[j][3] = bfhi(cw4.y) * bfhi(hw4.y);
                u[j][4] = bflo(cw4.z) * bflo(hw4.z); u[j][5] = bfhi(cw4.z) * bfhi(hw4.z); u[j][6] = bflo(cw4.w) * bflo(hw4.w); u[j][7] = bfhi(cw4.w) * bfhi(hw4.w); }
            else {
#pragma unroll
                for (int e = 0; e < 8; ++e) u[j][e] = 0.f; }
        }
        const u32x4 bw4 = *(const u32x4*)base;
        float bv[8] = {bflo(bw4.x), bfhi(bw4.x), bflo(bw4.y), bfhi(bw4.y), bflo(bw4.z), bfhi(bw4.z), bflo(bw4.w), bfhi(bw4.w)};
        float y[8];
#pragma unroll
        for (int e = 0; e < 8; ++e) { const int c = c8 + e; y[e] = bv[e] * (cw[c] * u[0][e] + cw[D + c] * u[1][e] + cw[2 * D + c] * u[2][e] + cb[c]); }
        u32x4 ow = {pk2(y[0], y[1]), pk2(y[2], y[3]), pk2(y[4], y[5]), pk2(y[6], y[7])};
        *(u32x4*)(OB + (size_t)row * D + c8) = ow;
    }
}
namespace at {
constexpr float SCALE = 0.08838834764831845f;
constexpr float C2 = 1.4426950408889634f * SCALE;
constexpr int OFF_V = 0, OFF_K = 16384, KVBUF = 32768  , OFF_WS = 65536, OFF_IMP = 67584, OFF_SELM = 83968, OFF_Q = 86016;
#define KSWZ(row, colB) ((row) * 256 + ((colB) ^ (((row) & 7) << 4)))
#define SBAR() __builtin_amdgcn_sched_barrier(0)
__device__ __forceinline__ int v_st(int k, int c) { const int kk = (k & ~0xC) | ((k & 4) << 1) | ((k & 8) >> 1); return ((kk >> 3) * 4 + (c >> 5)) * 512 + ((kk & 7) * 32 + (c & 31)) * 2; }
__device__ __forceinline__ int v_rd_base(int lane) { return ((lane & 3) << 3) | (((lane >> 2) & 3) << 6) | (((lane >> 4) & 1) << 5) | (((lane >> 5) & 1) << 8); }
constexpr int v_rd_off(int d0, int ks, int half) { return d0 * 512 + ks * 4096 + half * 2048; }
__device__ __forceinline__ int crow(int r, int hi) { return (r & 3) + 8 * (r >> 2) + 4 * hi; }
__device__ __forceinline__ unsigned cvtpk(float lo, float hi) { unsigned r; asm volatile("v_cvt_pk_bf16_f32 %0, %1, %2" : "=v"(r) : "v"(lo), "v"(hi)); return r; }

__device__ __forceinline__ void mask_tile(f32x16& p0, f32x16& p1, int dq, unsigned W, bool rowok) {
    const float NEG = -__builtin_inff();
#pragma unroll
    for (int r = 0; r < 16; ++r) {
        const int c = (r & 3) + 8 * (r >> 2);
        if (!rowok || (unsigned)(dq - c) >= W) p0[r] = NEG;
        if (!rowok || (unsigned)(dq - c - 32) >= W) p1[r] = NEG;
    }
}
__device__ __forceinline__ float rowmax32(const f32x16& p0, const f32x16& p1) {
    float pmax = p0[0];
#pragma unroll
    for (int r = 1; r < 16; ++r) pmax = fmaxf(pmax, p0[r]);
#pragma unroll
    for (int r = 0; r < 16; ++r) pmax = fmaxf(pmax, p1[r]);
    auto rr = __builtin_amdgcn_permlane32_swap(__float_as_uint(pmax), __float_as_uint(pmax), false, false);
    return fmaxf(__uint_as_float(rr[0]), __uint_as_float(rr[1]));
}
__device__ __forceinline__ float rowsum32(const f32x16& p0, const f32x16& p1) {
    float ps = 0.f;
#pragma unroll
    for (int r = 0; r < 16; ++r) ps += p0[r];
#pragma unroll
    for (int r = 0; r < 16; ++r) ps += p1[r];
    auto rr = __builtin_amdgcn_permlane32_swap(__float_as_uint(ps), __float_as_uint(ps), false, false);
    return __uint_as_float(rr[0]) + __uint_as_float(rr[1]);
}
__device__ __forceinline__ void pack_p(const f32x16& p0, const f32x16& p1, bf16x8& pa0, bf16x8& pa1, bf16x8& pa2, bf16x8& pa3) {
#define PK4(P, B_, OUT) do { unsigned a0 = cvtpk(P[B_+0], P[B_+1]), a1 = cvtpk(P[B_+2], P[B_+3]);                          \
        unsigned b0 = cvtpk(P[B_+4], P[B_+5]), b1 = cvtpk(P[B_+6], P[B_+7]);                                             \
        auto r0 = __builtin_amdgcn_permlane32_swap(a0, b0, false, false); auto r1 = __builtin_amdgcn_permlane32_swap(a1, b1, false, false); \
        u32x4 w = {r0[0], r1[0], r0[1], r1[1]}; OUT = *reinterpret_cast<bf16x8*>(&w); } while (0)
    PK4(p0, 0, pa0); PK4(p0, 8, pa1); PK4(p1, 0, pa2); PK4(p1, 8, pa3);
#undef PK4
}
__device__ __forceinline__ void qkt(f32x16& p0, f32x16& p1, const char* K_lds, int r32, int hi, const char* Qw) {
    p0 = f32x16{}; p1 = f32x16{};
    int ko[4];
#pragma unroll
    for (int dd = 0; dd < 4; ++dd) ko[dd] = KSWZ(r32, (dd * 16 + hi * 8) * 2);
#pragma unroll
    for (int d0 = 0; d0 < 8; ++d0) { const int off = ko[d0 & 3] + (d0 >> 2) * 128; const char* a = K_lds + off;
        bf16x8 b0 = *reinterpret_cast<const bf16x8*>(a);
        bf16x8 b1 = *reinterpret_cast<const bf16x8*>(a + 32 * 256);
        bf16x8 q = *reinterpret_cast<const bf16x8*>(Qw + off);
        p0 = __builtin_amdgcn_mfma_f32_32x32x16_bf16(b0, q, p0, 0, 0, 0);
        p1 = __builtin_amdgcn_mfma_f32_32x32x16_bf16(b1, q, p1, 0, 0, 0); }
}
__device__ __forceinline__ void q_park(char* Qw, int r32, int hi, int d0, bf16x8 v) { *(bf16x8*)(Qw + KSWZ(r32, (d0 * 16 + hi * 8) * 2)) = v; }
__device__ __forceinline__ void pv_tile(f32x16 (&o)[4], int vb0, bf16x8 pa0, bf16x8 pa1, bf16x8 pa2, bf16x8 pa3) {
#define TRRD(dst, off) asm volatile("ds_read_b64_tr_b16 %0, %1 offset:%2" : "=&v"(dst) : "v"(vb0), "i"(off) : "memory")
#define PV_RD(S_, d0) do { constexpr int b_ = v_rd_off(d0, 0, 0); \
        TRRD(S_##l0, b_); TRRD(S_##h0, b_ + 2048); TRRD(S_##l1, b_ + 4096); TRRD(S_##h1, b_ + 6144); TRRD(S_##l2, b_ + 8192); TRRD(S_##h2, b_ + 10240); TRRD(S_##l3, b_ + 12288); TRRD(S_##h3, b_ + 14336); } while (0)
#define PV_MM(S_, d0) do { \
        o[d0] = __builtin_amdgcn_mfma_f32_32x32x16_bf16(pa0, (bf16x8){S_##l0[0], S_##l0[1], S_##l0[2], S_##l0[3], S_##h0[0], S_##h0[1], S_##h0[2], S_##h0[3]}, o[d0], 0, 0, 0);   \
        o[d0] = __builtin_amdgcn_mfma_f32_32x32x16_bf16(pa1, (bf16x8){S_##l1[0], S_##l1[1], S_##l1[2], S_##l1[3], S_##h1[0], S_##h1[1], S_##h1[2], S_##h1[3]}, o[d0], 0, 0, 0);   \
        o[d0] = __builtin_amdgcn_mfma_f32_32x32x16_bf16(pa2, (bf16x8){S_##l2[0], S_##l2[1], S_##l2[2], S_##l2[3], S_##h2[0], S_##h2[1], S_##h2[2], S_##h2[3]}, o[d0], 0, 0, 0);   \
        o[d0] = __builtin_amdgcn_mfma_f32_32x32x16_bf16(pa3, (bf16x8){S_##l3[0], S_##l3[1], S_##l3[2], S_##l3[3], S_##h3[0], S_##h3[1], S_##h3[2], S_##h3[3]}, o[d0], 0, 0, 0); } while (0)
#define LWAIT() do { asm volatile("s_waitcnt lgkmcnt(0)" ::: "memory"); SBAR(); } while (0)
    s16x4 Al0, Al1, Al2, Al3, Ah0, Ah1, Ah2, Ah3, Bl0, Bl1, Bl2, Bl3, Bh0, Bh1, Bh2, Bh3;
    PV_RD(A, 0); LWAIT();
    PV_RD(B, 1); SBAR(); PV_MM(A, 0); LWAIT();
    PV_RD(A, 2); SBAR(); PV_MM(B, 1); LWAIT();
    PV_RD(B, 3); SBAR(); PV_MM(A, 2); LWAIT();
    PV_MM(B, 3);
#undef LWAIT
#undef PV_MM
#undef PV_RD
#undef TRRD
}

template <int MODE>
__device__ __forceinline__ void attn_tiles(f32x16 (&o)[4], float& m_reg, float& l_reg, const char* Qw, const bf16_t* Kb, const bf16_t* Vb, int ldk,
                                           int t_lo, int t_hi, int tpos, unsigned long long sel, int own, float rl, char* lds, int tid, int wid, int lane) {
    asm volatile("" : "+v"(tid)); asm volatile("" : "+v"(lane));
    const int r32 = lane & 31, hi = lane >> 5;
    float* al_l = (float*)(lds + OFF_WS) + wid * 64;
    const int sr = tid >> 4, sc = (tid & 15) * 8;
    const int kws = KSWZ(sr, sc * 2), vst0 = v_st(sr, sc), vst1 = v_st(32 + sr, sc);
    const int vbase = (int)(uintptr_t)(lds + OFF_V) + v_rd_base(lane);
    bf16x8 sk0, sk1, sv0, sv1;
    sk0 = sk1 = sv0 = sv1 = (bf16x8){0, 0, 0, 0, 0, 0, 0, 0};
    float carry = 0.f;
#define LOADT(tt) do { const bf16_t* kp_ = Kb + (size_t)((tt) * 64 + sr) * ldk + sc; sk0 = *(const bf16x8*)kp_; sk1 = *(const bf16x8*)(kp_ + (size_t)32 * ldk); \
        if (MODE != 3) { const bf16_t* vp_ = Vb + (size_t)((tt) * 64 + sr) * ldk + sc; sv0 = *(const bf16x8*)vp_; sv1 = *(const bf16x8*)(vp_ + (size_t)32 * ldk); } } while (0)
#define WRITET(bo) do { *(bf16x8*)(lds + (bo) + OFF_K + kws) = sk0; *(bf16x8*)(lds + (bo) + OFF_K + kws + 32 * 256) = sk1; \
        if (MODE != 3) { *(bf16x8*)(lds + (bo) + OFF_V + vst0) = sv0; *(bf16x8*)(lds + (bo) + OFF_V + vst1) = sv1; } } while (0)
    if (t_lo < t_hi) { LOADT(t_lo); __syncthreads(); WRITET(0); if (t_lo + 1 < t_hi) LOADT(t_lo + 1); __syncthreads(); }
    if (wid >= 4) __builtin_amdgcn_s_setprio(1);
    for (int t = t_lo; t < t_hi; ++t) {
        const int bo = ((t - t_lo) & 1) * KVBUF;
        if (t + 1 < t_hi) { WRITET(bo ^ KVBUF); if (t + 2 < t_hi) LOADT(t + 2); }
        const char* K_lds = lds + bo + OFF_K; const int vb0 = vbase + bo;
        bool rowok = true, needm = true; unsigned Wm = 0x7fffffffu;
        if (MODE == 0) { const int kb = t >> 2; if (kb < own) { rowok = ((sel >> kb) & 1ull) != 0ull; needm = false; } else needm = ((t - 4 * own) * 64 + 63 > 32 * wid); }
        if (MODE == 1) { rowok = ((sel >> t) & 1ull) != 0ull; needm = (t == t_hi - 1); }
        if (MODE == 2) { Wm = 512u; needm = (t == t_hi - 1) || (t == t_hi - 9); }
        bool skipw = (MODE == 0) && ((t >> 2) >= own) && ((t - 4 * own) * 64 > 32 * wid + 31);
        if (MODE == 0 || MODE == 1) skipw = skipw || !__any(rowok);
        if (!skipw) {
        f32x16 p0, p1;
        qkt(p0, p1, K_lds, r32, hi, Qw);
        if (needm) mask_tile(p0, p1, tpos - t * 64 - 4 * hi, Wm, true);
        const float NEGINF = -__builtin_inff();
        if (MODE == 3) {
            const float pmax = rowmax32(p0, p1);
            const float mn = fmaxf(m_reg, pmax); const float alpha = __builtin_amdgcn_exp2f((m_reg - mn) * C2); m_reg = mn;
            const float mnL = -mn * C2;
#pragma unroll
            for (int r = 0; r < 16; ++r) { p0[r] = __builtin_amdgcn_exp2f(fmaf(p0[r], C2, mnL)); p1[r] = __builtin_amdgcn_exp2f(fmaf(p1[r], C2, mnL)); }
            l_reg = l_reg * alpha + rowsum32(p0, p1);
        } else if (MODE == 4) {
            const float mnL = -m_reg * C2;
#pragma unroll
            for (int r = 0; r < 16; ++r) { p0[r] = __builtin_amdgcn_exp2f(fmaf(p0[r], C2, mnL)) * rl; p1[r] = __builtin_amdgcn_exp2f(fmaf(p1[r], C2, mnL)) * rl; }
            float* impA = (float*)(lds + OFF_IMP + wid * 2048);
#pragma unroll
            for (int half = 0; half < 2; ++half)
#pragma unroll
                for (int rr = 0; rr < 4; ++rr) {
                    float a = half ? ((p1[4 * rr] + p1[4 * rr + 1]) + (p1[4 * rr + 2] + p1[4 * rr + 3])) : ((p0[4 * rr] + p0[4 * rr + 1]) + (p0[4 * rr + 2] + p0[4 * rr + 3]));
                    float bl = half ? p1[4 * rr + 3] : p0[4 * rr + 3];
                    a += __shfl_xor(a, 1); a += __shfl_xor(a, 2); bl += __shfl_xor(bl, 1); bl += __shfl_xor(bl, 2);
                    const float other = __shfl_xor(bl, 32);
                    const float add = hi ? other : carry;
                    carry = other;
                    const int j = 16 * t + 8 * half + 2 * rr + hi;
                    if ((r32 & 3) == 0) impA[(r32 >> 2) * 64 + j] = a + add;
                }
            bf16x8 pa0, pa1, pa2, pa3; pack_p(p0, p1, pa0, pa1, pa2, pa3);
            pv_tile(o, vb0, pa0, pa1, pa2, pa3);
        } else {
            float pmax = rowmax32(p0, p1); pmax = rowok ? pmax : NEGINF;
            float mn, alpha;
            if (__all((pmax - m_reg) * SCALE <= 8.f)) { mn = m_reg; alpha = 1.f; }
            else { mn = fmaxf(m_reg, pmax); alpha = __builtin_amdgcn_exp2f((m_reg - mn) * C2); m_reg = mn; }
            const float mnL = rowok ? -mn * C2 : NEGINF;
#pragma unroll
            for (int r = 0; r < 16; ++r) { p0[r] = __builtin_amdgcn_exp2f(fmaf(p0[r], C2, mnL)); p1[r] = __builtin_amdgcn_exp2f(fmaf(p1[r], C2, mnL)); }
            l_reg = l_reg * alpha + rowsum32(p0, p1);
            bf16x8 pa0, pa1, pa2, pa3; pack_p(p0, p1, pa0, pa1, pa2, pa3);
            if (__any(alpha < 1.f)) {
                if (hi == 0) al_l[r32] = alpha;
                asm volatile("s_waitcnt lgkmcnt(0)" ::: "memory");
#pragma unroll
                for (int r = 0; r < 16; ++r) { const float f = al_l[crow(r, hi)];
#pragma unroll
                    for (int d_ = 0; d_ < 4; ++d_) o[d_][r] *= f; }
            }
            pv_tile(o, vb0, pa0, pa1, pa2, pa3);
        }
        }
        __syncthreads();
    }
    __builtin_amdgcn_s_setprio(0);
#undef LOADT
#undef WRITET
}

template <bool NSA, bool ACCUM>
__device__ __forceinline__ void store_o(const f32x16 (&o)[4], float f, bf16_t* OB, size_t rowbase, int tok0, int hbase, char* lds, int wid, int lane) {
    asm volatile("" : "+v"(lane));
    const int r32 = lane & 31, hi = lane >> 5;
    float* li_l = (float*)(lds + OFF_WS) + wid * 64 + 32;
    if (hi == 0) li_l[r32] = f;
    asm volatile("s_waitcnt lgkmcnt(0)" ::: "memory");
#pragma unroll
    for (int r = 0; r < 16; ++r) {
        const int rw = crow(r, hi); const float fr = li_l[rw];
        const int tok = NSA ? tok0 + (rw >> 2) : tok0 + rw, hd = NSA ? hbase + (rw & 3) : hbase;
        bf16_t* op = OB + (rowbase + tok) * D + hd * HD + r32;
#pragma unroll
        for (int d0 = 0; d0 < 4; ++d0) {
            float v = o[d0][r] * fr; float vn = __shfl_xor(v, 1);
            if ((r32 & 1) == 0) { unsigned* wp = (unsigned*)(op + d0 * 32);
                if (ACCUM) { const unsigned old = *wp; v += bflo(old); vn += bfhi(old); }
                *wp = cvtpk(v, vn); }
        }
    }
}
}

__device__ __forceinline__ void moba_unit(const Params& P, int b, int h, int own, char* lds, int tid, int wid, int lane) {
    using namespace at;
    const bf16_t* BIG = (const bf16_t*)(P.ws + WS_BIG); const float* KMEAN = (const float*)(P.ws + WS_KMEAN); bf16_t* OB = (bf16_t*)(P.ws + WS_OB);
    const int r32 = lane & 31, hi = lane >> 5;
    const int tokl = own * 256 + wid * 32 + r32; const size_t row = (size_t)b * S + tokl;
    char* Qw = lds + OFF_Q + wid * 8192;
#pragma unroll
    for (int d0 = 0; d0 < 8; ++d0) q_park(Qw, r32, hi, d0, *(const bf16x8*)(BIG + row * MQ_LD + h * HD + d0 * 16 + hi * 8));
    char* K_lds = lds + OFF_K;
    { const int sr = tid >> 4, sc = (tid & 15) * 8; const int kws = KSWZ(sr, sc * 2);
      bf16x8 z0 = (bf16x8){0, 0, 0, 0, 0, 0, 0, 0}; const bf16x8 z1 = z0;
      if (sr < 16) { const float* km = KMEAN + (size_t)((b * NH + h) * 16 + sr) * HD + sc; z0 = pack8(*(const f32x4*)km, *(const f32x4*)(km + 4)); }
      __syncthreads();
      *(bf16x8*)(K_lds + kws) = z0; *(bf16x8*)(K_lds + kws + 32 * 256) = z1;
      __syncthreads(); }
    unsigned sel = 0u;
    { f32x16 p0, p1; qkt(p0, p1, K_lds, r32, hi, Qw);
      float g[16];
#pragma unroll
      for (int r = 0; r < 8; ++r) { const float mine = p0[r], other = __shfl_xor(mine, 32); const int nb = (r & 3) + 8 * (r >> 2);
          g[nb] = hi == 0 ? mine : other; g[nb + 4] = hi == 0 ? other : mine; }
      if (own <= 3) sel = (1u << own) - 1u;
      else {
#pragma unroll
          for (int pass = 0; pass < 3; ++pass) { float best = 0.f; int bi = -1;
#pragma unroll
              for (int n = 0; n < 16; ++n) { const bool cand = (n < own) && (((sel >> n) & 1u) == 0u); if (cand && (bi < 0 || g[n] > best)) { best = g[n]; bi = n; } }
              sel |= 1u << bi; }
      } }
    f32x16 o[4]; o[0] = f32x16{}; o[1] = f32x16{}; o[2] = f32x16{}; o[3] = f32x16{};
    float m_reg = -1e30f, l_reg = 0.f;
    const bf16_t* Kb = BIG + (size_t)b * S * MQ_LD + D + h * HD; const bf16_t* Vb = Kb + D;
    attn_tiles<0>(o, m_reg, l_reg, Qw, Kb, Vb, MQ_LD, 0, 4 * own + 4, tokl, (unsigned long long)sel, own, 0.f, lds, tid, wid, lane);
    store_o<false, false>(o, 1.f / l_reg, OB, (size_t)b * S, own * 256 + wid * 32, h, lds, wid, lane);
}
__device__ __forceinline__ void phase_moba_attn(const Params& P, char* lds, int bid, int G, int tid, int wid, int lane) {
    asm volatile("" : "+v"(tid)); asm volatile("" : "+v"(lane));
    for (int p0 = bid; p0 < NB * NH * 8; p0 += G) {
        int pr = p0; if (G == 256) { const int xcd = p0 & 7, slot = p0 >> 3; pr = (xcd * 4 + (slot >> 3)) * 8 + (slot & 7); }
        const int x = pr & 7, h = (pr >> 3) & 15, b = pr >> 7;
        moba_unit(P, b, h, 15 - x, lds, tid, wid, lane);
        moba_unit(P, b, h, x, lds, tid, wid, lane);
    }
}

__device__ __forceinline__ void nsa_unit(const Params& P, int b, int g, int c, char* lds, int tid, int wid, int lane) {
    using namespace at;
    const bf16_t* BIG = (const bf16_t*)(P.ws + WS_BIG); const bf16_t* QROT = (const bf16_t*)(P.ws + WS_PP); bf16_t* OB = (bf16_t*)(P.ws + WS_OB);
    const int r32 = lane & 31, hi = lane >> 5;
    const int tokl = 64 * c + 8 * wid + (r32 >> 2), head = 4 * g + (r32 & 3); const size_t row = (size_t)b * S + tokl;
    char* Qw = lds + OFF_Q + wid * 8192;
#pragma unroll
    for (int d0 = 0; d0 < 8; ++d0) q_park(Qw, r32, hi, d0, *(const bf16x8*)(BIG + row * NQ_LD + head * HD + d0 * 16 + hi * 8));
    f32x16 o[4]; o[0] = f32x16{}; o[1] = f32x16{}; o[2] = f32x16{}; o[3] = f32x16{};
    float m_reg = -1e30f, l_reg = 0.f;
    const bf16_t* Kc = (const bf16_t*)(P.ws + WS_KC) + (size_t)(b * 4 + g) * 256 * HD; const bf16_t* Vc = (const bf16_t*)(P.ws + WS_VC) + (size_t)(b * 4 + g) * 256 * HD;
    const int tq = (tokl - 31) >> 4;
    const int ncmp = ((4 * c + 2) >> 6) + 1;
    attn_tiles<3>(o, m_reg, l_reg, Qw, Kc, Vc, HD, 0, ncmp, tq, 0ull, 0, 0.f, lds, tid, wid, lane);
    const float rl = l_reg > 0.f ? 1.f / l_reg : 0.f;
    attn_tiles<4>(o, m_reg, l_reg, Qw, Kc, Vc, HD, 0, ncmp, tq, 0ull, 0, rl, lds, tid, wid, lane);
    store_o<true, false>(o, sigmoidf_(bf1(BIG[row * NQ_LD + 5120 + head * 3 + 0])), OB, (size_t)b * S, 64 * c + 8 * wid, 4 * g, lds, wid, lane);
    unsigned long long sel;
    { float* impA = (float*)(lds + OFF_IMP + wid * 2048);
      unsigned long long* selm = (unsigned long long*)(lds + OFF_SELM + wid * 64);
      asm volatile("s_waitcnt lgkmcnt(0)" ::: "memory");
      const float INF = __builtin_inff();
      for (int tk = 0; tk < 8; ++tk) {
          float val = impA[tk * 64 + lane];
          if (lane == 0 || lane == c) val = INF; else if (lane > c) val = -INF;
          const unsigned u_ = __float_as_uint(val); const unsigned key = (u_ & 0x80000000u) ? ~u_ : (u_ | 0x80000000u);
          unsigned thr = 0u;
#pragma unroll
          for (int bit = 31; bit >= 0; --bit) { const unsigned cand = thr | (1u << bit); if (__popcll(__ballot(key >= cand)) >= 16) thr = cand; }
          const unsigned long long gt_ = __ballot(key > thr), eq_ = __ballot(key == thr);
          const int need = 16 - __popcll(gt_), eqrank = __popcll(eq_ & ((1ull << lane) - 1ull));
          const bool s = ((key > thr) || (key == thr && eqrank < need)) && (val > -INF);
          const unsigned long long mk = __ballot(s);
          if (lane == 0) selm[tk] = mk;
      }
      asm volatile("s_waitcnt lgkmcnt(0)" ::: "memory");
      sel = selm[r32 >> 2]; }
    {
      const int pos_ = ((const int*)P.in[2])[row];
      const u32x4 w1 = *(const u32x4*)(Qw + KSWZ(r32, (0 * 16 + hi * 8) * 2)), w2 = *(const u32x4*)(Qw + KSWZ(r32, (1 * 16 + hi * 8) * 2));
      float x1[8] = {bflo(w1.x), bfhi(w1.x), bflo(w1.y), bfhi(w1.y), bflo(w1.z), bfhi(w1.z), bflo(w1.w), bfhi(w1.w)};
      float x2[8] = {bflo(w2.x), bfhi(w2.x), bflo(w2.y), bfhi(w2.y), bflo(w2.z), bfhi(w2.z), bflo(w2.w), bfhi(w2.w)};
#pragma unroll
      for (int j = 0; j < 8; ++j) { const int i_ = hi * 8 + j;
          const float freq = __builtin_amdgcn_exp2f(-(float)i_ * (18.931568569324174f / 16.0f));
          const float ang = (float)pos_ * freq; const double rev = (double)ang * 0.15915494309189535; const float fr_ = (float)(rev - floor(rev));
          const float c_ = __builtin_amdgcn_cosf(fr_), s_ = __builtin_amdgcn_sinf(fr_);
          const float a1 = x1[j], a2 = x2[j]; x1[j] = a1 * c_ - a2 * s_; x2[j] = a2 * c_ + a1 * s_; }
      q_park(Qw, r32, hi, 0, pack8((f32x4){x1[0], x1[1], x1[2], x1[3]}, (f32x4){x1[4], x1[5], x1[6], x1[7]}));
      q_park(Qw, r32, hi, 1, pack8((f32x4){x2[0], x2[1], x2[2], x2[3]}, (f32x4){x2[4], x2[5], x2[6], x2[7]})); }
    o[0] = f32x16{}; o[1] = f32x16{}; o[2] = f32x16{}; o[3] = f32x16{}; m_reg = -1e30f; l_reg = 0.f;
    const bf16_t* kvb = BIG + (size_t)b * S * NQ_LD + D + g * HD;
    attn_tiles<1>(o, m_reg, l_reg, Qw, kvb + 2 * 512, kvb + 3 * 512, NQ_LD, 0, c + 1, tokl, sel, 0, 0.f, lds, tid, wid, lane);
    store_o<true, true>(o, sigmoidf_(bf1(BIG[row * NQ_LD + 5120 + head * 3 + 1])) / l_reg, OB, (size_t)b * S, 64 * c + 8 * wid, 4 * g, lds, wid, lane);
    o[0] = f32x16{}; o[1] = f32x16{}; o[2] = f32x16{}; o[3] = f32x16{}; m_reg = -1e30f; l_reg = 0.f;
    attn_tiles<2>(o, m_reg, l_reg, Qw, kvb + 4 * 512, kvb + 5 * 512, NQ_LD, (c > 8 ? c - 8 : 0), c + 1, tokl, 0ull, 0, 0.f, lds, tid, wid, lane);
    store_o<true, true>(o, sigmoidf_(bf1(BIG[row * NQ_LD + 5120 + head * 3 + 2])) / l_reg, OB, (size_t)b * S, 64 * c + 8 * wid, 4 * g, lds, wid, lane);
}
__device__ __forceinline__ void phase_nsa_attn(const Params& P, char* lds, int bid, int G, int tid, int wid, int lane) {
    asm volatile("" : "+v"(tid)); asm volatile("" : "+v"(lane));
    for (int p0 = bid; p0 < NB * 4 * 32; p0 += G) {
        int pr = p0; if (G == 256) { const int xcd = p0 & 7, slot = p0 >> 3; pr = xcd * 32 + slot; }
        const int x = pr & 31, g = (pr >> 5) & 3, b = pr >> 7;
        nsa_unit(P, b, g, 63 - x, lds, tid, wid, lane);
        nsa_unit(P, b, g, x, lds, tid, wid, lane);
    }
}
typedef unsigned v4u __attribute__((ext_vector_type(4)));
#define XB_TMO      128
#define XB_XCNT(j)  (256  + 64 * (j))
#define XB_XSUB(j)  (1280 + 64 * (j))
#define XB_XGEN(j)  (2304 + 64 * (j))
#define XB_TOP      3328
#define XB_TOPGEN   3392
#define XCD_BAR_WORDS 3456
#define XB_SPIN_CAP (1u << 18)

__device__ __forceinline__ unsigned xb_ld(unsigned* p)              { return __hip_atomic_load(p, __ATOMIC_RELAXED, __HIP_MEMORY_SCOPE_AGENT); }
__device__ __forceinline__ unsigned xb_add(unsigned* p, unsigned v) { return __hip_atomic_fetch_add(p, v, __ATOMIC_RELAXED, __HIP_MEMORY_SCOPE_AGENT); }
__device__ __forceinline__ unsigned xb_xcc_id() { return (unsigned)__builtin_amdgcn_s_getreg((3 << 11) | 20) & 0xFu; }
#define XB_SPIN(cond, bar) do { unsigned _sp = 0; while (cond) { __builtin_amdgcn_s_sleep(1); \
    if ((++_sp & 255u) == 0u) { if (xb_ld(&(bar)[XB_TMO])) break; if (_sp > XB_SPIN_CAP) { atomicAdd(&(bar)[XB_TMO], 1u); break; } } } } while (0)

struct XcdBarrier {
    unsigned* bar; unsigned x;
    volatile LAS unsigned* st;
};

__device__ __forceinline__ XcdBarrier xcd_barrier_post(unsigned* bar, volatile LAS unsigned* st) {
    XcdBarrier b; b.bar = bar; b.x = xb_xcc_id(); b.st = st;
    if (threadIdx.x == 0) (void)xb_add(&bar[XB_XCNT(b.x)], 1u);
    return b;
}
__device__ __forceinline__ void xcd_barrier_complete(unsigned* bar, unsigned x, unsigned& nloc, unsigned& nx) {
    const unsigned G = gridDim.x * gridDim.y * gridDim.z;
    unsigned sum, cnt, mine, sp = 0u;
    for (;;) {
        sum = 0u; cnt = 0u; mine = 0u;
#pragma unroll
        for (unsigned j = 0; j < 16; ++j) { const unsigned c = xb_ld(&bar[XB_XCNT(j)]); sum += c; cnt += (c > 0u) ? 1u : 0u; mine = (j == x) ? c : mine; }
        if (sum == G) break;
        __builtin_amdgcn_s_sleep(1);
        if ((++sp & 255u) == 0u) { if (xb_ld(&bar[XB_TMO])) break; if (sp > XB_SPIN_CAP) { atomicAdd(&bar[XB_TMO], 1u); break; } }
    }
    nloc = mine > 0u ? mine : 1u; nx = cnt > 0u ? cnt : 1u;
}

__device__ __forceinline__ void xcd_barrier(const XcdBarrier& b) {
    asm volatile("s_waitcnt vmcnt(0)" ::: "memory");
    __syncthreads();
    if (threadIdx.x == 0) {
        unsigned* bar = b.bar;
        __builtin_amdgcn_s_waitcnt(0);
        unsigned nloc = b.st[0], nx = b.st[1];
        if (nloc == 0u) { xcd_barrier_complete(bar, b.x, nloc, nx); b.st[0] = nloc; b.st[1] = nx; }
        const unsigned old = xb_add(&bar[XB_XSUB(b.x)], 1u);
        const unsigned gen = old / nloc;
        if (old + 1u == (gen + 1u) * nloc) {
            __builtin_amdgcn_fence(__ATOMIC_RELEASE, "agent");
            asm volatile("s_waitcnt vmcnt(0)" ::: "memory");
            const unsigned og = xb_add(&bar[XB_TOP], 1u);
            const unsigned tg = og / nx;
            if (og + 1u == (tg + 1u) * nx) xb_add(&bar[XB_TOPGEN], 1u);
            else XB_SPIN(xb_ld(&bar[XB_TOPGEN]) == tg, bar);
            __builtin_amdgcn_fence(__ATOMIC_ACQUIRE, "agent");
            xb_add(&bar[XB_XGEN(b.x)], 1u);
            asm volatile("s_waitcnt vmcnt(0)" ::: "memory");
        } else {
            XB_SPIN(xb_ld(&bar[XB_XGEN(b.x)]) == gen, bar);
            __builtin_amdgcn_fence(__ATOMIC_ACQUIRE, "agent");
            asm volatile("s_waitcnt vmcnt(0)" ::: "memory");
        }
    }
    __syncthreads();
}

__global__ void __launch_bounds__(NTHREADS, 2) trunk_fwd(Params P) {
    extern __shared__ __attribute__((aligned(16))) unsigned char lds_raw[];
    char* lds = (char*)lds_raw;
    cg::grid_group grid = cg::this_grid();
    const int tid = threadIdx.x, lane = tid & 63, wid = __builtin_amdgcn_readfirstlane(tid >> 6);
    const int bid = blockIdx.x, G = gridDim.x;
    const int gw = bid * NWAVES + wid, NGW = G * NWAVES, gtid = bid * NTHREADS + tid, NT = G * NTHREADS;
    unsigned char* ws = P.ws;
    const float* x = (const float*)P.in[0];
    float* out = P.out;
    bf16_t* XN = (bf16_t*)(ws + WS_XN); bf16_t* OB = (bf16_t*)(ws + WS_OB); bf16_t* PPB = (bf16_t*)(ws + WS_PP); bf16_t* BIG = (bf16_t*)(ws + WS_BIG);

    volatile LAS unsigned* bst = (volatile LAS unsigned*)((LAS unsigned char*)lds_raw + LDS_BYTES - 16);
    if (tid == 0) { bst[0] = 0u; bst[1] = 0u; }
    __syncthreads();
    const XcdBarrier bar = xcd_barrier_post((unsigned*)(ws + WS_CTL), bst);
#define GSYNC() do { XcdBarrier b2_ = bar; asm volatile("" : "+s"(b2_.x)); xcd_barrier(b2_); } while (0)
    phase_convert(P, lds, gw, NGW, gtid, NT, wid, lane);
    __syncthreads();
    if (P.out == nullptr) grid.sync();
    GSYNC();

    bf16_t* hbc = XN;
    bf16_t* hbo = (bf16_t*)(ws + WS_HB1);
    unsigned* SS = (unsigned*)(ws + WS_SS);
    for (int i = 0; i < 4; ++i) {
        if (i == 1) {
            phase_pool_prep(hbc, SS + (size_t)(3 * i) * T, (const float*)P.in[3] + (size_t)i * D, OB, lds, bid, G, tid, wid, lane);
            GSYNC();
            for (int gq = 0; gq < 4; ++gq) {
                pg8::EpiH<0> E{nullptr, hbc, nullptr, (const float*)P.in[15], gq * 512, nullptr, nullptr, hbc, SS + (size_t)(3 * i + 1) * T};
                gemm_run(lds, OB + gq * 512, D, (const bf16_t*)(ws + WS_POOL) + (size_t)gq * 512 * 512, 512, T, 512, 512, G, (bid + gq * (G / 4)) % G, E);
            }
            GSYNC();
        } else {
            { const bf16_t* Wt = (const bf16_t*)(ws + (i == 0 ? WS_MQKV : (i == 2 ? WS_NQKV : WS_CIN))); const int N = (i == 2) ? NQ_LD : MQ_LD;
              pg8::EpiB<0> E{BIG, N, SS + (size_t)(3 * i) * T};
              gemm_run(lds, hbc, D, Wt, D, T, N, D, G, bid, E); }
            GSYNC();
            if (i == 0) {
                phase_moba_prep(P, lds, bid, G, tid, wid, lane);
                GSYNC();
                phase_moba_attn(P, lds, bid, G, tid, wid, lane);
            } else if (i == 2) {
                phase_nsa_norm(P, gw, NGW, lane);
                phase_nsa_compress(P, lds, bid, G, tid, wid, lane);
                GSYNC();
                phase_nsa_attn(P, lds, bid, G, tid, wid, lane);
            } else {
                phase_conv_elem(P, gtid, NT);
            }
            __syncthreads();
            GSYNC();
            { const bf16_t* Wt = (const bf16_t*)(ws + (i == 0 ? WS_MWO : (i == 2 ? WS_NWO : WS_CWO)));
              pg8::EpiH<0> E{(i == 0) ? x : nullptr, hbc, nullptr, nullptr, 0, nullptr, nullptr, hbc, SS + (size_t)(3 * i + 1) * T};
              gemm_run(lds, OB, D, Wt, D, T, D, D, G, bid, E); }
            GSYNC();
        }
        { pg8::EpiB<2> E{BIG, FF, nullptr};
          gemm_run(lds, hbc, D, (const bf16_t*)(ws + WS_W1T + (size_t)i * 32 * MiB), D, T, FF, D, G, bid, E); }
        { pg8::EpiB<0> E{PPB, D, nullptr};
          gemm_run(lds, (const bf16_t*)(ws + WS_PB) + (size_t)i * T * 256, 256, (const bf16_t*)(ws + WS_PPT + (size_t)i * 1 * MiB), 256, T, D, 256, G, bid, E); }
        GSYNC();
        { pg8::EpiH<0> E{nullptr, hbc, nullptr, nullptr, 0, nullptr, SS + (size_t)(3 * i + 1) * T, hbc, SS + (size_t)(3 * i + 2) * T};
          gemm_run(lds, BIG, FF, (const bf16_t*)(ws + WS_W2T + (size_t)i * 32 * MiB), FF, T, D, FF, G, bid, E); }
        GSYNC();
        { pg8::EpiH<1> E{nullptr, hbc, (i == 3) ? out : nullptr, nullptr, 0, PPB, SS + (size_t)(3 * i + 2) * T, (i < 3) ? hbo : nullptr, (i < 3) ? SS + (size_t)(3 * i + 3) * T : nullptr};
          gemm_run(lds, hbc, D, (const bf16_t*)(ws + WS_PGT + (size_t)i * 8 * MiB), D, T, D, D, G, bid, E); }
        if (i < 3) { GSYNC(); bf16_t* tsw = hbc; hbc = hbo; hbo = tsw; }
    }
}

extern "C" void kernel_launch(void* const* d_in, const int* in_sizes, int n_in, void* d_out, int out_size, void* d_ws, size_t ws_size, hipStream_t stream) {
    static int grid = 0;
    if (grid == 0) {
        if (n_in != 29 || out_size != T * D || ws_size < WS_END) { fprintf(stderr, "kernel_launch: unexpected problem (n_in %d, out %d, ws %zu)\n", n_in, out_size, ws_size); grid = -1; return; }
        int dev = 0, cus = 0, per_cu = 0;
        hipGetDevice(&dev);
        hipDeviceGetAttribute(&cus, hipDeviceAttributeMultiprocessorCount, dev);
        hipFuncSetAttribute((const void*)trunk_fwd, hipFuncAttributeMaxDynamicSharedMemorySize, LDS_BYTES);
        hipOccupancyMaxActiveBlocksPerMultiprocessor(&per_cu, (const void*)trunk_fwd, NTHREADS, LDS_BYTES);
        (void)hipGetLastError();
        if (per_cu < 1) { fprintf(stderr, "kernel_launch: occupancy query says %d blocks per CU\n", per_cu); per_cu = 1; }
        grid = cus;
        fprintf(stderr, "kernel_launch: cus %d per_cu %d grid %d\n", cus, per_cu, grid);
    }
    if (grid < 0) return;
    if (hipMemsetAsync((char*)d_ws + WS_CTL, 0, 1048576, stream) != hipSuccess) { fprintf(stderr, "kernel_launch: memset failed\n"); return; }
    Params p{};
    for (int i = 0; i < 29; ++i) p.in[i] = d_in[i];
    p.out = (float*)d_out; p.ws = (unsigned char*)d_ws;
    void* args[] = {&p};
    hipError_t e = hipLaunchCooperativeKernel((const void*)trunk_fwd, dim3(grid), dim3(NTHREADS), args, LDS_BYTES, stream);
    if (e != hipSuccess) fprintf(stderr, "cooperative launch failed: %s (grid %d)\n", hipGetErrorString(e), grid);
}
```

```cpp
#include <hip/hip_runtime.h>
#include <hip/hip_cooperative_groups.h>
#include <cstdio>
#include <cstdint>
namespace cg = cooperative_groups;
namespace pg8 {
#define PG8_LAS __attribute__((address_space(3)))
typedef unsigned short bf16_t;
typedef short bf16x8 __attribute__((ext_vector_type(8)));
typedef float f32x4 __attribute__((ext_vector_type(4)));
typedef unsigned u32x4 __attribute__((ext_vector_type(4)));
typedef unsigned u32x2_ __attribute__((ext_vector_type(2)));
constexpr int BM = 256, BK = 64, HALF = 128, HTB = HALF * BK * 2  , STAGE_BYTES = 8 * HTB, NXCD = 8, WGM = 8;

__host__ __device__ __forceinline__ int lds_byte(int r, int c) { const int st = (r >> 4) * 2 + (c >> 5), rr = r & 15, cc = c & 31, ob = rr * 64 + cc * 2; return st * 1024 + (ob ^ (((ob >> 9) & 1) << 5)); }
__host__ __device__ __forceinline__ void stage_rc(int b, int& R, int& C) { const int st = b / 1024, sb = b % 1024, swz = sb ^ (((sb >> 9) & 1) << 5); R = (st >> 1) * 16 + swz / 64; C = (st & 1) * 32 + (swz % 64) / 2; }
__host__ __device__ __forceinline__ int perm32(int rho) { const int n = rho >> 4, i = rho & 15; return 8 * (i >> 2) + 4 * n + (i & 3); }

struct Unit { int pm, pn; };
struct Gemm { const bf16_t* A; const bf16_t* Bt; int M, N, K, lda, ldb; };

struct StaticOrder {
    int nM, nN, nwg, G, c;
    __host__ __device__ void init(int M, int N, int G_, int c_) { nM = M / BM; nN = N / BM; nwg = nM * nN; G = G_; c = c_; }
    __host__ __device__ bool next(int i, Unit& u) const {
        const long L = (long)i * G + c; if (L >= nwg) return false;
        int wgid = (int)L; { const int q = nwg / NXCD, r = nwg % NXCD, xcd = wgid % NXCD, off = wgid / NXCD; wgid = (xcd < r ? xcd * (q + 1) : r * (q + 1) + (xcd - r) * q) + off; }
        const int nig = WGM * nN, gid = wgid / nig, fm = gid * WGM, gsz = (nM - fm) < WGM ? (nM - fm) : WGM;
        u.pm = fm + ((wgid % nig) % gsz); u.pn = (wgid % nig) / gsz; return true;
    }
    __device__ __forceinline__ void a_ready(const Unit&) const {}
    __device__ __forceinline__ void done(const Unit&) const {}
};

__device__ __forceinline__ unsigned cvt_pk_bf16(float lo, float hi) { unsigned r; asm volatile("v_cvt_pk_bf16_f32 %0, %1, %2" : "=v"(r) : "v"(lo), "v"(hi)); return r; }
typedef float f32x2 __attribute__((ext_vector_type(2)));
__device__ __forceinline__ f32x2 gelu_pk(f32x2 v) {
    const f32x2 av = __builtin_elementwise_abs(v), d = av * 0.2316418882f + 1.0f;
    f32x2 t; t.x = __builtin_amdgcn_rcpf(d.x); t.y = __builtin_amdgcn_rcpf(d.y);
    f32x2 q = t * 0.5307027145f + (-0.7265760135f); q = q * t + 0.7107068705f; q = q * t + (-0.142248368f); q = q * t + 0.127414796f; q = q * t;
    const f32x2 s = (v * v) * (-0.72134752044f);
    f32x2 e; e.x = __builtin_amdgcn_exp2f(s.x); e.y = __builtin_amdgcn_exp2f(s.y);
    const f32x2 m = v * (q * e), r = v - m;
    f32x2 o; o.x = v.x < 0.f ? m.x : r.x; o.y = v.y < 0.f ? m.y : r.y; return o;
}

template <int ACT  > struct EpiBf16 {
    static constexpr bool PERM = true, AFTER_DRAIN = false; static_assert(ACT == 0 || ACT == 1, "EpiBf16: ACT is 0 (none) or 1 (gelu_pk)");
    bf16_t* O; int ldc; const float* bias; int split_cols; size_t split_stride; float scale0;
    __device__ __forceinline__ void operator()(const f32x4 (&acc)[2][2][4][2], const Unit& u, int wr, int wc, int fr, int fq) const {
        const int row0 = u.pm * BM + wr * 64 + fr; int colt = u.pn * BM; bf16_t* base = O;
        float sc = 1.f; if (split_cols) { const int t = colt / split_cols; base += (size_t)t * split_stride; colt -= t * split_cols; if (t == 0) sc = scale0; }
        const int col0 = colt + wc * 32 + 8 * fq, bcol0 = u.pn * BM + wc * 32 + 8 * fq;
        f32x4 bv[2][2];
#pragma unroll
        for (int bj = 0; bj < 2; ++bj)
#pragma unroll
            for (int n = 0; n < 2; ++n) bv[bj][n] = bias ? *(const f32x4*)(bias + bcol0 + bj * HALF + 4 * n) : (f32x4){0.f, 0.f, 0.f, 0.f};
#pragma unroll
        for (int ai = 0; ai < 2; ++ai)
#pragma unroll
            for (int m = 0; m < 4; ++m) { bf16_t* rowp = base + (size_t)(row0 + ai * HALF + m * 16) * ldc + col0;
#pragma unroll
                for (int bj = 0; bj < 2; ++bj) { f32x4 v0 = acc[ai][bj][m][0] + bv[bj][0], v1 = acc[ai][bj][m][1] + bv[bj][1];
                    if (ACT == 1) { f32x2 a = gelu_pk((f32x2){v0[0], v0[1]}), b = gelu_pk((f32x2){v0[2], v0[3]}), c = gelu_pk((f32x2){v1[0], v1[1]}), d = gelu_pk((f32x2){v1[2], v1[3]});
                        v0 = (f32x4){a.x, a.y, b.x, b.y}; v1 = (f32x4){c.x, c.y, d.x, d.y}; }
                    v0 = v0 * sc; v1 = v1 * sc; u32x4 w; w.x = cvt_pk_bf16(v0[0], v0[1]); w.y = cvt_pk_bf16(v0[2], v0[3]); w.z = cvt_pk_bf16(v1[0], v1[1]); w.w = cvt_pk_bf16(v1[2], v1[3]);
                    *(u32x4*)(rowp + bj * HALF) = w; } }
    }
};
template <class Epi, class Sched, bool ALIGN_EPI = false, bool SP2 = false>
__device__ __forceinline__ void gemm_phase(PG8_LAS unsigned char* lds, const Gemm g, const Sched& S, const Epi& E) {
    int tid_ = threadIdx.x; asm volatile("" : "+v"(tid_)); const int tid = tid_, wid = __builtin_amdgcn_readfirstlane(tid >> 6), lane = tid & 63, wr = wid >> 2, wc = wid & 3, fr = lane & 15, fq = lane >> 4;
    const int K = g.K, nt = K / BK;
    unsigned voffA[2], voffB[2];
#pragma unroll
    for (int i = 0; i < 2; ++i) { int R, C; stage_rc(tid * 16 + i * 8192, R, C); const int Rb = Epi::PERM ? ((R & ~31) + perm32(R & 31)) : R;
        voffA[i] = (unsigned)(R * g.lda + C) * 2u; voffB[i] = (unsigned)(Rb * g.ldb + C) * 2u; }
    const size_t kstep = (size_t)(BK * 2);
    const size_t hstepA = (size_t)HALF * g.lda * 2, hstepB = (size_t)HALF * g.ldb * 2;
    const size_t tstepA = 2 * hstepA, tstepB = 2 * hstepB;
    const unsigned ldsw = (unsigned)wid * 1024u;
    const int aoff = lds_byte(wr * 64 + fr, fq * 8), boff = lds_byte(wc * 32 + fr, fq * 8);
#define PG8_SA(b, h) (((b) * 2 + (h)) * HTB)
#define PG8_SB(b, h) ((4 + (b) * 2 + (h)) * HTB)
#define PG8_STAGE(bufoff, gbase, voff) do { _Pragma("unroll") for (int _i = 0; _i < 2; ++_i) \
        __builtin_amdgcn_global_load_lds((const unsigned*)((const char*)(gbase) + (voff)[_i]), (PG8_LAS unsigned*)(lds + (bufoff) + ldsw + _i * 8192), 16, 0, 0); } while (0)
#define PG8_LDA(dst, b, h) do { _Pragma("unroll") for (int m = 0; m < 4; ++m) _Pragma("unroll") for (int k = 0; k < 2; ++k) dst[m][k] = *(const PG8_LAS bf16x8*)(lds + PG8_SA(b, h) + aoff + m * 2048 + k * 1024); } while (0)
#define PG8_LDB(dst, b, h) do { _Pragma("unroll") for (int n = 0; n < 2; ++n) _Pragma("unroll") for (int k = 0; k < 2; ++k) dst[n][k] = *(const PG8_LAS bf16x8*)(lds + PG8_SB(b, h) + boff + n * 2048 + k * 1024); } while (0)
#define PG8_MMA(ai, bj, At, Bt) do { __builtin_amdgcn_s_setprio(1); _Pragma("unroll") for (int m = 0; m < 4; ++m) _Pragma("unroll") for (int n = 0; n < 2; ++n) _Pragma("unroll") for (int k = 0; k < 2; ++k) \
        acc[ai][bj][m][n] = __builtin_amdgcn_mfma_f32_16x16x32_bf16(Bt[n][k], At[m][k], acc[ai][bj][m][n], 0, 0, 0); __builtin_amdgcn_s_setprio(0); } while (0)
#define PG8_WAIT_V(n) asm volatile("s_waitcnt vmcnt(" #n ")" ::: "memory")
#define PG8_WAIT_L(n) asm volatile("s_waitcnt lgkmcnt(" #n ")" ::: "memory")
#define PG8_BAR __builtin_amdgcn_s_barrier()
#define PG8_SCHED __builtin_amdgcn_sched_barrier(0)
    Unit cur, nxt; int ui = 0;
    if (!S.next(0, cur)) return;
    f32x4 acc[2][2][4][2];
#pragma unroll
    for (int a = 0; a < 2; ++a)
#pragma unroll
        for (int b = 0; b < 2; ++b)
#pragma unroll
            for (int m = 0; m < 4; ++m)
#pragma unroll
                for (int n = 0; n < 2; ++n) acc[a][b][m][n] = (f32x4){0.f, 0.f, 0.f, 0.f};
    bf16x8 At[4][2], B0[2][2], B1[2][2];
    const char* cA = (const char*)g.A + (size_t)cur.pm * tstepA; const char* cB = (const char*)g.Bt + (size_t)cur.pn * tstepB;
    S.a_ready(cur);
    if constexpr (SP2) {
        PG8_STAGE(PG8_SB(0, 0), cB, voffB); PG8_STAGE(PG8_SB(0, 1), cB + hstepB, voffB); PG8_STAGE(PG8_SA(0, 0), cA, voffA); PG8_STAGE(PG8_SA(0, 1), cA + hstepA, voffA);
        if (wr == 1) PG8_BAR;
        PG8_WAIT_V(2); PG8_BAR;
        PG8_STAGE(PG8_SB(1, 0), cB + kstep, voffB); PG8_STAGE(PG8_SA(1, 0), cA + kstep, voffA); PG8_STAGE(PG8_SB(1, 1), cB + hstepB + kstep, voffB);
        PG8_WAIT_V(6); PG8_BAR;
    } else {
        PG8_STAGE(PG8_SB(0, 0), cB, voffB); PG8_STAGE(PG8_SA(0, 0), cA, voffA); PG8_STAGE(PG8_SB(0, 1), cB + hstepB, voffB); PG8_STAGE(PG8_SA(0, 1), cA + hstepA, voffA);
        if (wr == 1) PG8_BAR;
        PG8_WAIT_V(4); PG8_BAR;
        PG8_STAGE(PG8_SB(1, 0), cB + kstep, voffB); PG8_STAGE(PG8_SA(1, 0), cA + kstep, voffA); PG8_STAGE(PG8_SB(1, 1), cB + hstepB + kstep, voffB);
        PG8_WAIT_V(6); PG8_BAR;
    }
    for (;;) {
        const bool has_next = S.next(ui + 1, nxt);
        E.pre(lds + STAGE_BYTES, cur, wr, fr, wid);
        const char* nA = has_next ? (const char*)g.A + (size_t)nxt.pm * tstepA : cA; const char* nB = has_next ? (const char*)g.Bt + (size_t)nxt.pn * tstepB : cB;
        for (int t = 0; t < nt; t += 2) {
            const bool last = (t == nt - 2);
            const char* a1 = cA + (size_t)(t + 1) * kstep;
            const char* a2 = last ? nA : cA + (size_t)(t + 2) * kstep; const char* b2 = last ? nB : cB + (size_t)(t + 2) * kstep;
            const char* a3 = a2 + kstep; const char* b3 = b2 + kstep;
            if (last && has_next) S.a_ready(nxt);
            if constexpr (SP2) {
            PG8_LDB(B0, 0, 0); PG8_LDB(B1, 0, 1); PG8_SCHED; PG8_LDA(At, 0, 0); PG8_STAGE(PG8_SA(1, 1), a1 + hstepA, voffA);
            PG8_WAIT_V(8); PG8_WAIT_L(0); PG8_BAR; PG8_MMA(0, 0, At, B0); PG8_MMA(0, 1, At, B1); PG8_BAR; PG8_SCHED;
            PG8_LDA(At, 0, 1); PG8_STAGE(PG8_SB(0, 0), b2, voffB); PG8_STAGE(PG8_SB(0, 1), b2 + hstepB, voffB); PG8_STAGE(PG8_SA(0, 0), a2, voffA);
            PG8_WAIT_V(8); PG8_WAIT_L(0); PG8_BAR; PG8_MMA(1, 0, At, B0); PG8_MMA(1, 1, At, B1); PG8_BAR; PG8_SCHED;
            PG8_LDB(B0, 1, 0); PG8_LDB(B1, 1, 1); PG8_SCHED; PG8_LDA(At, 1, 0); PG8_STAGE(PG8_SA(0, 1), a2 + hstepA, voffA);
            PG8_WAIT_V(8); PG8_WAIT_L(0); PG8_BAR; PG8_MMA(0, 0, At, B0); PG8_MMA(0, 1, At, B1); PG8_BAR; PG8_SCHED;
            PG8_LDA(At, 1, 1); PG8_STAGE(PG8_SB(1, 0), b3, voffB); PG8_STAGE(PG8_SB(1, 1), b3 + hstepB, voffB); PG8_STAGE(PG8_SA(1, 0), a3, voffA);
            PG8_WAIT_V(8); PG8_WAIT_L(0); PG8_BAR; PG8_MMA(1, 0, At, B0); PG8_MMA(1, 1, At, B1); PG8_BAR; PG8_SCHED;
            } else {
            PG8_LDB(B0, 0, 0); PG8_SCHED; PG8_LDA(At, 0, 0); PG8_STAGE(PG8_SA(1, 1), a1 + hstepA, voffA);
            PG8_WAIT_L(8); PG8_BAR; PG8_WAIT_L(0); PG8_MMA(0, 0, At, B0); PG8_BAR; PG8_SCHED;
            PG8_LDB(B1, 0, 1); PG8_STAGE(PG8_SB(0, 0), b2, voffB);
            PG8_BAR; PG8_WAIT_L(0); PG8_MMA(0, 1, At, B1); PG8_BAR;
            PG8_LDA(At, 0, 1); PG8_STAGE(PG8_SA(0, 0), a2, voffA);
            PG8_BAR; PG8_WAIT_L(0); PG8_MMA(1, 0, At, B0); PG8_BAR; PG8_SCHED;
            PG8_STAGE(PG8_SB(0, 1), b2 + hstepB, voffB);
            PG8_WAIT_V(6); PG8_BAR; PG8_MMA(1, 1, At, B1); PG8_BAR;
            PG8_LDB(B0, 1, 0); PG8_SCHED; PG8_LDA(At, 1, 0); PG8_STAGE(PG8_SA(0, 1), a2 + hstepA, voffA);
            PG8_WAIT_L(8); PG8_BAR; PG8_WAIT_L(0); PG8_MMA(0, 0, At, B0); PG8_BAR; PG8_SCHED;
            PG8_LDB(B1, 1, 1); PG8_STAGE(PG8_SB(1, 0), b3, voffB);
            PG8_BAR; PG8_WAIT_L(0); PG8_MMA(0, 1, At, B1); PG8_BAR;
            PG8_LDA(At, 1, 1); PG8_STAGE(PG8_SA(1, 0), a3, voffA);
            PG8_BAR; PG8_WAIT_L(0); PG8_MMA(1, 0, At, B0); PG8_BAR; PG8_SCHED;
            PG8_STAGE(PG8_SB(1, 1), b3 + hstepB, voffB);
            PG8_WAIT_V(6); PG8_BAR; PG8_MMA(1, 1, At, B1); PG8_BAR;
            }
        }
        if constexpr (ALIGN_EPI) { if (wr == 0) PG8_BAR; }
        if constexpr (!Epi::AFTER_DRAIN) { E(acc, cur, wr, wc, fr, fq, lds + STAGE_BYTES, wid, lane); S.done(cur); }
        if (!has_next) break;
#pragma unroll
        for (int a = 0; a < 2; ++a)
#pragma unroll
            for (int b = 0; b < 2; ++b)
#pragma unroll
                for (int m = 0; m < 4; ++m)
#pragma unroll
                    for (int n = 0; n < 2; ++n) acc[a][b][m][n] = (f32x4){0.f, 0.f, 0.f, 0.f};
        cur = nxt; cA = nA; cB = nB; ++ui;
        if constexpr (ALIGN_EPI) { if (wr == 1) PG8_BAR; }
    }
    PG8_WAIT_V(0);
    if constexpr (!ALIGN_EPI) { if (wr == 0) PG8_BAR; }
    PG8_BAR;
    if constexpr (Epi::AFTER_DRAIN) { E.fused(acc, cur, wr, wc, fr, fq, lds, wid, lane); S.done(cur); }
#undef PG8_SA
#undef PG8_SB
#undef PG8_STAGE
#undef PG8_LDA
#undef PG8_LDB
#undef PG8_MMA
#undef PG8_WAIT_V
#undef PG8_WAIT_L
#undef PG8_BAR
#undef PG8_SCHED
}
}
namespace pg8 {
constexpr float NORM_EPS_ = 1e-6f;
__device__ __forceinline__ void stat_dma(PG8_LAS unsigned char* spare, const unsigned* ss, const Unit& u, int wr, int fr, int wid) {
#pragma unroll
    for (int k = 0; k < 8; ++k)
        __builtin_amdgcn_global_load_lds(ss + (u.pm * BM + wr * 64 + fr + (k >> 2) * HALF + (k & 3) * 16), (PG8_LAS unsigned*)(spare + wid * 2048 + k * 256), 4, 0, 0);
}
__device__ __forceinline__ float stat_rstd(PG8_LAS unsigned char* spare, int wid, int lane, int k) {
    const unsigned v = *(const PG8_LAS unsigned*)(spare + wid * 2048 + k * 256 + lane * 4);
    return 1.0f / sqrtf((float)v * (1.f / (1024.f * 2048.f)) + NORM_EPS_);
}
template <int ACT  > struct EpiB {
    static constexpr bool PERM = true, AFTER_DRAIN = false;
    bf16_t* O; int ldc; const unsigned* ss;
    __device__ __forceinline__ void pre(PG8_LAS unsigned char* spare, const Unit& u, int wr, int fr, int wid) const { if (ss) stat_dma(spare, ss, u, wr, fr, wid); }
    __device__ __forceinline__ void operator()(const f32x4 (&acc)[2][2][4][2], const Unit& u, int wr, int wc, int fr, int fq, PG8_LAS unsigned char* spare, int wid, int lane) const {
        const int row0 = u.pm * BM + wr * 64 + fr, col0 = u.pn * BM + wc * 32 + 8 * fq;
#pragma unroll
        for (int ai = 0; ai < 2; ++ai)
#pragma unroll
            for (int m = 0; m < 4; ++m) { const int row = row0 + ai * HALF + m * 16; bf16_t* rowp = O + (size_t)row * ldc + col0;
                const float rs = ss ? stat_rstd(spare, wid, lane, ai * 4 + m) : 1.f;
#pragma unroll
                for (int bj = 0; bj < 2; ++bj) { f32x4 v0 = acc[ai][bj][m][0] * rs, v1 = acc[ai][bj][m][1] * rs;
                    if (ACT == 2) {
#pragma unroll
                        for (int e = 0; e < 4; ++e) { float a = v0[e] > 0.f ? v0[e] : 0.f; v0[e] = a * a; float b = v1[e] > 0.f ? v1[e] : 0.f; v1[e] = b * b; } }
                    u32x4 w; w.x = cvt_pk_bf16(v0[0], v0[1]); w.y = cvt_pk_bf16(v0[2], v0[3]); w.z = cvt_pk_bf16(v1[0], v1[1]); w.w = cvt_pk_bf16(v1[2], v1[3]);
                    *(u32x4*)(rowp + bj * HALF) = w; } }
    }
};
template <int MODE> struct EpiH {
    static constexpr bool PERM = true, AFTER_DRAIN = false;
    const float* base_f; const bf16_t* hb_in; float* out; const float* cscale; int col_off; const bf16_t* pp; const unsigned* ss_in; bf16_t* hb; unsigned* ss_out;
    __device__ __forceinline__ void pre(PG8_LAS unsigned char* spare, const Unit& u, int wr, int fr, int wid) const { if (ss_in) stat_dma(spare, ss_in, u, wr, fr, wid); }
    __device__ __forceinline__ void operator()(const f32x4 (&acc)[2][2][4][2], const Unit& u, int wr, int wc, int fr, int fq, PG8_LAS unsigned char* spare, int wid, int lane) const {
        const int row0 = u.pm * BM + wr * 64 + fr, col0 = col_off + u.pn * BM + wc * 32 + 8 * fq;
        unsigned sqv[8];
#pragma unroll
        for (int ai = 0; ai < 2; ++ai)
#pragma unroll
            for (int mp = 0; mp < 2; ++mp) {
                f32x4 bv[2][2][2]; u32x4 pw[2][2]; float rs[2] = {1.f, 1.f};
#pragma unroll
                for (int mm = 0; mm < 2; ++mm) { const int row = row0 + ai * HALF + (2 * mp + mm) * 16; const size_t ro = (size_t)row * 2048;
                    if (ss_in) { const float r_ = stat_rstd(spare, wid, lane, ai * 4 + 2 * mp + mm); rs[mm] = (MODE == 0) ? r_ * r_ : r_; }
#pragma unroll
                    for (int bj = 0; bj < 2; ++bj) { const int c = col0 + bj * HALF;
                        if (base_f) { bv[mm][bj][0] = *(const f32x4*)(base_f + ro + c); bv[mm][bj][1] = *(const f32x4*)(base_f + ro + c + 4); }
                        else { const u32x4 w = *(const u32x4*)(hb_in + ro + c);
                            bv[mm][bj][0] = (f32x4){__uint_as_float(w.x << 16), __uint_as_float(w.x & 0xffff0000u), __uint_as_float(w.y << 16), __uint_as_float(w.y & 0xffff0000u)};
                            bv[mm][bj][1] = (f32x4){__uint_as_float(w.z << 16), __uint_as_float(w.z & 0xffff0000u), __uint_as_float(w.w << 16), __uint_as_float(w.w & 0xffff0000u)}; }
                        pw[mm][bj] = (MODE == 1) ? *(const u32x4*)(pp + ro + c) : (u32x4){0u, 0u, 0u, 0u}; } }
#pragma unroll
                for (int mm = 0; mm < 2; ++mm) { const int m = 2 * mp + mm; const int row = row0 + ai * HALF + m * 16; const size_t ro = (size_t)row * 2048;
                    float sq = 0.f;
#pragma unroll
                    for (int bj = 0; bj < 2; ++bj) { const int c = col0 + bj * HALF; f32x4 v0 = acc[ai][bj][m][0], v1 = acc[ai][bj][m][1];
                        if (MODE == 0) { if (cscale) { v0 = v0 * *(const f32x4*)(cscale + c); v1 = v1 * *(const f32x4*)(cscale + c + 4); } v0 = v0 * rs[mm]; v1 = v1 * rs[mm]; }
                        else { const u32x4 w = pw[mm][bj];
                            const f32x4 p0 = {__uint_as_float(w.x << 16), __uint_as_float(w.x & 0xffff0000u), __uint_as_float(w.y << 16), __uint_as_float(w.y & 0xffff0000u)};
                            const f32x4 p1 = {__uint_as_float(w.z << 16), __uint_as_float(w.z & 0xffff0000u), __uint_as_float(w.w << 16), __uint_as_float(w.w & 0xffff0000u)};
#pragma unroll
                            for (int e = 0; e < 4; ++e) { v0[e] = p0[e] / (1.f + __expf(-v0[e] * rs[mm])); v1[e] = p1[e] / (1.f + __expf(-v1[e] * rs[mm])); } }
                        const f32x4 h0 = bv[mm][bj][0] + v0, h1 = bv[mm][bj][1] + v1;
                        if (out) { *(f32x4*)(out + ro + c) = h0; *(f32x4*)(out + ro + c + 4) = h1; }
                        if (hb) { u32x4 w2; w2.x = cvt_pk_bf16(h0[0], h0[1]); w2.y = cvt_pk_bf16(h0[2], h0[3]); w2.z = cvt_pk_bf16(h1[0], h1[1]); w2.w = cvt_pk_bf16(h1[2], h1[3]); *(u32x4*)(hb + ro + c) = w2;
                            const float r0 = __uint_as_float(w2.x << 16), r1 = __uint_as_float(w2.x & 0xffff0000u), r2 = __uint_as_float(w2.y << 16), r3 = __uint_as_float(w2.y & 0xffff0000u);
                            const float r4 = __uint_as_float(w2.z << 16), r5 = __uint_as_float(w2.z & 0xffff0000u), r6 = __uint_as_float(w2.w << 16), r7 = __uint_as_float(w2.w & 0xffff0000u);
                            sq += ((r0 * r0 + r1 * r1) + (r2 * r2 + r3 * r3)) + ((r4 * r4 + r5 * r5) + (r6 * r6 + r7 * r7)); } }
                    sq += __shfl_xor(sq, 16); sq += __shfl_xor(sq, 32); sqv[ai * 4 + m] = __float2uint_rn(sq * 1024.f);
                }
            }
        if (ss_out) {
#pragma unroll
            for (int j = 0; j < 2; ++j) { const unsigned v = fq == 0 ? sqv[4 * j] : (fq == 1 ? sqv[4 * j + 1] : (fq == 2 ? sqv[4 * j + 2] : sqv[4 * j + 3]));
                atomicAdd(ss_out + row0 + j * HALF + fq * 16, v); }
        }
    }
};
}
using pg8::bf16_t; using pg8::bf16x8; using pg8::f32x4; using pg8::u32x4;
typedef float f32x16 __attribute__((ext_vector_type(16)));
typedef short s16x4 __attribute__((ext_vector_type(4)));
typedef unsigned u32x2 __attribute__((ext_vector_type(2)));
#define LAS __attribute__((address_space(3)))
constexpr int NB = 2, S = 4096, T = NB * S, D = 2048, FF = 8192, NH = 16, HD = 128;
constexpr int NQ_LD = 5376, MQ_LD = 6144;
constexpr float EPS = 1e-6f;
constexpr size_t MiB = 1u << 20;
constexpr size_t WS_W1T = 0, WS_W2T = 128 * MiB, WS_PGT = 256 * MiB, WS_PPT = 288 * MiB, WS_MQKV = 292 * MiB, WS_MWO = 316 * MiB, WS_POOL = 324 * MiB,
                 WS_NQKV = 326 * MiB, WS_NWO = 347 * MiB, WS_CW1 = 355 * MiB, WS_CIN = 357 * MiB, WS_CWO = 381 * MiB, WS_PB = 389 * MiB, WS_XN = 405 * MiB,
                 WS_OB = 437 * MiB, WS_PP = 469 * MiB, WS_BIG = 501 * MiB, WS_KMEAN = 629 * MiB, WS_KC = 630 * MiB, WS_VC = 631 * MiB, WS_CTL = 632 * MiB, WS_SS = 632 * MiB + 65536, WS_HB1 = 633 * MiB, WS_SSP = 665 * MiB, WS_END = 678 * MiB;
constexpr int LDS_BYTES = 155648;
constexpr int NWAVES = 8, NTHREADS = 512;

struct Params { const void* in[29]; float* out; unsigned char* ws; };

__device__ __forceinline__ float bflo(unsigned w) { return __uint_as_float(w << 16); }
__device__ __forceinline__ float bfhi(unsigned w) { return __uint_as_float(w & 0xffff0000u); }
__device__ __forceinline__ float bf1(bf16_t b) { return __uint_as_float((unsigned)b << 16); }
__device__ __forceinline__ unsigned pk2(float lo, float hi) { return pg8::cvt_pk_bf16(lo, hi); }
__device__ __forceinline__ bf16_t f2bf1(float f) { return (bf16_t)(pk2(f, 0.f) & 0xffffu); }
__device__ __forceinline__ float wave_sum(float v) {
#pragma unroll
    for (int o = 1; o < 64; o <<= 1) v += __shfl_xor(v, o);
    return v;
}
__device__ __forceinline__ bf16x8 pack8(f32x4 a, f32x4 b) { u32x4 w = {pk2(a[0], a[1]), pk2(a[2], a[3]), pk2(b[0], b[1]), pk2(b[2], b[3])}; return __builtin_bit_cast(bf16x8, w); }
__device__ __forceinline__ float sigmoidf_(float x) { return 1.f / (1.f + __expf(-x)); }

struct CJob { const float* W; bf16_t* WT; const float* gain; int K, N, row_off, item; };
__device__ __forceinline__ void tr_load(const CJob& J, int lane, float (&tv)[32]) {
    const int nblk = J.N / 32, kb = J.item / nblk, nb = J.item % nblk, k0 = 64 * kb, n0 = 32 * nb;
#pragma unroll
    for (int i = 0; i < 32; ++i) { const int kk = 2 * i + (lane >> 5); tv[i] = __builtin_nontemporal_load(J.W + (size_t)(k0 + kk) * J.N + n0 + (lane & 31)); }
}
__device__ __forceinline__ void tr_store(const CJob& J, int lane, const float (&tv)[32], float* scr) {
    const int nblk = J.N / 32, kb = J.item / nblk, nb = J.item % nblk, k0 = 64 * kb, n0 = 32 * nb;
#pragma unroll
    for (int i = 0; i < 32; ++i) { const int kk = 2 * i + (lane >> 5); scr[kk * 33 + (lane & 31)] = J.gain ? tv[i] * J.gain[k0 + kk] : tv[i]; }
    asm volatile("s_waitcnt lgkmcnt(0)" ::: "memory");
    const int c = lane & 7;
#pragma unroll
    for (int j = 0; j < 4; ++j) { const int n = (lane >> 3) + 8 * j; const float* s = scr + (8 * c) * 33 + n;
        u32x4 o; o.x = pk2(s[0 * 33], s[1 * 33]); o.y = pk2(s[2 * 33], s[3 * 33]); o.z = pk2(s[4 * 33], s[5 * 33]); o.w = pk2(s[6 * 33], s[7 * 33]);
        *(u32x4*)(J.WT + (size_t)(J.row_off + n0 + n) * J.K + k0 + 8 * c) = o; }
    asm volatile("s_waitcnt lgkmcnt(0)" ::: "memory");
}
#define CJOB(src, Kk, Nn, dst, roff, gn) if (!found) { const int ni_ = ((Kk) / 64) * ((Nn) / 32); if (r < ni_) { J.W = (const float*)(src); J.WT = (bf16_t*)(dst); J.gain = (const float*)(gn); J.K = (Kk); J.N = (Nn); J.row_off = (roff); J.item = r; found = true; } else r -= ni_; }
#define CJOB_LAYER(i) CJOB((const float*)P.in[5] + (size_t)(i) * D * FF, D, FF, ws + WS_W1T + (size_t)(i) * 32 * MiB, 0, (const float*)P.in[4] + (size_t)(i) * D) \
                      CJOB((const float*)P.in[6] + (size_t)(i) * D * FF, FF, D, ws + WS_W2T + (size_t)(i) * 32 * MiB, 0, nullptr) \
                      CJOB((const float*)P.in[8] + (size_t)(i) * D * D, D, D, ws + WS_PGT + (size_t)(i) * 8 * MiB, 0, (const float*)P.in[7] + (size_t)(i) * D) \
                      CJOB((const float*)P.in[9] + (size_t)(i) * 256 * D, 256, D, ws + WS_PPT + (size_t)(i) * 1 * MiB, 0, nullptr)
constexpr int NITEMS_CONV = 4 * (8192 + 8192 + 2048 + 256) + 6144 + 2048 + 4 * 128 + 2048 + 3072 + 2048 + 2 * 256 + 6144 + 2048;
__device__ __forceinline__ CJob conv_resolve(const Params& P, int it) {
    unsigned char* ws = P.ws; CJob J; J.W = nullptr; J.WT = nullptr; J.gain = nullptr; J.K = 64; J.N = 32; J.row_off = 0; J.item = 0;
    int r = it; bool found = false;
    CJOB_LAYER(0) CJOB_LAYER(1) CJOB_LAYER(2) CJOB_LAYER(3)
    CJOB(P.in[10], D, 3 * D, ws + WS_MQKV, 0, (const float*)P.in[3])
    CJOB(P.in[13], D, D, ws + WS_MWO, 0, nullptr)
    CJOB((const float*)P.in[14] + 0 * 512 * 512, 512, 512, ws + WS_POOL + 0 * 512 * 512 * 2, 0, nullptr)
    CJOB((const float*)P.in[14] + 1 * 512 * 512, 512, 512, ws + WS_POOL + 1 * 512 * 512 * 2, 0, nullptr)
    CJOB((const float*)P.in[14] + 2 * 512 * 512, 512, 512, ws + WS_POOL + 2 * 512 * 512 * 2, 0, nullptr)
    CJOB((const float*)P.in[14] + 3 * 512 * 512, 512, 512, ws + WS_POOL + 3 * 512 * 512 * 2, 0, nullptr)
    CJOB(P.in[16], D, D, ws + WS_NQKV, 0, (const float*)P.in[3] + 2 * D)
    CJOB(P.in[17], D, 3072, ws + WS_NQKV, 2048, (const float*)P.in[3] + 2 * D)
    CJOB(P.in[24], D, D, ws + WS_NWO, 0, nullptr)
    CJOB((const float*)P.in[21] + 0 * 4096 * 128, 4096, 128, ws + WS_CW1 + 0 * 128 * 4096 * 2, 0, nullptr)
    CJOB((const float*)P.in[21] + 1 * 4096 * 128, 4096, 128, ws + WS_CW1 + 1 * 128 * 4096 * 2, 0, nullptr)
    CJOB(P.in[25], D, 3 * D, ws + WS_CIN, 0, (const float*)P.in[3] + 3 * D)
    CJOB(P.in[28], D, D, ws + WS_CWO, 0, nullptr)
    return J;
}
__device__ __forceinline__ void phase_convert(const Params& P, char* lds, int gw, int NGW, int gtid, int NT, int wid, int lane) {
    asm volatile("" : "+v"(lane));
    unsigned char* ws = P.ws;
    float* scr = (float*)(lds + wid * 17408);
    for (int it = 2 * gw; it < NITEMS_CONV; it += 2 * NGW) {
        const CJob J0 = conv_resolve(P, it); const bool two = (it + 1 < NITEMS_CONV); const CJob J1 = conv_resolve(P, two ? it + 1 : it);
        float tv0[32], tv1[32];
        tr_load(J0, lane, tv0); tr_load(J1, lane, tv1);
        tr_store(J0, lane, tv0, scr);
        if (two) tr_store(J1, lane, tv1, scr);
    }
    { const float* Wg = (const float*)P.in[23]; bf16_t* dst = (bf16_t*)(ws + WS_NQKV) + (size_t)5120 * D;
      for (int idx = gtid; idx < 256 * D; idx += NT) { const int n = idx >> 11, k = idx & 2047; dst[idx] = (n < 48) ? f2bf1(Wg[(size_t)k * 48 + n] * ((const float*)P.in[3])[2 * D + k]) : (bf16_t)0; } }
    { const float* x = (const float*)P.in[0]; bf16_t* hb = (bf16_t*)(ws + WS_XN); unsigned* ss0 = (unsigned*)(ws + WS_SS);
      for (int m = gw; m < T; m += NGW) {
          const f32x4* xr = (const f32x4*)(x + (size_t)m * D) + lane; u32x2* o8 = (u32x2*)(hb + (size_t)m * D) + lane; float s = 0.f;
#pragma unroll
          for (int j = 0; j < 8; ++j) { const f32x4 v = xr[64 * j]; s += (v[0] * v[0] + v[1] * v[1]) + (v[2] * v[2] + v[3] * v[3]); u32x2 o; o.x = pk2(v[0], v[1]); o.y = pk2(v[2], v[3]); o8[64 * j] = o; }
          s = wave_sum(s); if (lane == 0) ss0[m] = __float2uint_rn(s * 1024.f); } }
    { const f32x4* ps = (const f32x4*)P.in[1]; u32x2* pd = (u32x2*)(ws + WS_PB);
      for (int idx = gtid; idx < 4 * T * 256 / 4; idx += NT) { const f32x4 v = ps[idx]; u32x2 o; o.x = pk2(v[0], v[1]); o.y = pk2(v[2], v[3]); pd[idx] = o; } }
}

__device__ __forceinline__ void phase_rms(const float* src, const float* gain, bf16_t* dst, int gw, int NGW, int lane) {
    asm volatile("" : "+v"(lane));
    for (int m = gw; m < T; m += NGW) {
        const f32x4* xr = (const f32x4*)(src + (size_t)m * D) + lane;
        f32x4 v[8]; float s = 0.f;
#pragma unroll
        for (int j = 0; j < 8; ++j) { v[j] = xr[64 * j]; s += (v[j][0] * v[j][0] + v[j][1] * v[j][1]) + (v[j][2] * v[j][2] + v[j][3] * v[j][3]); }
        const float rstd = 1.0f / sqrtf(wave_sum(s) * (1.f / D) + EPS);
        u32x2* o8 = (u32x2*)(dst + (size_t)m * D) + lane;
#pragma unroll
        for (int j = 0; j < 8; ++j) { const f32x4 g = ((const f32x4*)gain)[lane + 64 * j]; u32x2 o; o.x = pk2(v[j][0] * rstd * g[0], v[j][1] * rstd * g[1]); o.y = pk2(v[j][2] * rstd * g[2], v[j][3] * rstd * g[3]); o8[64 * j] = o; }
    }
}

template <class Epi>
__device__ __forceinline__ void gemm_run(char* lds, const bf16_t* A, int lda, const bf16_t* Bt, int ldb, int M, int N, int K, int G, int c, const Epi& E) {
    pg8::Gemm g{A, Bt, M, N, K, lda, ldb}; pg8::StaticOrder So; So.init(M, N, G, c);
    pg8::gemm_phase<Epi, pg8::StaticOrder, true, true>((PG8_LAS unsigned char*)lds, g, So, E);
}

__device__ __forceinline__ void rope_cs(int pos, int lane, float (&cs)[2], float (&sn)[2]) {
#pragma unroll
    for (int e = 0; e < 2; ++e) {
        const int i = 2 * (lane & 7) + e;
        const float freq = __builtin_amdgcn_exp2f(-(float)i * (18.931568569324174f / 16.0f));
        const float ang = (float)pos * freq;
        const double rev = (double)ang * 0.15915494309189535;
        const float fr = (float)(rev - floor(rev));
        cs[e] = __builtin_amdgcn_cosf(fr); sn[e] = __builtin_amdgcn_sinf(fr);
    }
}
__device__ __forceinline__ void head_norm_rope(unsigned w, const float* gain, int lane, const float (&cs)[2], const float (&sn)[2], float& n0, float& n1, float& r0, float& r1) {
    const float x0 = bflo(w), x1 = bfhi(w);
    const float ss = wave_sum(x0 * x0 + x1 * x1);
    const float rstd = 1.0f / sqrtf(ss * (1.f / HD) + EPS);
    n0 = x0 * rstd * gain[2 * lane]; n1 = x1 * rstd * gain[2 * lane + 1];
    const float p0 = __shfl_xor(n0, 8), p1 = __shfl_xor(n1, 8);
    r0 = n0; r1 = n1;
    if (lane < 8) { r0 = n0 * cs[0] - p0 * sn[0]; r1 = n1 * cs[1] - p1 * sn[1]; }
    else if (lane < 16) { r0 = n0 * cs[0] + p0 * sn[0]; r1 = n1 * cs[1] + p1 * sn[1]; }
}
__device__ __forceinline__ void phase_moba_prep(const Params& P, char* lds, int bid, int G, int tid, int wid, int lane) {
    asm volatile("" : "+v"(tid)); asm volatile("" : "+v"(lane));
    bf16_t* BIG = (bf16_t*)(P.ws + WS_BIG); float* KMEAN = (float*)(P.ws + WS_KMEAN);
    const int* pos = (const int*)P.in[2]; const float* qg = (const float*)P.in[11]; const float* kg = (const float*)P.in[12];
    float* red = (float*)(lds);
    const int sub = lane & 15, grp = lane >> 4;
    float qg8[8], kg8[8];
#pragma unroll
    for (int j = 0; j < 8; ++j) { qg8[j] = qg[8 * sub + j]; kg8[j] = kg[8 * sub + j]; }
    for (int u = bid; u < NB * 16 * NH; u += G) {
        const int h = u & 15, blk = (u >> 4) & 15, b = u >> 8;
        float ks[8];
#pragma unroll
        for (int j = 0; j < 8; ++j) ks[j] = 0.f;
        u32x4 qv[8], kv[8];
#pragma unroll
        for (int it = 0; it < 8; ++it) { const size_t row = (size_t)(b * S + blk * 256 + wid * 32 + it * 4 + grp);
            qv[it] = *(const u32x4*)(BIG + row * MQ_LD + h * HD + 8 * sub); kv[it] = *(const u32x4*)(BIG + row * MQ_LD + D + h * HD + 8 * sub); }
#pragma unroll
        for (int it = 0; it < 8; ++it) {
            const size_t row = (size_t)(b * S + blk * 256 + wid * 32 + it * 4 + grp);
            const int ps = pos[row];
            float cs[8], sn[8];
#pragma unroll
            for (int j = 0; j < 8; ++j) { const int i_ = 8 * (sub & 1) + j;
                const float freq = __builtin_amdgcn_exp2f(-(float)i_ * (18.931568569324174f / 16.0f));
                const float ang = (float)ps * freq; const double rev = (double)ang * 0.15915494309189535; const float fr_ = (float)(rev - floor(rev));
                cs[j] = __builtin_amdgcn_cosf(fr_); sn[j] = __builtin_amdgcn_sinf(fr_); }
#pragma unroll
            for (int which = 0; which < 2; ++which) {
                const u32x4 w = which ? kv[it] : qv[it];
                float x[8] = {bflo(w.x), bfhi(w.x), bflo(w.y), bfhi(w.y), bflo(w.z), bfhi(w.z), bflo(w.w), bfhi(w.w)};
                float ss = 0.f;
#pragma unroll
                for (int j = 0; j < 8; ++j) ss += x[j] * x[j];
                ss += __shfl_xor(ss, 1); ss += __shfl_xor(ss, 2); ss += __shfl_xor(ss, 4); ss += __shfl_xor(ss, 8);
                const float rstd = 1.0f / sqrtf(ss * (1.f / HD) + EPS);
                float y[8];
#pragma unroll
                for (int j = 0; j < 8; ++j) { y[j] = x[j] * rstd * (which ? kg8[j] : qg8[j]);
                    const float pr = __shfl_xor(y[j], 2);
                    const float rot = (sub < 2) ? (y[j] * cs[j] - pr * sn[j]) : (y[j] * cs[j] + pr * sn[j]);
                    y[j] = (sub < 4) ? rot : y[j]; }
                u32x4 ow = {pk2(y[0], y[1]), pk2(y[2], y[3]), pk2(y[4], y[5]), pk2(y[6], y[7])};
                *(u32x4*)(BIG + row * MQ_LD + (which ? D : 0) + h * HD + 8 * sub) = ow;
                if (which) {
#pragma unroll
                    for (int j = 0; j < 8; ++j) ks[j] += y[j]; }
            }
        }
#pragma unroll
        for (int j = 0; j < 8; ++j) { ks[j] += __shfl_xor(ks[j], 16); ks[j] += __shfl_xor(ks[j], 32); }
        if (grp == 0) {
#pragma unroll
            for (int j = 0; j < 8; ++j) red[wid * 128 + 8 * sub + j] = ks[j]; }
        __syncthreads();
        if (tid < 128) { float sm = 0.f;
#pragma unroll
            for (int w = 0; w < 8; ++w) sm += red[w * 128 + tid];
            KMEAN[(size_t)((b * NH + h) * 16 + blk) * HD + tid] = sm * (1.f / 256.f); }
        __syncthreads();
    }
}

__device__ __forceinline__ void phase_nsa_norm(const Params& P, int gw, int NGW, int lane) {
    asm volatile("" : "+v"(lane));
    bf16_t* BIG = (bf16_t*)(P.ws + WS_BIG);
    const int* pos = (const int*)P.in[2]; const float* qg = (const float*)P.in[18]; const float* kg = (const float*)P.in[19];
    const int sub = lane & 15, grp = lane >> 4;
    for (int row = gw; row < T; row += NGW) {
        bf16_t* base = BIG + (size_t)row * NQ_LD;
        u32x4 v[6];
#pragma unroll
        for (int st = 0; st < 6; ++st) { const int col = (st < 4) ? (st * 4 + grp) * HD : (D + (st == 4 ? 2 : 4) * 512 + grp * HD); v[st] = *(const u32x4*)(base + col + 8 * sub); }
        const int ps = pos[row];
        float cs[8], sn[8];
#pragma unroll
        for (int j = 0; j < 8; ++j) { const int i_ = 8 * (sub & 1) + j;
            const float freq = __builtin_amdgcn_exp2f(-(float)i_ * (18.931568569324174f / 16.0f));
            const float ang = (float)ps * freq; const double rev = (double)ang * 0.15915494309189535; const float fr_ = (float)(rev - floor(rev));
            cs[j] = __builtin_amdgcn_cosf(fr_); sn[j] = __builtin_amdgcn_sinf(fr_); }
#pragma unroll
        for (int st = 0; st < 6; ++st) {
            const int col = (st < 4) ? (st * 4 + grp) * HD : (D + (st == 4 ? 2 : 4) * 512 + grp * HD);
            const float* gn = (st < 4) ? qg : (st == 4 ? kg + 1 * HD : kg + 2 * HD);
            const u32x4 w = v[st];
            float x[8] = {bflo(w.x), bfhi(w.x), bflo(w.y), bfhi(w.y), bflo(w.z), bfhi(w.z), bflo(w.w), bfhi(w.w)};
            float ss = 0.f;
#pragma unroll
            for (int j = 0; j < 8; ++j) ss += x[j] * x[j];
            ss += __shfl_xor(ss, 1); ss += __shfl_xor(ss, 2); ss += __shfl_xor(ss, 4); ss += __shfl_xor(ss, 8);
            const float rstd = 1.0f / sqrtf(ss * (1.f / HD) + EPS);
            const f32x4 g0 = *(const f32x4*)(gn + 8 * sub), g1 = *(const f32x4*)(gn + 8 * sub + 4);
            float y[8];
#pragma unroll
            for (int j = 0; j < 8; ++j) { y[j] = x[j] * rstd * (j < 4 ? g0[j & 3] : g1[j & 3]);
                if (st >= 4) { const float pr = __shfl_xor(y[j], 2);
                    const float rot = (sub < 2) ? (y[j] * cs[j] - pr * sn[j]) : (y[j] * cs[j] + pr * sn[j]);
                    y[j] = (sub < 4) ? rot : y[j]; } }
            u32x4 ow = {pk2(y[0], y[1]), pk2(y[2], y[3]), pk2(y[4], y[5]), pk2(y[6], y[7])};
            *(u32x4*)(base + col + 8 * sub) = ow;
        }
    }
}

__device__ __forceinline__ void phase_nsa_compress(const Params& P, char* lds, int bid, int G, int tid, int wid, int lane) {
    asm volatile("" : "+v"(tid)); asm volatile("" : "+v"(lane));
    const bf16_t* BIG = (const bf16_t*)(P.ws + WS_BIG); const bf16_t* CW1 = (const bf16_t*)(P.ws + WS_CW1);
    const float* cpos = (const float*)P.in[20]; const float* w2 = (const float*)P.in[22]; const float* kg0 = (const float*)P.in[19];
    float* red = (float*)lds;
    float* h1s = (float*)(lds + 65536);
    const int fr = lane & 15, fq = lane >> 4;
    for (int u = bid; u < 256; u += G) {
        const int ng = u & 15, j = (u >> 4) & 1, g = (u >> 5) & 3, b = u >> 7;
        const int n = 16 * ng + fr;
        f32x4 acc[8];
#pragma unroll
        for (int i = 0; i < 8; ++i) acc[i] = (f32x4){0.f, 0.f, 0.f, 0.f};
        for (int l = 4 * wid; l < 4 * wid + 4; ++l) {
            int tokl = 16 * n + l; tokl = tokl > S - 1 ? S - 1 : tokl;
            const bf16_t* rowp = BIG + (size_t)(b * S + tokl) * NQ_LD + D + j * 512 + g * HD;
            const float* pp = cpos + (size_t)(j * 32 + l) * HD;
#pragma unroll
            for (int dd = 0; dd < 4; ++dd) {
                const int d = dd * 32 + 8 * fq;
                const u32x4 raw = *(const u32x4*)(rowp + d);
                const f32x4 pa = *(const f32x4*)(pp + d), pb = *(const f32x4*)(pp + d + 4);
                f32x4 a0 = {bflo(raw.x) + pa[0], bfhi(raw.x) + pa[1], bflo(raw.y) + pa[2], bfhi(raw.y) + pa[3]};
                f32x4 a1 = {bflo(raw.z) + pb[0], bfhi(raw.z) + pb[1], bflo(raw.w) + pb[2], bfhi(raw.w) + pb[3]};
                const bf16x8 Af = pack8(a0, a1);
                const int k0 = l * HD + dd * 32 + 8 * fq;
#pragma unroll
                for (int ns = 0; ns < 8; ++ns) {
                    const bf16x8 Bw = *(const bf16x8*)(CW1 + (size_t)(j * 128 + ns * 16 + fr) * 4096 + k0);
                    acc[ns] = __builtin_amdgcn_mfma_f32_16x16x32_bf16(Bw, Af, acc[ns], 0, 0, 0);
                }
            }
        }
#pragma unroll
        for (int ns = 0; ns < 8; ++ns) *(f32x4*)(red + (size_t)(wid * 16 + fr) * 128 + ns * 16 + 4 * fq) = acc[ns];
        __syncthreads();
        const int m = tid >> 5, c4 = (tid & 31) * 4;
        { f32x4 s = {0.f, 0.f, 0.f, 0.f};
#pragma unroll
          for (int w = 0; w < 8; ++w) s = s + *(const f32x4*)(red + (size_t)(w * 16 + m) * 128 + c4);
#pragma unroll
          for (int e = 0; e < 4; ++e) { const float x = s[e]; const float uu = 0.7978845608028654f * (x + 0.044715f * x * x * x); const float th = 1.f - 2.f / (__expf(2.f * uu) + 1.f); s[e] = 0.5f * x * (1.f + th); }
          *(f32x4*)(h1s + m * 128 + c4) = s; }
        __syncthreads();
        f32x4 o = {0.f, 0.f, 0.f, 0.f};
        const float* w2j = w2 + (size_t)j * 128 * 128 + c4;
#pragma unroll 16
        for (int k = 0; k < 128; ++k) { const float hv = h1s[m * 128 + k]; const f32x4 wv = *(const f32x4*)(w2j + (size_t)k * 128); o = o + wv * hv; }
        if (j == 0) {
            float ss = (o[0] * o[0] + o[1] * o[1]) + (o[2] * o[2] + o[3] * o[3]);
#pragma unroll
            for (int sh = 1; sh < 32; sh <<= 1) ss += __shfl_xor(ss, sh);
            const float rstd = 1.0f / sqrtf(ss * (1.f / HD) + EPS);
            const f32x4 gn = *(const f32x4*)(kg0 + c4);
            o = o * rstd * gn;
        }
        const int nn = 16 * ng + m;
        if (nn >= 255) o = (f32x4){0.f, 0.f, 0.f, 0.f};
        bf16_t* dst = (bf16_t*)(P.ws + (j == 0 ? WS_KC : WS_VC)) + (size_t)((b * 4 + g) * 256 + nn) * HD + c4;
        u32x2 ow; ow.x = pk2(o[0], o[1]); ow.y = pk2(o[2], o[3]); *(u32x2*)dst = ow;
        __syncthreads();
    }
}

__device__ __forceinline__ f32x4 ld4bf(const bf16_t* p) { const u32x2 w = *(const u32x2*)p; return (f32x4){bflo(w.x), bfhi(w.x), bflo(w.y), bfhi(w.y)}; }
__device__ __forceinline__ void phase_pool_prep(const bf16_t* hsrc, const unsigned* ssq, const float* gain, bf16_t* OB, char* lds, int bid, int G, int tid, int wid, int lane) {
    asm volatile("" : "+v"(tid)); asm volatile("" : "+v"(lane));
    float* rs = (float*)lds;
    for (int u = bid; u < T / 32; u += G) {
        const int b = u / (S / 32), s0 = (u % (S / 32)) * 32;
        if (tid < 47) { const int s = s0 - 15 + tid; rs[tid] = (s >= 0) ? 1.0f / sqrtf((float)ssq[b * S + s] * (1.f / (1024.f * 2048.f)) + EPS) : 0.f; }
        __syncthreads();
        const int col = tid * 4, w = 2 << (tid >> 7);
        const f32x4 gn = *(const f32x4*)(gain + col);
        for (int rr = 0; rr < 32; ++rr) {
            const int s = s0 + rr; const int lo = (s + 1 - w) > 0 ? (s + 1 - w) : 0; const float inv = 1.0f / (float)(s + 1 - lo);
            f32x4 a = {0.f, 0.f, 0.f, 0.f};
            for (int sp = lo; sp <= s; ++sp) a = a + ld4bf(hsrc + (size_t)(b * S + sp) * D + col) * rs[sp - s0 + 15];
            const f32x4 xs = ld4bf(hsrc + (size_t)(b * S + s) * D + col) * rs[rr + 15];
            const f32x4 dv = (a * inv - xs) * gn;
            u32x2 ow; ow.x = pk2(dv[0], dv[1]); ow.y = pk2(dv[2], dv[3]);
            *(u32x2*)(OB + (size_t)(b * S + s) * D + col) = ow;
        }
        __syncthreads();
    }
}

__device__ __forceinline__ void phase_conv_elem(const Params& P, int gtid, int NT) {
    asm volatile("" : "+v"(gtid));
    const bf16_t* BIG = (const bf16_t*)(P.ws + WS_BIG); bf16_t* OB = (bf16_t*)(P.ws + WS_OB);
    const float* cw = (const float*)P.in[26]; const float* cb = (const float*)P.in[27];
    for (int it = gtid; it < T * 256; it += NT) {
        const int row = it >> 8, c8 = (it & 255) * 8, s = row & (S - 1);
        const bf16_t* base = BIG + (size_t)row * MQ_LD + c8;
        float u[3][8];
#pragma unroll
        for (int j = 0; j < 3; ++j) {
            const int back = 2 - j;
            if (s >= back) { const u32x4 cw4 = *(const u32x4*)(base - (size_t)back * MQ_LD + D), hw4 = *(const u32x4*)(base - (size_t)back * MQ_LD + 2 * D);
                u[j][0] = bflo(cw4.x) * bflo(hw4.x); u[j][1] = bfhi(cw4.x) * bfhi(hw4.x); u[j][2] = bflo(cw4.y) * bflo(hw4.y); u[j][3] = bfhi(cw4.y) * bfhi(hw4.y);
                u[j][4] = bflo(cw4.z) * bflo(hw4.z); u[j][5] = bfhi(cw4.z) * bfhi(hw4.z); u[j][6] = bflo(cw4.w) * bflo(hw4.w); u[j][7] = bfhi(cw4.w) * bfhi(hw4.w); }
            else {
#pragma unroll
                for (int e = 0; e < 8; ++e) u[j][e] = 0.f; }
        }
        const u32x4 bw4 = *(const u32x4*)base;
        float bv[8] = {bflo(bw4.x), bfhi(bw4.x), bflo(bw4.y), bfhi(bw4.y), bflo(bw4.z), bfhi(bw4.z), bflo(bw4.w), bfhi(bw4.w)};
        float y[8];
#pragma unroll
        for (int e = 0; e < 8; ++e) { const int c = c8 + e; y[e] = bv[e] * (cw[c] * u[0][e] + cw[D + c] * u[1][e] + cw[2 * D + c] * u[2][e] + cb[c]); }
        u32x4 ow = {pk2(y[0], y[1]), pk2(y[2], y[3]), pk2(y[4], y[5]), pk2(y[6], y[7])};
        *(u32x4*)(OB + (size_t)row * D + c8) = ow;
    }
}
namespace at {
constexpr float SCALE = 0.08838834764831845f;
constexpr float C2 = 1.4426950408889634f * SCALE;
constexpr int OFF_V = 0, OFF_K = 16384, KVBUF = 32768  , OFF_WS = 65536, OFF_IMP = 67584, OFF_SELM = 83968, OFF_Q = 86016;
#define KSWZ(row, colB) ((row) * 256 + ((colB) ^ (((row) & 7) << 4)))
#define SBAR() __builtin_amdgcn_sched_barrier(0)
__device__ __forceinline__ int v_st(int k, int c) { const int kk = (k & ~0xC) | ((k & 4) << 1) | ((k & 8) >> 1); return ((kk >> 3) * 4 + (c >> 5)) * 512 + ((kk & 7) * 32 + (c & 31)) * 2; }
__device__ __forceinline__ int v_rd_base(int lane) { return ((lane & 3) << 3) | (((lane >> 2) & 3) << 6) | (((lane >> 4) & 1) << 5) | (((lane >> 5) & 1) << 8); }
constexpr int v_rd_off(int d0, int ks, int half) { return d0 * 512 + ks * 4096 + half * 2048; }
__device__ __forceinline__ int crow(int r, int hi) { return (r & 3) + 8 * (r >> 2) + 4 * hi; }
__device__ __forceinline__ unsigned cvtpk(float lo, float hi) { unsigned r; asm volatile("v_cvt_pk_bf16_f32 %0, %1, %2" : "=v"(r) : "v"(lo), "v"(hi)); return r; }

__device__ __forceinline__ void mask_tile(f32x16& p0, f32x16& p1, int dq, unsigned W, bool rowok) {
    const float NEG = -__builtin_inff();
#pragma unroll
    for (int r = 0; r < 16; ++r) {
        const int c = (r & 3) + 8 * (r >> 2);
        if (!rowok || (unsigned)(dq - c) >= W) p0[r] = NEG;
        if (!rowok || (unsigned)(dq - c - 32) >= W) p1[r] = NEG;
    }
}
__device__ __forceinline__ float rowmax32(const f32x16& p0, const f32x16& p1) {
    float pmax = p0[0];
#pragma unroll
    for (int r = 1; r < 16; ++r) pmax = fmaxf(pmax, p0[r]);
#pragma unroll
    for (int r = 0; r < 16; ++r) pmax = fmaxf(pmax, p1[r]);
    auto rr = __builtin_amdgcn_permlane32_swap(__float_as_uint(pmax), __float_as_uint(pmax), false, false);
    return fmaxf(__uint_as_float(rr[0]), __uint_as_float(rr[1]));
}
__device__ __forceinline__ float rowsum32(const f32x16& p0, const f32x16& p1) {
    float ps = 0.f;
#pragma unroll
    for (int r = 0; r < 16; ++r) ps += p0[r];
#pragma unroll
    for (int r = 0; r < 16; ++r) ps += p1[r];
    auto rr = __builtin_amdgcn_permlane32_swap(__float_as_uint(ps), __float_as_uint(ps), false, false);
    return __uint_as_float(rr[0]) + __uint_as_float(rr[1]);
}
__device__ __forceinline__ void pack_p(const f32x16& p0, const f32x16& p1, bf16x8& pa0, bf16x8& pa1, bf16x8& pa2, bf16x8& pa3) {
#define PK4(P, B_, OUT) do { unsigned a0 = cvtpk(P[B_+0], P[B_+1]), a1 = cvtpk(P[B_+2], P[B_+3]);                          \
        unsigned b0 = cvtpk(P[B_+4], P[B_+5]), b1 = cvtpk(P[B_+6], P[B_+7]);                                             \
        auto r0 = __builtin_amdgcn_permlane32_swap(a0, b0, false, false); auto r1 = __builtin_amdgcn_permlane32_swap(a1, b1, false, false); \
        u32x4 w = {r0[0], r1[0], r0[1], r1[1]}; OUT = *reinterpret_cast<bf16x8*>(&w); } while (0)
    PK4(p0, 0, pa0); PK4(p0, 8, pa1); PK4(p1, 0, pa2); PK4(p1, 8, pa3);
#undef PK4
}
__device__ __forceinline__ void qkt(f32x16& p0, f32x16& p1, const char* K_lds, int r32, int hi, const char* Qw) {
    p0 = f32x16{}; p1 = f32x16{};
    int ko[4];
#pragma unroll
    for (int dd = 0; dd < 4; ++dd) ko[dd] = KSWZ(r32, (dd * 16 + hi * 8) * 2);
#pragma unroll
    for (int d0 = 0; d0 < 8; ++d0) { const int off = ko[d0 & 3] + (d0 >> 2) * 128; const char* a = K_lds + off;
        bf16x8 b0 = *reinterpret_cast<const bf16x8*>(a);
        bf16x8 b1 = *reinterpret_cast<const bf16x8*>(a + 32 * 256);
        bf16x8 q = *reinterpret_cast<const bf16x8*>(Qw + off);
        p0 = __builtin_amdgcn_mfma_f32_32x32x16_bf16(b0, q, p0, 0, 0, 0);
        p1 = __builtin_amdgcn_mfma_f32_32x32x16_bf16(b1, q, p1, 0, 0, 0); }
}
__device__ __forceinline__ void q_park(char* Qw, int r32, int hi, int d0, bf16x8 v) { *(bf16x8*)(Qw + KSWZ(r32, (d0 * 16 + hi * 8) * 2)) = v; }
__device__ __forceinline__ void pv_tile(f32x16 (&o)[4], int vb0, bf16x8 pa0, bf16x8 pa1, bf16x8 pa2, bf16x8 pa3) {
#define TRRD(dst, off) asm volatile("ds_read_b64_tr_b16 %0, %1 offset:%2" : "=&v"(dst) : "v"(vb0), "i"(off) : "memory")
#define PV_RD(S_, d0) do { constexpr int b_ = v_rd_off(d0, 0, 0); \
        TRRD(S_##l0, b_); TRRD(S_##h0, b_ + 2048); TRRD(S_##l1, b_ + 4096); TRRD(S_##h1, b_ + 6144); TRRD(S_##l2, b_ + 8192); TRRD(S_##h2, b_ + 10240); TRRD(S_##l3, b_ + 12288); TRRD(S_##h3, b_ + 14336); } while (0)
#define PV_MM(S_, d0) do { \
        o[d0] = __builtin_amdgcn_mfma_f32_32x32x16_bf16(pa0, (bf16x8){S_##l0[0], S_##l0[1], S_##l0[2], S_##l0[3], S_##h0[0], S_##h0[1], S_##h0[2], S_##h0[3]}, o[d0], 0, 0, 0);   \
        o[d0] = __builtin_amdgcn_mfma_f32_32x32x16_bf16(pa1, (bf16x8){S_##l1[0], S_##l1[1], S_##l1[2], S_##l1[3], S_##h1[0], S_##h1[1], S_##h1[2], S_##h1[3]}, o[d0], 0, 0, 0);   \
        o[d0] = __builtin_amdgcn_mfma_f32_32x32x16_bf16(pa2, (bf16x8){S_##l2[0], S_##l2[1], S_##l2[2], S_##l2[3], S_##h2[0], S_##h2[1], S_##h2[2], S_##h2[3]}, o[d0], 0, 0, 0);   \
        o[d0] = __builtin_amdgcn_mfma_f32_32x32x16_bf16(pa3, (bf16x8){S_##l3[0], S_##l3[1], S_##l3[2], S_##l3[3], S_##h3[0], S_##h3[1], S_##h3[2], S_##h3[3]}, o[d0], 0, 0, 0); } while (0)
#define LWAIT() do { asm volatile("s_waitcnt lgkmcnt(0)" ::: "memory"); SBAR(); } while (0)
    s16x4 Al0, Al1, Al2, Al3, Ah0, Ah1, Ah2, Ah3, Bl0, Bl1, Bl2, Bl3, Bh0, Bh1, Bh2, Bh3;
    PV_RD(A, 0); LWAIT();
    PV_RD(B, 1); SBAR(); PV_MM(A, 0); LWAIT();
    PV_RD(A, 2); SBAR(); PV_MM(B, 1); LWAIT();
    PV_RD(B, 3); SBAR(); PV_MM(A, 2); LWAIT();
    PV_MM(B, 3);
#undef LWAIT
#undef PV_MM
#undef PV_RD
#undef TRRD
}

template <int MODE>
__device__ __forceinline__ void attn_tiles(f32x16 (&o)[4], float& m_reg, float& l_reg, const char* Qw, const bf16_t* Kb, const bf16_t* Vb, int ldk,
                                           int t_lo, int t_hi, int tpos, unsigned long long sel, int own, float rl, char* lds, int tid, int wid, int lane) {
    asm volatile("" : "+v"(tid)); asm volatile("" : "+v"(lane));
    const int r32 = lane & 31, hi = lane >> 5;
    float* al_l = (float*)(lds + OFF_WS) + wid * 64;
    const int sr = tid >> 4, sc = (tid & 15) * 8;
    const int kws = KSWZ(sr, sc * 2), vst0 = v_st(sr, sc), vst1 = v_st(32 + sr, sc);
    const int vbase = (int)(uintptr_t)(lds + OFF_V) + v_rd_base(lane);
    bf16x8 sk0, sk1, sv0, sv1;
    sk0 = sk1 = sv0 = sv1 = (bf16x8){0, 0, 0, 0, 0, 0, 0, 0};
    float carry = 0.f;
#define LOADT(tt) do { const bf16_t* kp_ = Kb + (size_t)((tt) * 64 + sr) * ldk + sc; sk0 = *(const bf16x8*)kp_; sk1 = *(const bf16x8*)(kp_ + (size_t)32 * ldk); \
        if (MODE != 3) { const bf16_t* vp_ = Vb + (size_t)((tt) * 64 + sr) * ldk + sc; sv0 = *(const bf16x8*)vp_; sv1 = *(const bf16x8*)(vp_ + (size_t)32 * ldk); } } while (0)
#define WRITET(bo) do { *(bf16x8*)(lds + (bo) + OFF_K + kws) = sk0; *(bf16x8*)(lds + (bo) + OFF_K + kws + 32 * 256) = sk1; \
        if (MODE != 3) { *(bf16x8*)(lds + (bo) + OFF_V + vst0) = sv0; *(bf16x8*)(lds + (bo) + OFF_V + vst1) = sv1; } } while (0)
    if (t_lo < t_hi) { LOADT(t_lo); __syncthreads(); WRITET(0); if (t_lo + 1 < t_hi) LOADT(t_lo + 1); __syncthreads(); }
    if (wid >= 4) __builtin_amdgcn_s_setprio(1);
    for (int t = t_lo; t < t_hi; ++t) {
        const int bo = ((t - t_lo) & 1) * KVBUF;
        if (t + 1 < t_hi) { WRITET(bo ^ KVBUF); if (t + 2 < t_hi) LOADT(t + 2); }
        const char* K_lds = lds + bo + OFF_K; const int vb0 = vbase + bo;
        bool rowok = true, needm = true; unsigned Wm = 0x7fffffffu;
        if (MODE == 0) { const int kb = t >> 2; if (kb < own) { rowok = ((sel >> kb) & 1ull) != 0ull; needm = false; } else needm = ((t - 4 * own) * 64 + 63 > 32 * wid); }
        if (MODE == 1) { rowok = ((sel >> t) & 1ull) != 0ull; needm = (t == t_hi - 1); }
        if (MODE == 2) { Wm = 512u; needm = (t == t_hi - 1) || (t == t_hi - 9); }
        bool skipw = (MODE == 0) && ((t >> 2) >= own) && ((t - 4 * own) * 64 > 32 * wid + 31);
        if (MODE == 0 || MODE == 1) skipw = skipw || !__any(rowok);
        if (!skipw) {
        f32x16 p0, p1;
        qkt(p0, p1, K_lds, r32, hi, Qw);
        if (needm) mask_tile(p0, p1, tpos - t * 64 - 4 * hi, Wm, true);
        const float NEGINF = -__builtin_inff();
        if (MODE == 3) {
            const float pmax = rowmax32(p0, p1);
            const float mn = fmaxf(m_reg, pmax); const float alpha = __builtin_amdgcn_exp2f((m_reg - mn) * C2); m_reg = mn;
            const float mnL = -mn * C2;
#pragma unroll
            for (int r = 0; r < 16; ++r) { p0[r] = __builtin_amdgcn_exp2f(fmaf(p0[r], C2, mnL)); p1[r] = __builtin_amdgcn_exp2f(fmaf(p1[r], C2, mnL)); }
            l_reg = l_reg * alpha + rowsum32(p0, p1);
        } else if (MODE == 4) {
            const float mnL = -m_reg * C2;
#pragma unroll
            for (int r = 0; r < 16; ++r) { p0[r] = __builtin_amdgcn_exp2f(fmaf(p0[r], C2, mnL)) * rl; p1[r] = __builtin_amdgcn_exp2f(fmaf(p1[r], C2, mnL)) * rl; }
            float* impA = (float*)(lds + OFF_IMP + wid * 2048);
#pragma unroll
            for (int half = 0; half < 2; ++half)
#pragma unroll
                for (int rr = 0; rr < 4; ++rr) {
                    float a = half ? ((p1[4 * rr] + p1[4 * rr + 1]) + (p1[4 * rr + 2] + p1[4 * rr + 3])) : ((p0[4 * rr] + p0[4 * rr + 1]) + (p0[4 * rr + 2] + p0[4 * rr + 3]));
                    float bl = half ? p1[4 * rr + 3] : p0[4 * rr + 3];
                    a += __shfl_xor(a, 1); a += __shfl_xor(a, 2); bl += __shfl_xor(bl, 1); bl += __shfl_xor(bl, 2);
                    const float other = __shfl_xor(bl, 32);
                    const float add = hi ? other : carry;
                    carry = other;
                    const int j = 16 * t + 8 * half + 2 * rr + hi;
                    if ((r32 & 3) == 0) impA[(r32 >> 2) * 64 + j] = a + add;
                }
            bf16x8 pa0, pa1, pa2, pa3; pack_p(p0, p1, pa0, pa1, pa2, pa3);
            pv_tile(o, vb0, pa0, pa1, pa2, pa3);
        } else {
            float pmax = rowmax32(p0, p1); pmax = rowok ? pmax : NEGINF;
            float mn, alpha;
            if (__all((pmax - m_reg) * SCALE <= 8.f)) { mn = m_reg; alpha = 1.f; }
            else { mn = fmaxf(m_reg, pmax); alpha = __builtin_amdgcn_exp2f((m_reg - mn) * C2); m_reg = mn; }
            const float mnL = rowok ? -mn * C2 : NEGINF;
#pragma unroll
            for (int r = 0; r < 16; ++r) { p0[r] = __builtin_amdgcn_exp2f(fmaf(p0[r], C2, mnL)); p1[r] = __builtin_amdgcn_exp2f(fmaf(p1[r], C2, mnL)); }
            l_reg = l_reg * alpha + rowsum32(p0, p1);
            bf16x8 pa0, pa1, pa2, pa3; pack_p(p0, p1, pa0, pa1, pa2, pa3);
            if (__any(alpha < 1.f)) {
                if (hi == 0) al_l[r32] = alpha;
                asm volatile("s_waitcnt lgkmcnt(0)" ::: "memory");
#pragma unroll
                for (int r = 0; r < 16; ++r) { const float f = al_l[crow(r, hi)];
#pragma unroll
                    for (int d_ = 0; d_ < 4; ++d_) o[d_][r] *= f; }
            }
            pv_tile(o, vb0, pa0, pa1, pa2, pa3);
        }
        }
        __syncthreads();
    }
    __builtin_amdgcn_s_setprio(0);
#undef LOADT
#undef WRITET
}

template <bool NSA, bool ACCUM>
__device__ __forceinline__ void store_o(const f32x16 (&o)[4], float f, bf16_t* OB, size_t rowbase, int tok0, int hbase, char* lds, int wid, int lane) {
    asm volatile("" : "+v"(lane));
    const int r32 = lane & 31, hi = lane >> 5;
    float* li_l = (float*)(lds + OFF_WS) + wid * 64 + 32;
    if (hi == 0) li_l[r32] = f;
    asm volatile("s_waitcnt lgkmcnt(0)" ::: "memory");
#pragma unroll
    for (int r = 0; r < 16; ++r) {
        const int rw = crow(r, hi); const float fr = li_l[rw];
        const int tok = NSA ? tok0 + (rw >> 2) : tok0 + rw, hd = NSA ? hbase + (rw & 3) : hbase;
        bf16_t* op = OB + (rowbase + tok) * D + hd * HD + r32;
#pragma unroll
        for (int d0 = 0; d0 < 4; ++d0) {
            float v = o[d0][r] * fr; float vn = __shfl_xor(v, 1);
            if ((r32 & 1) == 0) { unsigned* wp = (unsigned*)(op + d0 * 32);
                if (ACCUM) { const unsigned old = *wp; v += bflo(old); vn += bfhi(old); }
                *wp = cvtpk(v, vn); }
        }
    }
}
}

__device__ __forceinline__ void moba_unit(const Params& P, int b, int h, int own, char* lds, int tid, int wid, int lane) {
    using namespace at;
    const bf16_t* BIG = (const bf16_t*)(P.ws + WS_BIG); const float* KMEAN = (const float*)(P.ws + WS_KMEAN); bf16_t* OB = (bf16_t*)(P.ws + WS_OB);
    const int r32 = lane & 31, hi = lane >> 5;
    const int tokl = own * 256 + wid * 32 + r32; const size_t row = (size_t)b * S + tokl;
    char* Qw = lds + OFF_Q + wid * 8192;
#pragma unroll
    for (int d0 = 0; d0 < 8; ++d0) q_park(Qw, r32, hi, d0, *(const bf16x8*)(BIG + row * MQ_LD + h * HD + d0 * 16 + hi * 8));
    char* K_lds = lds + OFF_K;
    { const int sr = tid >> 4, sc = (tid & 15) * 8; const int kws = KSWZ(sr, sc * 2);
      bf16x8 z0 = (bf16x8){0, 0, 0, 0, 0, 0, 0, 0}; const bf16x8 z1 = z0;
      if (sr < 16) { const float* km = KMEAN + (size_t)((b * NH + h) * 16 + sr) * HD + sc; z0 = pack8(*(const f32x4*)km, *(const f32x4*)(km + 4)); }
      __syncthreads();
      *(bf16x8*)(K_lds + kws) = z0; *(bf16x8*)(K_lds + kws + 32 * 256) = z1;
      __syncthreads(); }
    unsigned sel = 0u;
    { f32x16 p0, p1; qkt(p0, p1, K_lds, r32, hi, Qw);
      float g[16];
#pragma unroll
      for (int r = 0; r < 8; ++r) { const float mine = p0[r], other = __shfl_xor(mine, 32); const int nb = (r & 3) + 8 * (r >> 2);
          g[nb] = hi == 0 ? mine : other; g[nb + 4] = hi == 0 ? other : mine; }
      if (own <= 3) sel = (1u << own) - 1u;
      else {
#pragma unroll
          for (int pass = 0; pass < 3; ++pass) { float best = 0.f; int bi = -1;
#pragma unroll
              for (int n = 0; n < 16; ++n) { const bool cand = (n < own) && (((sel >> n) & 1u) == 0u); if (cand && (bi < 0 || g[n] > best)) { best = g[n]; bi = n; } }
              sel |= 1u << bi; }
      } }
    f32x16 o[4]; o[0] = f32x16{}; o[1] = f32x16{}; o[2] = f32x16{}; o[3] = f32x16{};
    float m_reg = -1e30f, l_reg = 0.f;
    const bf16_t* Kb = BIG + (size_t)b * S * MQ_LD + D + h * HD; const bf16_t* Vb = Kb + D;
    attn_tiles<0>(o, m_reg, l_reg, Qw, Kb, Vb, MQ_LD, 0, 4 * own + 4, tokl, (unsigned long long)sel, own, 0.f, lds, tid, wid, lane);
    store_o<false, false>(o, 1.f / l_reg, OB, (size_t)b * S, own * 256 + wid * 32, h, lds, wid, lane);
}
__device__ __forceinline__ void phase_moba_attn(const Params& P, char* lds, int bid, int G, int tid, int wid, int lane) {
    asm volatile("" : "+v"(tid)); asm volatile("" : "+v"(lane));
    for (int p0 = bid; p0 < NB * NH * 8; p0 += G) {
        int pr = p0; if (G == 256) { const int xcd = p0 & 7, slot = p0 >> 3; pr = (xcd * 4 + (slot >> 3)) * 8 + (slot & 7); }
        const int x = pr & 7, h = (pr >> 3) & 15, b = pr >> 7;
        moba_unit(P, b, h, 15 - x, lds, tid, wid, lane);
        moba_unit(P, b, h, x, lds, tid, wid, lane);
    }
}

__device__ __forceinline__ void nsa_unit(const Params& P, int b, int g, int c, char* lds, int tid, int wid, int lane) {
    using namespace at;
    const bf16_t* BIG = (const bf16_t*)(P.ws + WS_BIG); const bf16_t* QROT = (const bf16_t*)(P.ws + WS_PP); bf16_t* OB = (bf16_t*)(P.ws + WS_OB);
    const int r32 = lane & 31, hi = lane >> 5;
    const int tokl = 64 * c + 8 * wid + (r32 >> 2), head = 4 * g + (r32 & 3); const size_t row = (size_t)b * S + tokl;
    char* Qw = lds + OFF_Q + wid * 8192;
#pragma unroll
    for (int d0 = 0; d0 < 8; ++d0) q_park(Qw, r32, hi, d0, *(const bf16x8*)(BIG + row * NQ_LD + head * HD + d0 * 16 + hi * 8));
    f32x16 o[4]; o[0] = f32x16{}; o[1] = f32x16{}; o[2] = f32x16{}; o[3] = f32x16{};
    float m_reg = -1e30f, l_reg = 0.f;
    const bf16_t* Kc = (const bf16_t*)(P.ws + WS_KC) + (size_t)(b * 4 + g) * 256 * HD; const bf16_t* Vc = (const bf16_t*)(P.ws + WS_VC) + (size_t)(b * 4 + g) * 256 * HD;
    const int tq = (tokl - 31) >> 4;
    const int ncmp = ((4 * c + 2) >> 6) + 1;
    attn_tiles<3>(o, m_reg, l_reg, Qw, Kc, Vc, HD, 0, ncmp, tq, 0ull, 0, 0.f, lds, tid, wid, lane);
    const float rl = l_reg > 0.f ? 1.f / l_reg : 0.f;
    attn_tiles<4>(o, m_reg, l_reg, Qw, Kc, Vc, HD, 0, ncmp, tq, 0ull, 0, rl, lds, tid, wid, lane);
    store_o<true, false>(o, sigmoidf_(bf1(BIG[row * NQ_LD + 5120 + head * 3 + 0])), OB, (size_t)b * S, 64 * c + 8 * wid, 4 * g, lds, wid, lane);
    unsigned long long sel;
    { float* impA = (float*)(lds + OFF_IMP + wid * 2048);
      unsigned long long* selm = (unsigned long long*)(lds + OFF_SELM + wid * 64);
      asm volatile("s_waitcnt lgkmcnt(0)" ::: "memory");
      const float INF = __builtin_inff();
      for (int tk = 0; tk < 8; ++tk) {
          float val = impA[tk * 64 + lane];
          if (lane == 0 || lane == c) val = INF; else if (lane > c) val = -INF;
          const unsigned u_ = __float_as_uint(val); const unsigned key = (u_ & 0x80000000u) ? ~u_ : (u_ | 0x80000000u);
          unsigned thr = 0u;
#pragma unroll
          for (int bit = 31; bit >= 0; --bit) { const unsigned cand = thr | (1u << bit); if (__popcll(__ballot(key >= cand)) >= 16) thr = cand; }
          const unsigned long long gt_ = __ballot(key > thr), eq_ = __ballot(key == thr);
          const int need = 16 - __popcll(gt_), eqrank = __popcll(eq_ & ((1ull << lane) - 1ull));
          const bool s = ((key > thr) || (key == thr && eqrank < need)) && (val > -INF);
          const unsigned long long mk = __ballot(s);
          if (lane == 0) selm[tk] = mk;
      }
      asm volatile("s_waitcnt lgkmcnt(0)" ::: "memory");
      sel = selm[r32 >> 2]; }
    {
      const int pos_ = ((const int*)P.in[2])[row];
      const u32x4 w1 = *(const u32x4*)(Qw + KSWZ(r32, (0 * 16 + hi * 8) * 2)), w2 = *(const u32x4*)(Qw + KSWZ(r32, (1 * 16 + hi * 8) * 2));
      float x1[8] = {bflo(w1.x), bfhi(w1.x), bflo(w1.y), bfhi(w1.y), bflo(w1.z), bfhi(w1.z), bflo(w1.w), bfhi(w1.w)};
      float x2[8] = {bflo(w2.x), bfhi(w2.x), bflo(w2.y), bfhi(w2.y), bflo(w2.z), bfhi(w2.z), bflo(w2.w), bfhi(w2.w)};
#pragma unroll
      for (int j = 0; j < 8; ++j) { const int i_ = hi * 8 + j;
          const float freq = __builtin_amdgcn_exp2f(-(float)i_ * (18.931568569324174f / 16.0f));
          const float ang = (float)pos_ * freq; const double rev = (double)ang * 0.15915494309189535; const float fr_ = (float)(rev - floor(rev));
          const float c_ = __builtin_amdgcn_cosf(fr_), s_ = __builtin_amdgcn_sinf(fr_);
          const float a1 = x1[j], a2 = x2[j]; x1[j] = a1 * c_ - a2 * s_; x2[j] = a2 * c_ + a1 * s_; }
      q_park(Qw, r32, hi, 0, pack8((f32x4){x1[0], x1[1], x1[2], x1[3]}, (f32x4){x1[4], x1[5], x1[6], x1[7]}));
      q_park(Qw, r32, hi, 1, pack8((f32x4){x2[0], x2[1], x2[2], x2[3]}, (f32x4){x2[4], x2[5], x2[6], x2[7]})); }
    o[0] = f32x16{}; o[1] = f32x16{}; o[2] = f32x16{}; o[3] = f32x16{}; m_reg = -1e30f; l_reg = 0.f;
    const bf16_t* kvb = BIG + (size_t)b * S * NQ_LD + D + g * HD;
    attn_tiles<1>(o, m_reg, l_reg, Qw, kvb + 2 * 512, kvb + 3 * 512, NQ_LD, 0, c + 1, tokl, sel, 0, 0.f, lds, tid, wid, lane);
    store_o<true, true>(o, sigmoidf_(bf1(BIG[row * NQ_LD + 5120 + head * 3 + 1])) / l_reg, OB, (size_t)b * S, 64 * c + 8 * wid, 4 * g, lds, wid, lane);
    o[0] = f32x16{}; o[1] = f32x16{}; o[2] = f32x16{}; o[3] = f32x16{}; m_reg = -1e30f; l_reg = 0.f;
    attn_tiles<2>(o, m_reg, l_reg, Qw, kvb + 4 * 512, kvb + 5 * 512, NQ_LD, (c > 8 ? c - 8 : 0), c + 1, tokl, 0ull, 0, 0.f, lds, tid, wid, lane);
    store_o<true, true>(o, sigmoidf_(bf1(BIG[row * NQ_LD + 5120 + head * 3 + 2])) / l_reg, OB, (size_t)b * S, 64 * c + 8 * wid, 4 * g, lds, wid, lane);
}
__device__ __forceinline__ void phase_nsa_attn(const Params& P, char* lds, int bid, int G, int tid, int wid, int lane) {
    asm volatile("" : "+v"(tid)); asm volatile("" : "+v"(lane));
    for (int p0 = bid; p0 < NB * 4 * 32; p0 += G) {
        int pr = p0; if (G == 256) { const int xcd = p0 & 7, slot = p0 >> 3; pr = xcd * 32 + slot; }
        const int x = pr & 31, g = (pr >> 5) & 3, b = pr >> 7;
        nsa_unit(P, b, g, 63 - x, lds, tid, wid, lane);
        nsa_unit(P, b, g, x, lds, tid, wid, lane);
    }
}
typedef unsigned v4u __attribute__((ext_vector_type(4)));
#define XB_TMO      128
#define XB_XCNT(j)  (256  + 64 * (j))
#define XB_XSUB(j)  (1280 + 64 * (j))
#define XB_XGEN(j)  (2304 + 64 * (j))
#define XB_TOP      3328
#define XB_TOPGEN   3392
#define XCD_BAR_WORDS 3456
#define XB_SPIN_CAP (1u << 18)

__device__ __forceinline__ unsigned xb_ld(unsigned* p)              { return __hip_atomic_load(p, __ATOMIC_RELAXED, __HIP_MEMORY_SCOPE_AGENT); }
__device__ __forceinline__ unsigned xb_add(unsigned* p, unsigned v) { return __hip_atomic_fetch_add(p, v, __ATOMIC_RELAXED, __HIP_MEMORY_SCOPE_AGENT); }
__device__ __forceinline__ unsigned xb_xcc_id() { return (unsigned)__builtin_amdgcn_s_getreg((3 << 11) | 20) & 0xFu; }
#define XB_SPIN(cond, bar) do { unsigned _sp = 0; while (cond) { __builtin_amdgcn_s_sleep(1); \
    if ((++_sp & 255u) == 0u) { if (xb_ld(&(bar)[XB_TMO])) break; if (_sp > XB_SPIN_CAP) { atomicAdd(&(bar)[XB_TMO], 1u); break; } } } } while (0)

struct XcdBarrier {
    unsigned* bar; unsigned x;
    volatile LAS unsigned* st;
};

__device__ __forceinline__ XcdBarrier xcd_barrier_post(unsigned* bar, volatile LAS unsigned* st) {
    XcdBarrier b; b.bar = bar; b.x = xb_xcc_id(); b.st = st;
    if (threadIdx.x == 0) (void)xb_add(&bar[XB_XCNT(b.x)], 1u);
    return b;
}
__device__ __forceinline__ void xcd_barrier_complete(unsigned* bar, unsigned x, unsigned& nloc, unsigned& nx) {
    const unsigned G = gridDim.x * gridDim.y * gridDim.z;
    unsigned sum, cnt, mine, sp = 0u;
    for (;;) {
        sum = 0u; cnt = 0u; mine = 0u;
#pragma unroll
        for (unsigned j = 0; j < 16; ++j) { const unsigned c = xb_ld(&bar[XB_XCNT(j)]); sum += c; cnt += (c > 0u) ? 1u : 0u; mine = (j == x) ? c : mine; }
        if (sum == G) break;
        __builtin_amdgcn_s_sleep(1);
        if ((++sp & 255u) == 0u) { if (xb_ld(&bar[XB_TMO])) break; if (sp > XB_SPIN_CAP) { atomicAdd(&bar[XB_TMO], 1u); break; } }
    }
    nloc = mine > 0u ? mine : 1u; nx = cnt > 0u ? cnt : 1u;
}

__device__ __forceinline__ void xcd_barrier(const XcdBarrier& b) {
    asm volatile("s_waitcnt vmcnt(0)" ::: "memory");
    __syncthreads();
    if (threadIdx.x == 0) {
        unsigned* bar = b.bar;
        __builtin_amdgcn_s_waitcnt(0);
        unsigned nloc = b.st[0], nx = b.st[1];
        if (nloc == 0u) { xcd_barrier_complete(bar, b.x, nloc, nx); b.st[0] = nloc; b.st[1] = nx; }
        const unsigned old = xb_add(&bar[XB_XSUB(b.x)], 1u);
        const unsigned gen = old / nloc;
        if (old + 1u == (gen + 1u) * nloc) {
            __builtin_amdgcn_fence(__ATOMIC_RELEASE, "agent");
            asm volatile("s_waitcnt vmcnt(0)" ::: "memory");
            const unsigned og = xb_add(&bar[XB_TOP], 1u);
            const unsigned tg = og / nx;
            if (og + 1u == (tg + 1u) * nx) xb_add(&bar[XB_TOPGEN], 1u);
            else XB_SPIN(xb_ld(&bar[XB_TOPGEN]) == tg, bar);
            __builtin_amdgcn_fence(__ATOMIC_ACQUIRE, "agent");
            xb_add(&bar[XB_XGEN(b.x)], 1u);
            asm volatile("s_waitcnt vmcnt(0)" ::: "memory");
        } else {
            XB_SPIN(xb_ld(&bar[XB_XGEN(b.x)]) == gen, bar);
            __builtin_amdgcn_fence(__ATOMIC_ACQUIRE, "agent");
            asm volatile("s_waitcnt vmcnt(0)" ::: "memory");
        }
    }
    __syncthreads();
}

__global__ void __launch_bounds__(NTHREADS, 2) trunk_fwd(Params P) {
    extern __shared__ __attribute__((aligned(16))) unsigned char lds_raw[];
    char* lds = (char*)lds_raw;
    cg::grid_group grid = cg::this_grid();
    const int tid = threadIdx.x, lane = tid & 63, wid = __builtin_amdgcn_readfirstlane(tid >> 6);
    const int bid = blockIdx.x, G = gridDim.x;
    const int gw = bid * NWAVES + wid, NGW = G * NWAVES, gtid = bid * NTHREADS + tid, NT = G * NTHREADS;
    unsigned char* ws = P.ws;
    const float* x = (const float*)P.in[0];
    float* out = P.out;
    bf16_t* XN = (bf16_t*)(ws + WS_XN); bf16_t* OB = (bf16_t*)(ws + WS_OB); bf16_t* PPB = (bf16_t*)(ws + WS_PP); bf16_t* BIG = (bf16_t*)(ws + WS_BIG);

    volatile LAS unsigned* bst = (volatile LAS unsigned*)((LAS unsigned char*)lds_raw + LDS_BYTES - 16);
    if (tid == 0) { bst[0] = 0u; bst[1] = 0u; }
    __syncthreads();
    const XcdBarrier bar = xcd_barrier_post((unsigned*)(ws + WS_CTL), bst);
#define GSYNC() do { XcdBarrier b2_ = bar; asm volatile("" : "+s"(b2_.x)); xcd_barrier(b2_); } while (0)
    phase_convert(P, lds, gw, NGW, gtid, NT, wid, lane);
    __syncthreads();
    if (P.out == nullptr) grid.sync();
    GSYNC();

    bf16_t* hbc = XN;
    bf16_t* hbo = (bf16_t*)(ws + WS_HB1);
    unsigned* SS = (unsigned*)(ws + WS_SS);
    for (int i = 0; i < 4; ++i) {
        if (i == 1) {
            phase_pool_prep(hbc, SS + (size_t)(3 * i) * T, (const float*)P.in[3] + (size_t)i * D, OB, lds, bid, G, tid, wid, lane);
            GSYNC();
            for (int gq = 0; gq < 4; ++gq) {
                pg8::EpiH<0> E{nullptr, hbc, nullptr, (const float*)P.in[15], gq * 512, nullptr, nullptr, hbc, SS + (size_t)(3 * i + 1) * T};
                gemm_run(lds, OB + gq * 512, D, (const bf16_t*)(ws + WS_POOL) + (size_t)gq * 512 * 512, 512, T, 512, 512, G, (bid + gq * (G / 4)) % G, E);
            }
            GSYNC();
        } else {
            { const bf16_t* Wt = (const bf16_t*)(ws + (i == 0 ? WS_MQKV : (i == 2 ? WS_NQKV : WS_CIN))); const int N = (i == 2) ? NQ_LD : MQ_LD;
              pg8::EpiB<0> E{BIG, N, SS + (size_t)(3 * i) * T};
              gemm_run(lds, hbc, D, Wt, D, T, N, D, G, bid, E); }
            GSYNC();
            if (i == 0) {
                phase_moba_prep(P, lds, bid, G, tid, wid, lane);
                GSYNC();
                phase_moba_attn(P, lds, bid, G, tid, wid, lane);
            } else if (i == 2) {
                phase_nsa_norm(P, gw, NGW, lane);
                phase_nsa_compress(P, lds, bid, G, tid, wid, lane);
                GSYNC();
                phase_nsa_attn(P, lds, bid, G, tid, wid, lane);
            } else {
                phase_conv_elem(P, gtid, NT);
            }
            __syncthreads();
            GSYNC();
            { const bf16_t* Wt = (const bf16_t*)(ws + (i == 0 ? WS_MWO : (i == 2 ? WS_NWO : WS_CWO)));
              pg8::EpiH<0> E{(i == 0) ? x : nullptr, hbc, nullptr, nullptr, 0, nullptr, nullptr, hbc, SS + (size_t)(3 * i + 1) * T};
              gemm_run(lds, OB, D, Wt, D, T, D, D, G, bid, E); }
            GSYNC();
        }
        { pg8::EpiB<2> E{BIG, FF, nullptr};
          gemm_run(lds, hbc, D, (const bf16_t*)(ws + WS_W1T + (size_t)i * 32 * MiB), D, T, FF, D, G, bid, E); }
        { pg8::EpiB<0> E{PPB, D, nullptr};
          gemm_run(lds, (const bf16_t*)(ws + WS_PB) + (size_t)i * T * 256, 256, (const bf16_t*)(ws + WS_PPT + (size_t)i * 1 * MiB), 256, T, D, 256, G, bid, E); }
        GSYNC();
        { pg8::EpiH<0> E{nullptr, hbc, nullptr, nullptr, 0, nullptr, SS + (size_t)(3 * i + 1) * T, hbc, SS + (size_t)(3 * i + 2) * T};
          gemm_run(lds, BIG, FF, (const bf16_t*)(ws + WS_W2T + (size_t)i * 32 * MiB), FF, T, D, FF, G, bid, E); }
        GSYNC();
        { pg8::EpiH<1> E{nullptr, hbc, (i == 3) ? out : nullptr, nullptr, 0, PPB, SS + (size_t)(3 * i + 2) * T, (i < 3) ? hbo : nullptr, (i < 3) ? SS + (size_t)(3 * i + 3) * T : nullptr};
          gemm_run(lds, hbc, D, (const bf16_t*)(ws + WS_PGT + (size_t)i * 8 * MiB), D, T, D, D, G, bid, E); }
        if (i < 3) { GSYNC(); bf16_t* tsw = hbc; hbc = hbo; hbo = tsw; }
    }
}

extern "C" void kernel_launch(void* const* d_in, const int* in_sizes, int n_in, void* d_out, int out_size, void* d_ws, size_t ws_size, hipStream_t stream) {
    static int grid = 0;
    if (grid == 0) {
        if (n_in != 29 || out_size != T * D || ws_size < WS_END) { fprintf(stderr, "kernel_launch: unexpected problem (n_in %d, out %d, ws %zu)\n", n_in, out_size, ws_size); grid = -1; return; }
        int dev = 0, cus = 0, per_cu = 0;
        hipGetDevice(&dev);
        hipDeviceGetAttribute(&cus, hipDeviceAttributeMultiprocessorCount, dev);
        hipFuncSetAttribute((const void*)trunk_fwd, hipFuncAttributeMaxDynamicSharedMemorySize, LDS_BYTES);
        hipOccupancyMaxActiveBlocksPerMultiprocessor(&per_cu, (const void*)trunk_fwd, NTHREADS, LDS_BYTES);
        (void)hipGetLastError();
        if (per_cu < 1) { fprintf(stderr, "kernel_launch: occupancy query says %d blocks per CU\n", per_cu); per_cu = 1; }
        grid = cus;
        fprintf(stderr, "kernel_launch: cus %d per_cu %d grid %d\n", cus, per_cu, grid);
    }
    if (grid < 0) return;
    if (hipMemsetAsync((char*)d_ws + WS_CTL, 0, 1048576, stream) != hipSuccess) { fprintf(stderr, "kernel_launch: memset failed\n"); return; }
    Params p{};
    for (int i = 0; i < 29; ++i) p.in[i] = d_in[i];
    p.out = (float*)d_out; p.ws = (unsigned char*)d_ws;
    void* args[] = {&p};
    hipError_t e = hipLaunchCooperativeKernel((const void*)trunk_fwd, dim3(grid), dim3(NTHREADS), args, LDS_BYTES, stream);
    if (e != hipSuccess) fprintf(stderr, "cooperative launch failed: %s (grid %d)\n", hipGetErrorString(e), grid);
}
```

```cpp
#include <hip/hip_runtime.h>
#include <hip/hip_cooperative_groups.h>
#include <cstdio>
#include <cstdint>
namespace cg = cooperative_groups;
namespace pg8 {
#define PG8_LAS __attribute__((address_space(3)))
typedef unsigned short bf16_t;
typedef short bf16x8 __attribute__((ext_vector_type(8)));
typedef float f32x4 __attribute__((ext_vector_type(4)));
typedef unsigned u32x4 __attribute__((ext_vector_type(4)));
typedef unsigned u32x2_ __attribute__((ext_vector_type(2)));
constexpr int BM = 256, BK = 64, HALF = 128, HTB = HALF * BK * 2  , STAGE_BYTES = 8 * HTB, NXCD = 8, WGM = 8;

__host__ __device__ __forceinline__ int lds_byte(int r, int c) { const int st = (r >> 4) * 2 + (c >> 5), rr = r & 15, cc = c & 31, ob = rr * 64 + cc * 2; return st * 1024 + (ob ^ (((ob >> 9) & 1) << 5)); }
__host__ __device__ __forceinline__ void stage_rc(int b, int& R, int& C) { const int st = b / 1024, sb = b % 1024, swz = sb ^ (((sb >> 9) & 1) << 5); R = (st >> 1) * 16 + swz / 64; C = (st & 1) * 32 + (swz % 64) / 2; }
__host__ __device__ __forceinline__ int perm32(int rho) { const int n = rho >> 4, i = rho & 15; return 8 * (i >> 2) + 4 * n + (i & 3); }

struct Unit { int pm, pn; };
struct Gemm { const bf16_t* A; const bf16_t* Bt; int M, N, K, lda, ldb; };

struct StaticOrder {
    int nM, nN, nwg, G, c;
    __host__ __device__ void init(int M, int N, int G_, int c_) { nM = M / BM; nN = N / BM; nwg = nM * nN; G = G_; c = c_; }
    __host__ __device__ bool next(int i, Unit& u) const {
        const long L = (long)i * G + c; if (L >= nwg) return false;
        int wgid = (int)L; { const int q = nwg / NXCD, r = nwg % NXCD, xcd = wgid % NXCD, off = wgid / NXCD; wgid = (xcd < r ? xcd * (q + 1) : r * (q + 1) + (xcd - r) * q) + off; }
        const int nig = WGM * nN, gid = wgid / nig, fm = gid * WGM, gsz = (nM - fm) < WGM ? (nM - fm) : WGM;
        u.pm = fm + ((wgid % nig) % gsz); u.pn = (wgid % nig) / gsz; return true;
    }
    __device__ __forceinline__ void a_ready(const Unit&) const {}
    __device__ __forceinline__ void done(const Unit&) const {}
};

__device__ __forceinline__ unsigned cvt_pk_bf16(float lo, float hi) { unsigned r; asm volatile("v_cvt_pk_bf16_f32 %0, %1, %2" : "=v"(r) : "v"(lo), "v"(hi)); return r; }
typedef float f32x2 __attribute__((ext_vector_type(2)));
__device__ __forceinline__ f32x2 gelu_pk(f32x2 v) {
    const f32x2 av = __builtin_elementwise_abs(v), d = av * 0.2316418882f + 1.0f;
    f32x2 t; t.x = __builtin_amdgcn_rcpf(d.x); t.y = __builtin_amdgcn_rcpf(d.y);
    f32x2 q = t * 0.5307027145f + (-0.7265760135f); q = q * t + 0.7107068705f; q = q * t + (-0.142248368f); q = q * t + 0.127414796f; q = q * t;
    const f32x2 s = (v * v) * (-0.72134752044f);
    f32x2 e; e.x = __builtin_amdgcn_exp2f(s.x); e.y = __builtin_amdgcn_exp2f(s.y);
    const f32x2 m = v * (q * e), r = v - m;
    f32x2 o; o.x = v.x < 0.f ? m.x : r.x; o.y = v.y < 0.f ? m.y : r.y; return o;
}

template <int ACT  > struct EpiBf16 {
    static constexpr bool PERM = true, AFTER_DRAIN = false; static_assert(ACT == 0 || ACT == 1, "EpiBf16: ACT is 0 (none) or 1 (gelu_pk)");
    bf16_t* O; int ldc; const float* bias; int split_cols; size_t split_stride; float scale0;
    __device__ __forceinline__ void operator()(const f32x4 (&acc)[2][2][4][2], const Unit& u, int wr, int wc, int fr, int fq) const {
        const int row0 = u.pm * BM + wr * 64 + fr; int colt = u.pn * BM; bf16_t* base = O;
        float sc = 1.f; if (split_cols) { const int t = colt / split_cols; base += (size_t)t * split_stride; colt -= t * split_cols; if (t == 0) sc = scale0; }
        const int col0 = colt + wc * 32 + 8 * fq, bcol0 = u.pn * BM + wc * 32 + 8 * fq;
        f32x4 bv[2][2];
#pragma unroll
        for (int bj = 0; bj < 2; ++bj)
#pragma unroll
            for (int n = 0; n < 2; ++n) bv[bj][n] = bias ? *(const f32x4*)(bias + bcol0 + bj * HALF + 4 * n) : (f32x4){0.f, 0.f, 0.f, 0.f};
#pragma unroll
        for (int ai = 0; ai < 2; ++ai)
#pragma unroll
            for (int m = 0; m < 4; ++m) { bf16_t* rowp = base + (size_t)(row0 + ai * HALF + m * 16) * ldc + col0;
#pragma unroll
                for (int bj = 0; bj < 2; ++bj) { f32x4 v0 = acc[ai][bj][m][0] + bv[bj][0], v1 = acc[ai][bj][m][1] + bv[bj][1];
                    if (ACT == 1) { f32x2 a = gelu_pk((f32x2){v0[0], v0[1]}), b = gelu_pk((f32x2){v0[2], v0[3]}), c = gelu_pk((f32x2){v1[0], v1[1]}), d = gelu_pk((f32x2){v1[2], v1[3]});
                        v0 = (f32x4){a.x, a.y, b.x, b.y}; v1 = (f32x4){c.x, c.y, d.x, d.y}; }
                    v0 = v0 * sc; v1 = v1 * sc; u32x4 w; w.x = cvt_pk_bf16(v0[0], v0[1]); w.y = cvt_pk_bf16(v0[2], v0[3]); w.z = cvt_pk_bf16(v1[0], v1[1]); w.w = cvt_pk_bf16(v1[2], v1[3]);
                    *(u32x4*)(rowp + bj * HALF) = w; } }
    }
};
template <class Epi, class Sched, bool ALIGN_EPI = false, bool SP2 = false>
__device__ __forceinline__ void gemm_phase(PG8_LAS unsigned char* lds, const Gemm g, const Sched& S, const Epi& E) {
    int tid_ = threadIdx.x; asm volatile("" : "+v"(tid_)); const int tid = tid_, wid = __builtin_amdgcn_readfirstlane(tid >> 6), lane = tid & 63, wr = wid >> 2, wc = wid & 3, fr = lane & 15, fq = lane >> 4;
    const int K = g.K, nt = K / BK;
    unsigned voffA[2], voffB[2];
#pragma unroll
    for (int i = 0; i < 2; ++i) { int R, C; stage_rc(tid * 16 + i * 8192, R, C); const int Rb = Epi::PERM ? ((R & ~31) + perm32(R & 31)) : R;
        voffA[i] = (unsigned)(R * g.lda + C) * 2u; voffB[i] = (unsigned)(Rb * g.ldb + C) * 2u; }
    const size_t kstep = (size_t)(BK * 2);
    const size_t hstepA = (size_t)HALF * g.lda * 2, hstepB = (size_t)HALF * g.ldb * 2;
    const size_t tstepA = 2 * hstepA, tstepB = 2 * hstepB;
    const unsigned ldsw = (unsigned)wid * 1024u;
    const int aoff = lds_byte(wr * 64 + fr, fq * 8), boff = lds_byte(wc * 32 + fr, fq * 8);
#define PG8_SA(b, h) (((b) * 2 + (h)) * HTB)
#define PG8_SB(b, h) ((4 + (b) * 2 + (h)) * HTB)
#define PG8_STAGE(bufoff, gbase, voff) do { _Pragma("unroll") for (int _i = 0; _i < 2; ++_i) \
        __builtin_amdgcn_global_load_lds((const unsigned*)((const char*)(gbase) + (voff)[_i]), (PG8_LAS unsigned*)(lds + (bufoff) + ldsw + _i * 8192), 16, 0, 0); } while (0)
#define PG8_LDA(dst, b, h) do { _Pragma("unroll") for (int m = 0; m < 4; ++m) _Pragma("unroll") for (int k = 0; k < 2; ++k) dst[m][k] = *(const PG8_LAS bf16x8*)(lds + PG8_SA(b, h) + aoff + m * 2048 + k * 1024); } while (0)
#define PG8_LDB(dst, b, h) do { _Pragma("unroll") for (int n = 0; n < 2; ++n) _Pragma("unroll") for (int k = 0; k < 2; ++k) dst[n][k] = *(const PG8_LAS bf16x8*)(lds + PG8_SB(b, h) + boff + n * 2048 + k * 1024); } while (0)
#define PG8_MMA(ai, bj, At, Bt) do { __builtin_amdgcn_s_setprio(1); _Pragma("unroll") for (int m = 0; m < 4; ++m) _Pragma("unroll") for (int n = 0; n < 2; ++n) _Pragma("unroll") for (int k = 0; k < 2; ++k) \
        acc[ai][bj][m][n] = __builtin_amdgcn_mfma_f32_16x16x32_bf16(Bt[n][k], At[m][k], acc[ai][bj][m][n], 0, 0, 0); __builtin_amdgcn_s_setprio(0); } while (0)
#define PG8_WAIT_V(n) asm volatile("s_waitcnt vmcnt(" #n ")" ::: "memory")
#define PG8_WAIT_L(n) asm volatile("s_waitcnt lgkmcnt(" #n ")" ::: "memory")
#define PG8_BAR __builtin_amdgcn_s_barrier()
#define PG8_SCHED __builtin_amdgcn_sched_barrier(0)
    Unit cur, nxt; int ui = 0;
    if (!S.next(0, cur)) return;
    f32x4 acc[2][2][4][2];
#pragma unroll
    for (int a = 0; a < 2; ++a)
#pragma unroll
        for (int b = 0; b < 2; ++b)
#pragma unroll
            for (int m = 0; m < 4; ++m)
#pragma unroll
                for (int n = 0; n < 2; ++n) acc[a][b][m][n] = (f32x4){0.f, 0.f, 0.f, 0.f};
    bf16x8 At[4][2], B0[2][2], B1[2][2];
    const char* cA = (const char*)g.A + (size_t)cur.pm * tstepA; const char* cB = (const char*)g.Bt + (size_t)cur.pn * tstepB;
    S.a_ready(cur);
    if constexpr (SP2) {
        PG8_STAGE(PG8_SB(0, 0), cB, voffB); PG8_STAGE(PG8_SB(0, 1), cB + hstepB, voffB); PG8_STAGE(PG8_SA(0, 0), cA, voffA); PG8_STAGE(PG8_SA(0, 1), cA + hstepA, voffA);
        if (wr == 1) PG8_BAR;
        PG8_WAIT_V(2); PG8_BAR;
        PG8_STAGE(PG8_SB(1, 0), cB + kstep, voffB); PG8_STAGE(PG8_SA(1, 0), cA + kstep, voffA); PG8_STAGE(PG8_SB(1, 1), cB + hstepB + kstep, voffB);
        PG8_WAIT_V(6); PG8_BAR;
    } else {
        PG8_STAGE(PG8_SB(0, 0), cB, voffB); PG8_STAGE(PG8_SA(0, 0), cA, voffA); PG8_STAGE(PG8_SB(0, 1), cB + hstepB, voffB); PG8_STAGE(PG8_SA(0, 1), cA + hstepA, voffA);
        if (wr == 1) PG8_BAR;
        PG8_WAIT_V(4); PG8_BAR;
        PG8_STAGE(PG8_SB(1, 0), cB + kstep, voffB); PG8_STAGE(PG8_SA(1, 0), cA + kstep, voffA); PG8_STAGE(PG8_SB(1, 1), cB + hstepB + kstep, voffB);
        PG8_WAIT_V(6); PG8_BAR;
    }
    for (;;) {
        const bool has_next = S.next(ui + 1, nxt);
        E.pre(lds + STAGE_BYTES, cur, wr, fr, wid);
        const char* nA = has_next ? (const char*)g.A + (size_t)nxt.pm * tstepA : cA; const char* nB = has_next ? (const char*)g.Bt + (size_t)nxt.pn * tstepB : cB;
        for (int t = 0; t < nt; t += 2) {
            const bool last = (t == nt - 2);
            const char* a1 = cA + (size_t)(t + 1) * kstep;
            const char* a2 = last ? nA : cA + (size_t)(t + 2) * kstep; const char* b2 = last ? nB : cB + (size_t)(t + 2) * kstep;
            const char* a3 = a2 + kstep; const char* b3 = b2 + kstep;
            if (last && has_next) S.a_ready(nxt);
            if constexpr (SP2) {
            PG8_LDB(B0, 0, 0); PG8_LDB(B1, 0, 1); PG8_SCHED; PG8_LDA(At, 0, 0); PG8_STAGE(PG8_SA(1, 1), a1 + hstepA, voffA);
            PG8_WAIT_V(8); PG8_WAIT_L(0); PG8_BAR; PG8_MMA(0, 0, At, B0); PG8_MMA(0, 1, At, B1); PG8_BAR; PG8_SCHED;
            PG8_LDA(At, 0, 1); PG8_STAGE(PG8_SB(0, 0), b2, voffB); PG8_STAGE(PG8_SB(0, 1), b2 + hstepB, voffB); PG8_STAGE(PG8_SA(0, 0), a2, voffA);
            PG8_WAIT_V(8); PG8_WAIT_L(0); PG8_BAR; PG8_MMA(1, 0, At, B0); PG8_MMA(1, 1, At, B1); PG8_BAR; PG8_SCHED;
            PG8_LDB(B0, 1, 0); PG8_LDB(B1, 1, 1); PG8_SCHED; PG8_LDA(At, 1, 0); PG8_STAGE(PG8_SA(0, 1), a2 + hstepA, voffA);
            PG8_WAIT_V(8); PG8_WAIT_L(0); PG8_BAR; PG8_MMA(0, 0, At, B0); PG8_MMA(0, 1, At, B1); PG8_BAR; PG8_SCHED;
            PG8_LDA(At, 1, 1); PG8_STAGE(PG8_SB(1, 0), b3, voffB); PG8_STAGE(PG8_SB(1, 1), b3 + hstepB, voffB); PG8_STAGE(PG8_SA(1, 0), a3, voffA);
            PG8_WAIT_V(8); PG8_WAIT_L(0); PG8_BAR; PG8_MMA(1, 0, At, B0); PG8_MMA(1, 1, At, B1); PG8_BAR; PG8_SCHED;
            } else {
            PG8_LDB(B0, 0, 0); PG8_SCHED; PG8_LDA(At, 0, 0); PG8_STAGE(PG8_SA(1, 1), a1 + hstepA, voffA);
            PG8_WAIT_L(8); PG8_BAR; PG8_WAIT_L(0); PG8_MMA(0, 0, At, B0); PG8_BAR; PG8_SCHED;
            PG8_LDB(B1, 0, 1); PG8_STAGE(PG8_SB(0, 0), b2, voffB);
            PG8_BAR; PG8_WAIT_L(0); PG8_MMA(0, 1, At, B1); PG8_BAR;
            PG8_LDA(At, 0, 1); PG8_STAGE(PG8_SA(0, 0), a2, voffA);
            PG8_BAR; PG8_WAIT_L(0); PG8_MMA(1, 0, At, B0); PG8_BAR; PG8_SCHED;
            PG8_STAGE(PG8_SB(0, 1), b2 + hstepB, voffB);
            PG8_WAIT_V(6); PG8_BAR; PG8_MMA(1, 1, At, B1); PG8_BAR;
            PG8_LDB(B0, 1, 0); PG8_SCHED; PG8_LDA(At, 1, 0); PG8_STAGE(PG8_SA(0, 1), a2 + hstepA, voffA);
            PG8_WAIT_L(8); PG8_BAR; PG8_WAIT_L(0); PG8_MMA(0, 0, At, B0); PG8_BAR; PG8_SCHED;
            PG8_LDB(B1, 1, 1); PG8_STAGE(PG8_SB(1, 0), b3, voffB);
            PG8_BAR; PG8_WAIT_L(0); PG8_MMA(0, 1, At, B1); PG8_BAR;
            PG8_LDA(At, 1, 1); PG8_STAGE(PG8_SA(1, 0), a3, voffA);
            PG8_BAR; PG8_WAIT_L(0); PG8_MMA(1, 0, At, B0); PG8_BAR; PG8_SCHED;
            PG8_STAGE(PG8_SB(1, 1), b3 + hstepB, voffB);
            PG8_WAIT_V(6); PG8_BAR; PG8_MMA(1, 1, At, B1); PG8_BAR;
            }
        }
        if constexpr (ALIGN_EPI) { if (wr == 0) PG8_BAR; }
        if constexpr (!Epi::AFTER_DRAIN) { E(acc, cur, wr, wc, fr, fq, lds + STAGE_BYTES, wid, lane); S.done(cur); }
        if (!has_next) break;
#pragma unroll
        for (int a = 0; a < 2; ++a)
#pragma unroll
            for (int b = 0; b < 2; ++b)
#pragma unroll
                for (int m = 0; m < 4; ++m)
#pragma unroll
                    for (int n = 0; n < 2; ++n) acc[a][b][m][n] = (f32x4){0.f, 0.f, 0.f, 0.f};
        cur = nxt; cA = nA; cB = nB; ++ui;
        if constexpr (ALIGN_EPI) { if (wr == 1) PG8_BAR; }
    }
    PG8_WAIT_V(0);
    if constexpr (!ALIGN_EPI) { if (wr == 0) PG8_BAR; }
    PG8_BAR;
    if constexpr (Epi::AFTER_DRAIN) { E.fused(acc, cur, wr, wc, fr, fq, lds, wid, lane); S.done(cur); }
#undef PG8_SA
#undef PG8_SB
#undef PG8_STAGE
#undef PG8_LDA
#undef PG8_LDB
#undef PG8_MMA
#undef PG8_WAIT_V
#undef PG8_WAIT_L
#undef PG8_BAR
#undef PG8_SCHED
}
}
namespace pg8 {
constexpr float NORM_EPS_ = 1e-6f;
__device__ __forceinline__ void stat_dma(PG8_LAS unsigned char* spare, const unsigned* ss, const Unit& u, int wr, int fr, int wid) {
#pragma unroll
    for (int k = 0; k < 8; ++k)
        __builtin_amdgcn_global_load_lds(ss + (u.pm * BM + wr * 64 + fr + (k >> 2) * HALF + (k & 3) * 16), (PG8_LAS unsigned*)(spare + wid * 2048 + k * 256), 4, 0, 0);
}
__device__ __forceinline__ float stat_rstd(PG8_LAS unsigned char* spare, int wid, int lane, int k) {
    const unsigned v = *(const PG8_LAS unsigned*)(spare + wid * 2048 + k * 256 + lane * 4);
    return 1.0f / sqrtf((float)v * (1.f / (1024.f * 2048.f)) + NORM_EPS_);
}
template <int ACT  > struct EpiB {
    static constexpr bool PERM = true, AFTER_DRAIN = false;
    bf16_t* O; int ldc; const unsigned* ss;
    __device__ __forceinline__ void pre(PG8_LAS unsigned char* spare, const Unit& u, int wr, int fr, int wid) const { if (ss) stat_dma(spare, ss, u, wr, fr, wid); }
    __device__ __forceinline__ void operator()(const f32x4 (&acc)[2][2][4][2], const Unit& u, int wr, int wc, int fr, int fq, PG8_LAS unsigned char* spare, int wid, int lane) const {
        const int row0 = u.pm * BM + wr * 64 + fr, col0 = u.pn * BM + wc * 32 + 8 * fq;
#pragma unroll
        for (int ai = 0; ai < 2; ++ai)
#pragma unroll
            for (int m = 0; m < 4; ++m) { const int row = row0 + ai * HALF + m * 16; bf16_t* rowp = O + (size_t)row * ldc + col0;
                const float rs = ss ? stat_rstd(spare, wid, lane, ai * 4 + m) : 1.f;
#pragma unroll
                for (int bj = 0; bj < 2; ++bj) { f32x4 v0 = acc[ai][bj][m][0] * rs, v1 = acc[ai][bj][m][1] * rs;
                    if (ACT == 2) {
#pragma unroll
                        for (int e = 0; e < 4; ++e) { float a = v0[e] > 0.f ? v0[e] : 0.f; v0[e] = a * a; float b = v1[e] > 0.f ? v1[e] : 0.f; v1[e] = b * b; } }
                    u32x4 w; w.x = cvt_pk_bf16(v0[0], v0[1]); w.y = cvt_pk_bf16(v0[2], v0[3]); w.z = cvt_pk_bf16(v1[0], v1[1]); w.w = cvt_pk_bf16(v1[2], v1[3]);
                    *(u32x4*)(rowp + bj * HALF) = w; } }
    }
};
template <int MODE> struct EpiH {
    static constexpr bool PERM = true, AFTER_DRAIN = false;
    const float* base_f; const bf16_t* hb_in; float* out; const float* cscale; int col_off; const bf16_t* pp; const unsigned* ss_in; bf16_t* hb; unsigned* ss_out;
    __device__ __forceinline__ void pre(PG8_LAS unsigned char* spare, const Unit& u, int wr, int fr, int wid) const { if (ss_in) stat_dma(spare, ss_in, u, wr, fr, wid); }
    __device__ __forceinline__ void operator()(const f32x4 (&acc)[2][2][4][2], const Unit& u, int wr, int wc, int fr, int fq, PG8_LAS unsigned char* spare, int wid, int lane) const {
        const int row0 = u.pm * BM + wr * 64 + fr, col0 = col_off + u.pn * BM + wc * 32 + 8 * fq;
        unsigned sqv[8];
#pragma unroll
        for (int ai = 0; ai < 2; ++ai)
#pragma unroll
            for (int mp = 0; mp < 2; ++mp) {
                f32x4 bv[2][2][2]; u32x4 pw[2][2]; float rs[2] = {1.f, 1.f};
#pragma unroll
                for (int mm = 0; mm < 2; ++mm) { const int row = row0 + ai * HALF + (2 * mp + mm) * 16; const size_t ro = (size_t)row * 2048;
                    if (ss_in) { const float r_ = stat_rstd(spare, wid, lane, ai * 4 + 2 * mp + mm); rs[mm] = (MODE == 0) ? r_ * r_ : r_; }
#pragma unroll
                    for (int bj = 0; bj < 2; ++bj) { const int c = col0 + bj * HALF;
                        if (base_f) { bv[mm][bj][0] = *(const f32x4*)(base_f + ro + c); bv[mm][bj][1] = *(const f32x4*)(base_f + ro + c + 4); }
                        else { const u32x4 w = *(const u32x4*)(hb_in + ro + c);
                            bv[mm][bj][0] = (f32x4){__uint_as_float(w.x << 16), __uint_as_float(w.x & 0xffff0000u), __uint_as_float(w.y << 16), __uint_as_float(w.y & 0xffff0000u)};
                            bv[mm][bj][1] = (f32x4){__uint_as_float(w.z << 16), __uint_as_float(w.z & 0xffff0000u), __uint_as_float(w.w << 16), __uint_as_float(w.w & 0xffff0000u)}; }
                        pw[mm][bj] = (MODE == 1) ? *(const u32x4*)(pp + ro + c) : (u32x4){0u, 0u, 0u, 0u}; } }
#pragma unroll
                for (int mm = 0; mm < 2; ++mm) { const int m = 2 * mp + mm; const int row = row0 + ai * HALF + m * 16; const size_t ro = (size_t)row * 2048;
                    float sq = 0.f;
#pragma unroll
                    for (int bj = 0; bj < 2; ++bj) { const int c = col0 + bj * HALF; f32x4 v0 = acc[ai][bj][m][0], v1 = acc[ai][bj][m][1];
                        if (MODE == 0) { if (cscale) { v0 = v0 * *(const f32x4*)(cscale + c); v1 = v1 * *(const f32x4*)(cscale + c + 4); } v0 = v0 * rs[mm]; v1 = v1 * rs[mm]; }
                        else { const u32x4 w = pw[mm][bj];
                            const f32x4 p0 = {__uint_as_float(w.x << 16), __uint_as_float(w.x & 0xffff0000u), __uint_as_float(w.y << 16), __uint_as_float(w.y & 0xffff0000u)};
                            const f32x4 p1 = {__uint_as_float(w.z << 16), __uint_as_float(w.z & 0xffff0000u), __uint_as_float(w.w << 16), __uint_as_float(w.w & 0xffff0000u)};
#pragma unroll
                            for (int e = 0; e < 4; ++e) { v0[e] = p0[e] / (1.f + __expf(-v0[e] * rs[mm])); v1[e] = p1[e] / (1.f + __expf(-v1[e] * rs[mm])); } }
                        const f32x4 h0 = bv[mm][bj][0] + v0, h1 = bv[mm][bj][1] + v1;
                        if (out) { *(f32x4*)(out + ro + c) = h0; *(f32x4*)(out + ro + c + 4) = h1; }
                        if (hb) { u32x4 w2; w2.x = cvt_pk_bf16(h0[0], h0[1]); w2.y = cvt_pk_bf16(h0[2], h0[3]); w2.z = cvt_pk_bf16(h1[0], h1[1]); w2.w = cvt_pk_bf16(h1[2], h1[3]); *(u32x4*)(hb + ro + c) = w2;
                            const float r0 = __uint_as_float(w2.x << 16), r1 = __uint_as_float(w2.x & 0xffff0000u), r2 = __uint_as_float(w2.y << 16), r3 = __uint_as_float(w2.y & 0xffff0000u);
                            const float r4 = __uint_as_float(w2.z << 16), r5 = __uint_as_float(w2.z & 0xffff0000u), r6 = __uint_as_float(w2.w << 16), r7 = __uint_as_float(w2.w & 0xffff0000u);
                            sq += ((r0 * r0 + r1 * r1) + (r2 * r2 + r3 * r3)) + ((r4 * r4 + r5 * r5) + (r6 * r6 + r7 * r7)); } }
                    sq += __shfl_xor(sq, 16); sq += __shfl_xor(sq, 32); sqv[ai * 4 + m] = __float2uint_rn(sq * 1024.f);
                }
            }
        if (ss_out) {
#pragma unroll
            for (int j = 0; j < 2; ++j) { const unsigned v = fq == 0 ? sqv[4 * j] : (fq == 1 ? sqv[4 * j + 1] : (fq == 2 ? sqv[4 * j + 2] : sqv[4 * j + 3]));
                atomicAdd(ss_out + row0 + j * HALF + fq * 16, v); }
        }
    }
};
}
using pg8::bf16_t; using pg8::bf16x8; using pg8::f32x4; using pg8::u32x4;
typedef float f32x16 __attribute__((ext_vector_type(16)));
typedef short s16x4 __attribute__((ext_vector_type(4)));
typedef unsigned u32x2 __attribute__((ext_vector_type(2)));
#define LAS __attribute__((address_space(3)))
constexpr int NB = 2, S = 4096, T = NB * S, D = 2048, FF = 8192, NH = 16, HD = 128;
constexpr int NQ_LD = 5376, MQ_LD = 6144;
constexpr float EPS = 1e-6f;
constexpr size_t MiB = 1u << 20;
constexpr size_t WS_W1T = 0, WS_W2T = 128 * MiB, WS_PGT = 256 * MiB, WS_PPT = 288 * MiB, WS_MQKV = 292 * MiB, WS_MWO = 316 * MiB, WS_POOL = 324 * MiB,
                 WS_NQKV = 326 * MiB, WS_NWO = 347 * MiB, WS_CW1 = 355 * MiB, WS_CIN = 357 * MiB, WS_CWO = 381 * MiB, WS_PB = 389 * MiB, WS_XN = 405 * MiB,
                 WS_OB = 437 * MiB, WS_PP = 469 * MiB, WS_BIG = 501 * MiB, WS_KMEAN = 629 * MiB, WS_KC = 630 * MiB, WS_VC = 631 * MiB, WS_CTL = 632 * MiB, WS_SS = 632 * MiB + 65536, WS_HB1 = 633 * MiB, WS_SSP = 665 * MiB, WS_END = 678 * MiB;
constexpr int LDS_BYTES = 155648;
constexpr int NWAVES = 8, NTHREADS = 512;

struct Params { const void* in[29]; float* out; unsigned char* ws; };

__device__ __forceinline__ float bflo(unsigned w) { return __uint_as_float(w << 16); }
__device__ __forceinline__ float bfhi(unsigned w) { return __uint_as_float(w & 0xffff0000u); }
__device__ __forceinline__ float bf1(bf16_t b) { return __uint_as_float((unsigned)b << 16); }
__device__ __forceinline__ unsigned pk2(float lo, float hi) { return pg8::cvt_pk_bf16(lo, hi); }
__device__ __forceinline__ bf16_t f2bf1(float f) { return (bf16_t)(pk2(f, 0.f) & 0xffffu); }
__device__ __forceinline__ float wave_sum(float v) {
#pragma unroll
    for (int o = 1; o < 64; o <<= 1) v += __shfl_xor(v, o);
    return v;
}
__device__ __forceinline__ bf16x8 pack8(f32x4 a, f32x4 b) { u32x4 w = {pk2(a[0], a[1]), pk2(a[2], a[3]), pk2(b[0], b[1]), pk2(b[2], b[3])}; return __builtin_bit_cast(bf16x8, w); }
__device__ __forceinline__ float sigmoidf_(float x) { return 1.f / (1.f + __expf(-x)); }

struct CJob { const float* W; bf16_t* WT; const float* gain; int K, N, row_off, item; };
__device__ __forceinline__ void tr_load(const CJob& J, int lane, float (&tv)[32]) {
    const int nblk = J.N / 32, kb = J.item / nblk, nb = J.item % nblk, k0 = 64 * kb, n0 = 32 * nb;
#pragma unroll
    for (int i = 0; i < 32; ++i) { const int kk = 2 * i + (lane >> 5); tv[i] = __builtin_nontemporal_load(J.W + (size_t)(k0 + kk) * J.N + n0 + (lane & 31)); }
}
__device__ __forceinline__ void tr_store(const CJob& J, int lane, const float (&tv)[32], float* scr) {
    const int nblk = J.N / 32, kb = J.item / nblk, nb = J.item % nblk, k0 = 64 * kb, n0 = 32 * nb;
#pragma unroll
    for (int i = 0; i < 32; ++i) { const int kk = 2 * i + (lane >> 5); scr[kk * 33 + (lane & 31)] = J.gain ? tv[i] * J.gain[k0 + kk] : tv[i]; }
    asm volatile("s_waitcnt lgkmcnt(0)" ::: "memory");
    const int c = lane & 7;
#pragma unroll
    for (int j = 0; j < 4; ++j) { const int n = (lane >> 3) + 8 * j; const float* s = scr + (8 * c) * 33 + n;
        u32x4 o; o.x = pk2(s[0 * 33], s[1 * 33]); o.y = pk2(s[2 * 33], s[3 * 33]); o.z = pk2(s[4 * 33], s[5 * 33]); o.w = pk2(s[6 * 33], s[7 * 33]);
        *(u32x4*)(J.WT + (size_t)(J.row_off + n0 + n) * J.K + k0 + 8 * c) = o; }
    asm volatile("s_waitcnt lgkmcnt(0)" ::: "memory");
}
#define CJOB(src, Kk, Nn, dst, roff, gn) if (!found) { const int ni_ = ((Kk) / 64) * ((Nn) / 32); if (r < ni_) { J.W = (const float*)(src); J.WT = (bf16_t*)(dst); J.gain = (const float*)(gn); J.K = (Kk); J.N = (Nn); J.row_off = (roff); J.item = r; found = true; } else r -= ni_; }
#define CJOB_LAYER(i) CJOB((const float*)P.in[5] + (size_t)(i) * D * FF, D, FF, ws + WS_W1T + (size_t)(i) * 32 * MiB, 0, (const float*)P.in[4] + (size_t)(i) * D) \
                      CJOB((const float*)P.in[6] + (size_t)(i) * D * FF, FF, D, ws + WS_W2T + (size_t)(i) * 32 * MiB, 0, nullptr) \
                      CJOB((const float*)P.in[8] + (size_t)(i) * D * D, D, D, ws + WS_PGT + (size_t)(i) * 8 * MiB, 0, (const float*)P.in[7] + (size_t)(i) * D) \
                      CJOB((const float*)P.in[9] + (size_t)(i) * 256 * D, 256, D, ws + WS_PPT + (size_t)(i) * 1 * MiB, 0, nullptr)
constexpr int NITEMS_CONV = 4 * (8192 + 8192 + 2048 + 256) + 6144 + 2048 + 4 * 128 + 2048 + 3072 + 2048 + 2 * 256 + 6144 + 2048;
__device__ __forceinline__ CJob conv_resolve(const Params& P, int it) {
    unsigned char* ws = P.ws; CJob J; J.W = nullptr; J.WT = nullptr; J.gain = nullptr; J.K = 64; J.N = 32; J.row_off = 0; J.item = 0;
    int r = it; bool found = false;
    CJOB_LAYER(0) CJOB_LAYER(1) CJOB_LAYER(2) CJOB_LAYER(3)
    CJOB(P.in[10], D, 3 * D, ws + WS_MQKV, 0, (const float*)P.in[3])
    CJOB(P.in[13], D, D, ws + WS_MWO, 0, nullptr)
    CJOB((const float*)P.in[14] + 0 * 512 * 512, 512, 512, ws + WS_POOL + 0 * 512 * 512 * 2, 0, nullptr)
    CJOB((const float*)P.in[14] + 1 * 512 * 512, 512, 512, ws + WS_POOL + 1 * 512 * 512 * 2, 0, nullptr)
    CJOB((const float*)P.in[14] + 2 * 512 * 512, 512, 512, ws + WS_POOL + 2 * 512 * 512 * 2, 0, nullptr)
    CJOB((const float*)P.in[14] + 3 * 512 * 512, 512, 512, ws + WS_POOL + 3 * 512 * 512 * 2, 0, nullptr)
    CJOB(P.in[16], D, D, ws + WS_NQKV, 0, (const float*)P.in[3] + 2 * D)
    CJOB(P.in[17], D, 3072, ws + WS_NQKV, 2048, (const float*)P.in[3] + 2 * D)
    CJOB(P.in[24], D, D, ws + WS_NWO, 0, nullptr)
    CJOB((const float*)P.in[21] + 0 * 4096 * 128, 4096, 128, ws + WS_CW1 + 0 * 128 * 4096 * 2, 0, nullptr)
    CJOB((const float*)P.in[21] + 1 * 4096 * 128, 4096, 128, ws + WS_CW1 + 1 * 128 * 4096 * 2, 0, nullptr)
    CJOB(P.in[25], D, 3 * D, ws + WS_CIN, 0, (const float*)P.in[3] + 3 * D)
    CJOB(P.in[28], D, D, ws + WS_CWO, 0, nullptr)
    return J;
}
__device__ __forceinline__ void phase_convert(const Params& P, char* lds, int gw, int NGW, int gtid, int NT, int wid, int lane) {
    asm volatile("" : "+v"(lane));
    unsigned char* ws = P.ws;
    float* scr = (float*)(lds + wid * 17408);
    for (int it = 2 * gw; it < NITEMS_CONV; it += 2 * NGW) {
        const CJob J0 = conv_resolve(P, it); const bool two = (it + 1 < NITEMS_CONV); const CJob J1 = conv_resolve(P, two ? it + 1 : it);
        float tv0[32], tv1[32];
        tr_load(J0, lane, tv0); tr_load(J1, lane, tv1);
        tr_store(J0, lane, tv0, scr);
        if (two) tr_store(J1, lane, tv1, scr);
    }
    { const float* Wg = (const float*)P.in[23]; bf16_t* dst = (bf16_t*)(ws + WS_NQKV) + (size_t)5120 * D;
      for (int idx = gtid; idx < 256 * D; idx += NT) { const int n = idx >> 11, k = idx & 2047; dst[idx] = (n < 48) ? f2bf1(Wg[(size_t)k * 48 + n] * ((const float*)P.in[3])[2 * D + k]) : (bf16_t)0; } }
    { const float* x = (const float*)P.in[0]; bf16_t* hb = (bf16_t*)(ws + WS_XN); unsigned* ss0 = (unsigned*)(ws + WS_SS);
      for (int m = gw; m < T; m += NGW) {
          const f32x4* xr = (const f32x4*)(x + (size_t)m * D) + lane; u32x2* o8 = (u32x2*)(hb + (size_t)m * D) + lane; float s = 0.f;
#pragma unroll
          for (int j = 0; j < 8; ++j) { const f32x4 v = xr[64 * j]; s += (v[0] * v[0] + v[1] * v[1]) + (v[2] * v[2] + v[3] * v[3]); u32x2 o; o.x = pk2(v[0], v[1]); o.y = pk2(v[2], v[3]); o8[64 * j] = o; }
          s = wave_sum(s); if (lane == 0) ss0[m] = __float2uint_rn(s * 1024.f); } }
    { const f32x4* ps = (const f32x4*)P.in[1]; u32x2* pd = (u32x2*)(ws + WS_PB);
      for (int idx = gtid; idx < 4 * T * 256 / 4; idx += NT) { const f32x4 v = ps[idx]; u32x2 o; o.x = pk2(v[0], v[1]); o.y = pk2(v[2], v[3]); pd[idx] = o; } }
}

__device__ __forceinline__ void phase_rms(const float* src, const float* gain, bf16_t* dst, int gw, int NGW, int lane) {
    asm volatile("" : "+v"(lane));
    for (int m = gw; m < T; m += NGW) {
        const f32x4* xr = (const f32x4*)(src + (size_t)m * D) + lane;
        f32x4 v[8]; float s = 0.f;
#pragma unroll
        for (int j = 0; j < 8; ++j) { v[j] = xr[64 * j]; s += (v[j][0] * v[j][0] + v[j][1] * v[j][1]) + (v[j][2] * v[j][2] + v[j][3] * v[j][3]); }
        const float rstd = 1.0f / sqrtf(wave_sum(s) * (1.f / D) + EPS);
        u32x2* o8 = (u32x2*)(dst + (size_t)m * D) + lane;
#pragma unroll
        for (int j = 0; j < 8; ++j) { const f32x4 g = ((const f32x4*)gain)[lane + 64 * j]; u32x2 o; o.x = pk2(v[j][0] * rstd * g[0], v[j][1] * rstd * g[1]); o.y = pk2(v[j][2] * rstd * g[2], v[j][3] * rstd * g[3]); o8[64 * j] = o; }
    }
}

template <class Epi>
__device__ __forceinline__ void gemm_run(char* lds, const bf16_t* A, int lda, const bf16_t* Bt, int ldb, int M, int N, int K, int G, int c, const Epi& E) {
    pg8::Gemm g{A, Bt, M, N, K, lda, ldb}; pg8::StaticOrder So; So.init(M, N, G, c);
    pg8::gemm_phase<Epi, pg8::StaticOrder, true, true>((PG8_LAS unsigned char*)lds, g, So, E);
}

__device__ __forceinline__ void rope_cs(int pos, int lane, float (&cs)[2], float (&sn)[2]) {
#pragma unroll
    for (int e = 0; e < 2; ++e) {
        const int i = 2 * (lane & 7) + e;
        const float freq = __builtin_amdgcn_exp2f(-(float)i * (18.931568569324174f / 16.0f));
        const float ang = (float)pos * freq;
        const double rev = (double)ang * 0.15915494309189535;
        const float fr = (float)(rev - floor(rev));
        cs[e] = __builtin_amdgcn_cosf(fr); sn[e] = __builtin_amdgcn_sinf(fr);
    }
}
__device__ __forceinline__ void head_norm_rope(unsigned w, const float* gain, int lane, const float (&cs)[2], const float (&sn)[2], float& n0, float& n1, float& r0, float& r1) {
    const float x0 = bflo(w), x1 = bfhi(w);
    const float ss = wave_sum(x0 * x0 + x1 * x1);
    const float rstd = 1.0f / sqrtf(ss * (1.f / HD) + EPS);
    n0 = x0 * rstd * gain[2 * lane]; n1 = x1 * rstd * gain[2 * lane + 1];
    const float p0 = __shfl_xor(n0, 8), p1 = __shfl_xor(n1, 8);
    r0 = n0; r1 = n1;
    if (lane < 8) { r0 = n0 * cs[0] - p0 * sn[0]; r1 = n1 * cs[1] - p1 * sn[1]; }
    else if (lane < 16) { r0 = n0 * cs[0] + p0 * sn[0]; r1 = n1 * cs[1] + p1 * sn[1]; }
}
__device__ __forceinline__ void phase_moba_prep(const Params& P, char* lds, int bid, int G, int tid, int wid, int lane) {
    asm volatile("" : "+v"(tid)); asm volatile("" : "+v"(lane));
    bf16_t* BIG = (bf16_t*)(P.ws + WS_BIG); float* KMEAN = (float*)(P.ws + WS_KMEAN);
    const int* pos = (const int*)P.in[2]; const float* qg = (const float*)P.in[11]; const float* kg = (const float*)P.in[12];
    float* red = (float*)(lds);
    const int sub = lane & 15, grp = lane >> 4;
    float qg8[8], kg8[8];
#pragma unroll
    for (int j = 0; j < 8; ++j) { qg8[j] = qg[8 * sub + j]; kg8[j] = kg[8 * sub + j]; }
    for (int u = bid; u < NB * 16 * NH; u += G) {
        const int h = u & 15, blk = (u >> 4) & 15, b = u >> 8;
        float ks[8];
#pragma unroll
        for (int j = 0; j < 8; ++j) ks[j] = 0.f;
        u32x4 qv[8], kv[8];
#pragma unroll
        for (int it = 0; it < 8; ++it) { const size_t row = (size_t)(b * S + blk * 256 + wid * 32 + it * 4 + grp);
            qv[it] = *(const u32x4*)(BIG + row * MQ_LD + h * HD + 8 * sub); kv[it] = *(const u32x4*)(BIG + row * MQ_LD + D + h * HD + 8 * sub); }
#pragma unroll
        for (int it = 0; it < 8; ++it) {
            const size_t row = (size_t)(b * S + blk * 256 + wid * 32 + it * 4 + grp);
            const int ps = pos[row];
            float cs[8], sn[8];
#pragma unroll
            for (int j = 0; j < 8; ++j) { const int i_ = 8 * (sub & 1) + j;
                const float freq = __builtin_amdgcn_exp2f(-(float)i_ * (18.931568569324174f / 16.0f));
                const float ang = (float)ps * freq; const double rev = (double)ang * 0.15915494309189535; const float fr_ = (float)(rev - floor(rev));
                cs[j] = __builtin_amdgcn_cosf(fr_); sn[j] = __builtin_amdgcn_sinf(fr_); }
#pragma unroll
            for (int which = 0; which < 2; ++which) {
                const u32x4 w = which ? kv[it] : qv[it];
                float x[8] = {bflo(w.x), bfhi(w.x), bflo(w.y), bfhi(w.y), bflo(w.z), bfhi(w.z), bflo(w.w), bfhi(w.w)};
                float ss = 0.f;
#pragma unroll
                for (int j = 0; j < 8; ++j) ss += x[j] * x[j];
                ss += __shfl_xor(ss, 1); ss += __shfl_xor(ss, 2); ss += __shfl_xor(ss, 4); ss += __shfl_xor(ss, 8);
                const float rstd = 1.0f / sqrtf(ss * (1.f / HD) + EPS);
                float y[8];
#pragma unroll
                for (int j = 0; j < 8; ++j) { y[j] = x[j] * rstd * (which ? kg8[j] : qg8[j]);
                    const float pr = __shfl_xor(y[j], 2);
                    const float rot = (sub < 2) ? (y[j] * cs[j] - pr * sn[j]) : (y[j] * cs[j] + pr * sn[j]);
                    y[j] = (sub < 4) ? rot : y[j]; }
                u32x4 ow = {pk2(y[0], y[1]), pk2(y[2], y[3]), pk2(y[4], y[5]), pk2(y[6], y[7])};
                *(u32x4*)(BIG + row * MQ_LD + (which ? D : 0) + h * HD + 8 * sub) = ow;
                if (which) {
#pragma unroll
                    for (int j = 0; j < 8; ++j) ks[j] += y[j]; }
            }
        }
#pragma unroll
        for (int j = 0; j < 8; ++j) { ks[j] += __shfl_xor(ks[j], 16); ks[j] += __shfl_xor(ks[j], 32); }
        if (grp == 0) {
#pragma unroll
            for (int j = 0; j < 8; ++j) red[wid * 128 + 8 * sub + j] = ks[j]; }
        __syncthreads();
        if (tid < 128) { float sm = 0.f;
#pragma unroll
            for (int w = 0; w < 8; ++w) sm += red[w * 128 + tid];
            KMEAN[(size_t)((b * NH + h) * 16 + blk) * HD + tid] = sm * (1.f / 256.f); }
        __syncthreads();
    }
}

__device__ __forceinline__ void phase_nsa_norm(const Params& P, int gw, int NGW, int lane) {
    asm volatile("" : "+v"(lane));
    bf16_t* BIG = (bf16_t*)(P.ws + WS_BIG);
    const int* pos = (const int*)P.in[2]; const float* qg = (const float*)P.in[18]; const float* kg = (const float*)P.in[19];
    const int sub = lane & 15, grp = lane >> 4;
    for (int row = gw; row < T; row += NGW) {
        bf16_t* base = BIG + (size_t)row * NQ_LD;
        u32x4 v[6];
#pragma unroll
        for (int st = 0; st < 6; ++st) { const int col = (st < 4) ? (st * 4 + grp) * HD : (D + (st == 4 ? 2 : 4) * 512 + grp * HD); v[st] = *(const u32x4*)(base + col + 8 * sub); }
        const int ps = pos[row];
        float cs[8], sn[8];
#pragma unroll
        for (int j = 0; j < 8; ++j) { const int i_ = 8 * (sub & 1) + j;
            const float freq = __builtin_amdgcn_exp2f(-(float)i_ * (18.931568569324174f / 16.0f));
            const float ang = (float)ps * freq; const double rev = (double)ang * 0.15915494309189535; const float fr_ = (float)(rev - floor(rev));
            cs[j] = __builtin_amdgcn_cosf(fr_); sn[j] = __builtin_amdgcn_sinf(fr_); }
#pragma unroll
        for (int st = 0; st < 6; ++st) {
            const int col = (st < 4) ? (st * 4 + grp) * HD : (D + (st == 4 ? 2 : 4) * 512 + grp * HD);
            const float* gn = (st < 4) ? qg : (st == 4 ? kg + 1 * HD : kg + 2 * HD);
            const u32x4 w = v[st];
            float x[8] = {bflo(w.x), bfhi(w.x), bflo(w.y), bfhi(w.y), bflo(w.z), bfhi(w.z), bflo(w.w), bfhi(w.w)};
            float ss = 0.f;
#pragma unroll
            for (int j = 0; j < 8; ++j) ss += x[j] * x[j];
            ss += __shfl_xor(ss, 1); ss += __shfl_xor(ss, 2); ss += __shfl_xor(ss, 4); ss += __shfl_xor(ss, 8);
            const float rstd = 1.0f / sqrtf(ss * (1.f / HD) + EPS);
            const f32x4 g0 = *(const f32x4*)(gn + 8 * sub), g1 = *(const f32x4*)(gn + 8 * sub + 4);
            float y[8];
#pragma unroll
            for (int j = 0; j < 8; ++j) { y[j] = x[j] * rstd * (j < 4 ? g0[j & 3] : g1[j & 3]);
                if (st >= 4) { const float pr = __shfl_xor(y[j], 2);
                    const float rot = (sub < 2) ? (y[j] * cs[j] - pr * sn[j]) : (y[j] * cs[j] + pr * sn[j]);
                    y[j] = (sub < 4) ? rot : y[j]; } }
            u32x4 ow = {pk2(y[0], y[1]), pk2(y[2], y[3]), pk2(y[4], y[5]), pk2(y[6], y[7])};
            *(u32x4*)(base + col + 8 * sub) = ow;
        }
    }
}

__device__ __forceinline__ void phase_nsa_compress(const Params& P, char* lds, int bid, int G, int tid, int wid, int lane) {
    asm volatile("" : "+v"(tid)); asm volatile("" : "+v"(lane));
    const bf16_t* BIG = (const bf16_t*)(P.ws + WS_BIG); const bf16_t* CW1 = (const bf16_t*)(P.ws + WS_CW1);
    const float* cpos = (const float*)P.in[20]; const float* w2 = (const float*)P.in[22]; const float* kg0 = (const float*)P.in[19];
    float* red = (float*)lds;
    float* h1s = (float*)(lds + 65536);
    const int fr = lane & 15, fq = lane >> 4;
    for (int u = bid; u < 256; u += G) {
        const int ng = u & 15, j = (u >> 4) & 1, g = (u >> 5) & 3, b = u >> 7;
        const int n = 16 * ng + fr;
        f32x4 acc[8];
#pragma unroll
        for (int i = 0; i < 8; ++i) acc[i] = (f32x4){0.f, 0.f, 0.f, 0.f};
        for (int l = 4 * wid; l < 4 * wid + 4; ++l) {
            int tokl = 16 * n + l; tokl = tokl > S - 1 ? S - 1 : tokl;
            const bf16_t* rowp = BIG + (size_t)(b * S + tokl) * NQ_LD + D + j * 512 + g * HD;
            const float* pp = cpos + (size_t)(j * 32 + l) * HD;
#pragma unroll
            for (int dd = 0; dd < 4; ++dd) {
                const int d = dd * 32 + 8 * fq;
                const u32x4 raw = *(const u32x4*)(rowp + d);
                const f32x4 pa = *(const f32x4*)(pp + d), pb = *(const f32x4*)(pp + d + 4);
                f32x4 a0 = {bflo(raw.x) + pa[0], bfhi(raw.x) + pa[1], bflo(raw.y) + pa[2], bfhi(raw.y) + pa[3]};
                f32x4 a1 = {bflo(raw.z) + pb[0], bfhi(raw.z) + pb[1], bflo(raw.w) + pb[2], bfhi(raw.w) + pb[3]};
                const bf16x8 Af = pack8(a0, a1);
                const int k0 = l * HD + dd * 32 + 8 * fq;
#pragma unroll
                for (int ns = 0; ns < 8; ++ns) {
                    const bf16x8 Bw = *(const bf16x8*)(CW1 + (size_t)(j * 128 + ns * 16 + fr) * 4096 + k0);
                    acc[ns] = __builtin_amdgcn_mfma_f32_16x16x32_bf16(Bw, Af, acc[ns], 0, 0, 0);
                }
            }
        }
#pragma unroll
        for (int ns = 0; ns < 8; ++ns) *(f32x4*)(red + (size_t)(wid * 16 + fr) * 128 + ns * 16 + 4 * fq) = acc[ns];
        __syncthreads();
        const int m = tid >> 5, c4 = (tid & 31) * 4;
        { f32x4 s = {0.f, 0.f, 0.f, 0.f};
#pragma unroll
          for (int w = 0; w < 8; ++w) s = s + *(const f32x4*)(red + (size_t)(w * 16 + m) * 128 + c4);
#pragma unroll
          for (int e = 0; e < 4; ++e) { const float x = s[e]; const float uu = 0.7978845608028654f * (x + 0.044715f * x * x * x); const float th = 1.f - 2.f / (__expf(2.f * uu) + 1.f); s[e] = 0.5f * x * (1.f + th); }
          *(f32x4*)(h1s + m * 128 + c4) = s; }
        __syncthreads();
        f32x4 o = {0.f, 0.f, 0.f, 0.f};
        const float* w2j = w2 + (size_t)j * 128 * 128 + c4;
#pragma unroll 16
        for (int k = 0; k < 128; ++k) { const float hv = h1s[m * 128 + k]; const f32x4 wv = *(const f32x4*)(w2j + (size_t)k * 128); o = o + wv * hv; }
        if (j == 0) {
            float ss = (o[0] * o[0] + o[1] * o[1]) + (o[2] * o[2] + o[3] * o[3]);
#pragma unroll
            for (int sh = 1; sh < 32; sh <<= 1) ss += __shfl_xor(ss, sh);
            const float rstd = 1.0f / sqrtf(ss * (1.f / HD) + EPS);
            const f32x4 gn = *(const f32x4*)(kg0 + c4);
            o = o * rstd * gn;
        }
        const int nn = 16 * ng + m;
        if (nn >= 255) o = (f32x4){0.f, 0.f, 0.f, 0.f};
        bf16_t* dst = (bf16_t*)(P.ws + (j == 0 ? WS_KC : WS_VC)) + (size_t)((b * 4 + g) * 256 + nn) * HD + c4;
        u32x2 ow; ow.x = pk2(o[0], o[1]); ow.y = pk2(o[2], o[3]); *(u32x2*)dst = ow;
        __syncthreads();
    }
}

__device__ __forceinline__ f32x4 ld4bf(const bf16_t* p) { const u32x2 w = *(const u32x2*)p; return (f32x4){bflo(w.x), bfhi(w.x), bflo(w.y), bfhi(w.y)}; }
__device__ __forceinline__ void phase_pool_prep(const bf16_t* hsrc, const unsigned* ssq, const float* gain, bf16_t* OB, char* lds, int bid, int G, int tid, int wid, int lane) {
    asm volatile("" : "+v"(tid)); asm volatile("" : "+v"(lane));
    float* rs = (float*)lds;
    for (int u = bid; u < T / 32; u += G) {
        const int b = u / (S / 32), s0 = (u % (S / 32)) * 32;
        if (tid < 47) { const int s = s0 - 15 + tid; rs[tid] = (s >= 0) ? 1.0f / sqrtf((float)ssq[b * S + s] * (1.f / (1024.f * 2048.f)) + EPS) : 0.f; }
        __syncthreads();
        const int col = (tid & 255) * 8, w = 2 << (col >> 9), r_lo = (tid >> 8) * 16;
        const f32x4 gn0 = *(const f32x4*)(gain + col), gn1 = *(const f32x4*)(gain + col + 4);
        for (int rr = r_lo; rr < r_lo + 16; ++rr) {
            const int s = s0 + rr; const int lo = (s + 1 - w) > 0 ? (s + 1 - w) : 0; const float inv = 1.0f / (float)(s + 1 - lo);
            f32x4 a0 = {0.f, 0.f, 0.f, 0.f}, a1 = {0.f, 0.f, 0.f, 0.f};
            for (int sp = lo; sp <= s; ++sp) { const u32x4 wv = *(const u32x4*)(hsrc + (size_t)(b * S + sp) * D + col); const float r_ = rs[sp - s0 + 15];
                a0 = a0 + (f32x4){bflo(wv.x), bfhi(wv.x), bflo(wv.y), bfhi(wv.y)} * r_; a1 = a1 + (f32x4){bflo(wv.z), bfhi(wv.z), bflo(wv.w), bfhi(wv.w)} * r_; }
            const u32x4 wx = *(const u32x4*)(hsrc + (size_t)(b * S + s) * D + col); const float rx = rs[rr + 15];
            const f32x4 d0 = (a0 * inv - (f32x4){bflo(wx.x), bfhi(wx.x), bflo(wx.y), bfhi(wx.y)} * rx) * gn0;
            const f32x4 d1 = (a1 * inv - (f32x4){bflo(wx.z), bfhi(wx.z), bflo(wx.w), bfhi(wx.w)} * rx) * gn1;
            u32x4 ow = {pk2(d0[0], d0[1]), pk2(d0[2], d0[3]), pk2(d1[0], d1[1]), pk2(d1[2], d1[3])};
            *(u32x4*)(OB + (size_t)(b * S + s) * D + col) = ow;
        }
        __syncthreads();
    }
}

__device__ __forceinline__ void phase_conv_elem(const Params& P, int gtid, int NT) {
    asm volatile("" : "+v"(gtid));
    const bf16_t* BIG = (const bf16_t*)(P.ws + WS_BIG); bf16_t* OB = (bf16_t*)(P.ws + WS_OB);
    const float* cw = (const float*)P.in[26]; const float* cb = (const float*)P.in[27];
    for (int it = gtid; it < T * 256; it += NT) {
        const int row = it >> 8, c8 = (it & 255) * 8, s = row & (S - 1);
        const bf16_t* base = BIG + (size_t)row * MQ_LD + c8;
        float u[3][8];
#pragma unroll
        for (int j = 0; j < 3; ++j) {
            const int back = 2 - j;
            if (s >= back) { const u32x4 cw4 = *(const u32x4*)(base - (size_t)back * MQ_LD + D), hw4 = *(const u32x4*)(base - (size_t)back * MQ_LD + 2 * D);
                u[j][0] = bflo(cw4.x) * bflo(hw4.x); u[j][1] = bfhi(cw4.x) * bfhi(hw4.x); u[j][2] = bflo(cw4.y) * bflo(hw4.y); u[j][3] = bfhi(cw4.y) * bfhi(hw4.y);
                u[j][4] = bflo(cw4.z) * bflo(hw4.z); u[j][5] = bfhi(cw4.z) * bfhi(hw4.z); u[j][6] = bflo(cw4.w) * bflo(hw4.w); u[j][7] = bfhi(cw4.w) * bfhi(hw4.w); }
            else {
#pragma unroll
                for (int e = 0; e < 8; ++e) u[j][e] = 0.f; }
        }
        const u32x4 bw4 = *(const u32x4*)base;
        float bv[8] = {bflo(bw4.x), bfhi(bw4.x), bflo(bw4.y), bfhi(bw4.y), bflo(bw4.z), bfhi(bw4.z), bflo(bw4.w), bfhi(bw4.w)};
        float y[8];
#pragma unroll
        for (int e = 0; e < 8; ++e) { const int c = c8 + e; y[e] = bv[e] * (cw[c] * u[0][e] + cw[D + c] * u[1][e] + cw[2 * D + c] * u[2][e] + cb[c]); }
        u32x4 ow = {pk2(y[0], y[1]), pk2(y[2], y[3]), pk2(y[4], y[5]), pk2(y[6], y[7])};
        *(u32x4*)(OB + (size_t)row * D + c8) = ow;
    }
}
namespace at {
constexpr float SCALE = 0.08838834764831845f;
constexpr float C2 = 1.4426950408889634f * SCALE;
constexpr int OFF_V = 0, OFF_K = 16384, KVBUF = 32768  , OFF_WS = 65536, OFF_IMP = 67584, OFF_SELM = 83968, OFF_Q = 86016;
#define KSWZ(row, colB) ((row) * 256 + ((colB) ^ (((row) & 7) << 4)))
#define SBAR() __builtin_amdgcn_sched_barrier(0)
__device__ __forceinline__ int v_st(int k, int c) { const int kk = (k & ~0xC) | ((k & 4) << 1) | ((k & 8) >> 1); return ((kk >> 3) * 4 + (c >> 5)) * 512 + ((kk & 7) * 32 + (c & 31)) * 2; }
__device__ __forceinline__ int v_rd_base(int lane) { return ((lane & 3) << 3) | (((lane >> 2) & 3) << 6) | (((lane >> 4) & 1) << 5) | (((lane >> 5) & 1) << 8); }
constexpr int v_rd_off(int d0, int ks, int half) { return d0 * 512 + ks * 4096 + half * 2048; }
__device__ __forceinline__ int crow(int r, int hi) { return (r & 3) + 8 * (r >> 2) + 4 * hi; }
__device__ __forceinline__ unsigned cvtpk(float lo, float hi) { unsigned r; asm volatile("v_cvt_pk_bf16_f32 %0, %1, %2" : "=v"(r) : "v"(lo), "v"(hi)); return r; }

__device__ __forceinline__ void mask_tile(f32x16& p0, f32x16& p1, int dq, unsigned W, bool rowok) {
    const float NEG = -__builtin_inff();
#pragma unroll
    for (int r = 0; r < 16; ++r) {
        const int c = (r & 3) + 8 * (r >> 2);
        if (!rowok || (unsigned)(dq - c) >= W) p0[r] = NEG;
        if (!rowok || (unsigned)(dq - c - 32) >= W) p1[r] = NEG;
    }
}
__device__ __forceinline__ float rowmax32(const f32x16& p0, const f32x16& p1) {
    float pmax = p0[0];
#pragma unroll
    for (int r = 1; r < 16; ++r) pmax = fmaxf(pmax, p0[r]);
#pragma unroll
    for (int r = 0; r < 16; ++r) pmax = fmaxf(pmax, p1[r]);
    auto rr = __builtin_amdgcn_permlane32_swap(__float_as_uint(pmax), __float_as_uint(pmax), false, false);
    return fmaxf(__uint_as_float(rr[0]), __uint_as_float(rr[1]));
}
__device__ __forceinline__ float rowsum32(const f32x16& p0, const f32x16& p1) {
    float ps = 0.f;
#pragma unroll
    for (int r = 0; r < 16; ++r) ps += p0[r];
#pragma unroll
    for (int r = 0; r < 16; ++r) ps += p1[r];
    auto rr = __builtin_amdgcn_permlane32_swap(__float_as_uint(ps), __float_as_uint(ps), false, false);
    return __uint_as_float(rr[0]) + __uint_as_float(rr[1]);
}
__device__ __forceinline__ void pack_p(const f32x16& p0, const f32x16& p1, bf16x8& pa0, bf16x8& pa1, bf16x8& pa2, bf16x8& pa3) {
#define PK4(P, B_, OUT) do { unsigned a0 = cvtpk(P[B_+0], P[B_+1]), a1 = cvtpk(P[B_+2], P[B_+3]);                          \
        unsigned b0 = cvtpk(P[B_+4], P[B_+5]), b1 = cvtpk(P[B_+6], P[B_+7]);                                             \
        auto r0 = __builtin_amdgcn_permlane32_swap(a0, b0, false, false); auto r1 = __builtin_amdgcn_permlane32_swap(a1, b1, false, false); \
        u32x4 w = {r0[0], r1[0], r0[1], r1[1]}; OUT = *reinterpret_cast<bf16x8*>(&w); } while (0)
    PK4(p0, 0, pa0); PK4(p0, 8, pa1); PK4(p1, 0, pa2); PK4(p1, 8, pa3);
#undef PK4
}
__device__ __forceinline__ void qkt(f32x16& p0, f32x16& p1, const char* K_lds, int r32, int hi, const char* Qw) {
    p0 = f32x16{}; p1 = f32x16{};
    int ko[4];
#pragma unroll
    for (int dd = 0; dd < 4; ++dd) ko[dd] = KSWZ(r32, (dd * 16 + hi * 8) * 2);
#pragma unroll
    for (int d0 = 0; d0 < 8; ++d0) { const int off = ko[d0 & 3] + (d0 >> 2) * 128; const char* a = K_lds + off;
        bf16x8 b0 = *reinterpret_cast<const bf16x8*>(a);
        bf16x8 b1 = *reinterpret_cast<const bf16x8*>(a + 32 * 256);
        bf16x8 q = *reinterpret_cast<const bf16x8*>(Qw + off);
        p0 = __builtin_amdgcn_mfma_f32_32x32x16_bf16(b0, q, p0, 0, 0, 0);
        p1 = __builtin_amdgcn_mfma_f32_32x32x16_bf16(b1, q, p1, 0, 0, 0); }
}
__device__ __forceinline__ void q_park(char* Qw, int r32, int hi, int d0, bf16x8 v) { *(bf16x8*)(Qw + KSWZ(r32, (d0 * 16 + hi * 8) * 2)) = v; }
__device__ __forceinline__ void pv_tile(f32x16 (&o)[4], int vb0, bf16x8 pa0, bf16x8 pa1, bf16x8 pa2, bf16x8 pa3) {
#define TRRD(dst, off) asm volatile("ds_read_b64_tr_b16 %0, %1 offset:%2" : "=&v"(dst) : "v"(vb0), "i"(off) : "memory")
#define PV_RD(S_, d0) do { constexpr int b_ = v_rd_off(d0, 0, 0); \
        TRRD(S_##l0, b_); TRRD(S_##h0, b_ + 2048); TRRD(S_##l1, b_ + 4096); TRRD(S_##h1, b_ + 6144); TRRD(S_##l2, b_ + 8192); TRRD(S_##h2, b_ + 10240); TRRD(S_##l3, b_ + 12288); TRRD(S_##h3, b_ + 14336); } while (0)
#define PV_MM(S_, d0) do { \
        o[d0] = __builtin_amdgcn_mfma_f32_32x32x16_bf16(pa0, (bf16x8){S_##l0[0], S_##l0[1], S_##l0[2], S_##l0[3], S_##h0[0], S_##h0[1], S_##h0[2], S_##h0[3]}, o[d0], 0, 0, 0);   \
        o[d0] = __builtin_amdgcn_mfma_f32_32x32x16_bf16(pa1, (bf16x8){S_##l1[0], S_##l1[1], S_##l1[2], S_##l1[3], S_##h1[0], S_##h1[1], S_##h1[2], S_##h1[3]}, o[d0], 0, 0, 0);   \
        o[d0] = __builtin_amdgcn_mfma_f32_32x32x16_bf16(pa2, (bf16x8){S_##l2[0], S_##l2[1], S_##l2[2], S_##l2[3], S_##h2[0], S_##h2[1], S_##h2[2], S_##h2[3]}, o[d0], 0, 0, 0);   \
        o[d0] = __builtin_amdgcn_mfma_f32_32x32x16_bf16(pa3, (bf16x8){S_##l3[0], S_##l3[1], S_##l3[2], S_##l3[3], S_##h3[0], S_##h3[1], S_##h3[2], S_##h3[3]}, o[d0], 0, 0, 0); } while (0)
#define LWAIT() do { asm volatile("s_waitcnt lgkmcnt(0)" ::: "memory"); SBAR(); } while (0)
    s16x4 Al0, Al1, Al2, Al3, Ah0, Ah1, Ah2, Ah3, Bl0, Bl1, Bl2, Bl3, Bh0, Bh1, Bh2, Bh3;
    PV_RD(A, 0); LWAIT();
    PV_RD(B, 1); SBAR(); PV_MM(A, 0); LWAIT();
    PV_RD(A, 2); SBAR(); PV_MM(B, 1); LWAIT();
    PV_RD(B, 3); SBAR(); PV_MM(A, 2); LWAIT();
    PV_MM(B, 3);
#undef LWAIT
#undef PV_MM
#undef PV_RD
#undef TRRD
}

template <int MODE>
__device__ __forceinline__ void attn_tiles(f32x16 (&o)[4], float& m_reg, float& l_reg, const char* Qw, const bf16_t* Kb, const bf16_t* Vb, int ldk,
                                           int t_lo, int t_hi, int tpos, unsigned long long sel, int own, float rl, char* lds, int tid, int wid, int lane) {
    asm volatile("" : "+v"(tid)); asm volatile("" : "+v"(lane));
    const int r32 = lane & 31, hi = lane >> 5;
    float* al_l = (float*)(lds + OFF_WS) + wid * 64;
    const int sr = tid >> 4, sc = (tid & 15) * 8;
    const int kws = KSWZ(sr, sc * 2), vst0 = v_st(sr, sc), vst1 = v_st(32 + sr, sc);
    const int vbase = (int)(uintptr_t)(lds + OFF_V) + v_rd_base(lane);
    bf16x8 sk0, sk1, sv0, sv1;
    sk0 = sk1 = sv0 = sv1 = (bf16x8){0, 0, 0, 0, 0, 0, 0, 0};
    float carry = 0.f;
#define LOADT(tt) do { const bf16_t* kp_ = Kb + (size_t)((tt) * 64 + sr) * ldk + sc; sk0 = *(const bf16x8*)kp_; sk1 = *(const bf16x8*)(kp_ + (size_t)32 * ldk); \
        if (MODE != 3) { const bf16_t* vp_ = Vb + (size_t)((tt) * 64 + sr) * ldk + sc; sv0 = *(const bf16x8*)vp_; sv1 = *(const bf16x8*)(vp_ + (size_t)32 * ldk); } } while (0)
#define WRITET(bo) do { *(bf16x8*)(lds + (bo) + OFF_K + kws) = sk0; *(bf16x8*)(lds + (bo) + OFF_K + kws + 32 * 256) = sk1; \
        if (MODE != 3) { *(bf16x8*)(lds + (bo) + OFF_V + vst0) = sv0; *(bf16x8*)(lds + (bo) + OFF_V + vst1) = sv1; } } while (0)
    if (t_lo < t_hi) { LOADT(t_lo); __syncthreads(); WRITET(0); if (t_lo + 1 < t_hi) LOADT(t_lo + 1); __syncthreads(); }
    if (wid >= 4) __builtin_amdgcn_s_setprio(1);
    for (int t = t_lo; t < t_hi; ++t) {
        const int bo = ((t - t_lo) & 1) * KVBUF;
        if (t + 1 < t_hi) { WRITET(bo ^ KVBUF); if (t + 2 < t_hi) LOADT(t + 2); }
        const char* K_lds = lds + bo + OFF_K; const int vb0 = vbase + bo;
        bool rowok = true, needm = true; unsigned Wm = 0x7fffffffu;
        if (MODE == 0) { const int kb = t >> 2; if (kb < own) { rowok = ((sel >> kb) & 1ull) != 0ull; needm = false; } else needm = ((t - 4 * own) * 64 + 63 > 32 * wid); }
        if (MODE == 1) { rowok = ((sel >> t) & 1ull) != 0ull; needm = (t == t_hi - 1); }
        if (MODE == 2) { Wm = 512u; needm = (t == t_hi - 1) || (t == t_hi - 9); }
        bool skipw = (MODE == 0) && ((t >> 2) >= own) && ((t - 4 * own) * 64 > 32 * wid + 31);
        if (MODE == 0 || MODE == 1) skipw = skipw || !__any(rowok);
        if (!skipw) {
        f32x16 p0, p1;
        qkt(p0, p1, K_lds, r32, hi, Qw);
        if (needm) mask_tile(p0, p1, tpos - t * 64 - 4 * hi, Wm, true);
        const float NEGINF = -__builtin_inff();
        if (MODE == 3) {
            const float pmax = rowmax32(p0, p1);
            const float mn = fmaxf(m_reg, pmax); const float alpha = __builtin_amdgcn_exp2f((m_reg - mn) * C2); m_reg = mn;
            const float mnL = -mn * C2;
#pragma unroll
            for (int r = 0; r < 16; ++r) { p0[r] = __builtin_amdgcn_exp2f(fmaf(p0[r], C2, mnL)); p1[r] = __builtin_amdgcn_exp2f(fmaf(p1[r], C2, mnL)); }
            l_reg = l_reg * alpha + rowsum32(p0, p1);
        } else if (MODE == 4) {
            const float mnL = -m_reg * C2;
#pragma unroll
            for (int r = 0; r < 16; ++r) { p0[r] = __builtin_amdgcn_exp2f(fmaf(p0[r], C2, mnL)) * rl; p1[r] = __builtin_amdgcn_exp2f(fmaf(p1[r], C2, mnL)) * rl; }
            float* impA = (float*)(lds + OFF_IMP + wid * 2048);
#pragma unroll
            for (int half = 0; half < 2; ++half)
#pragma unroll
                for (int rr = 0; rr < 4; ++rr) {
                    float a = half ? ((p1[4 * rr] + p1[4 * rr + 1]) + (p1[4 * rr + 2] + p1[4 * rr + 3])) : ((p0[4 * rr] + p0[4 * rr + 1]) + (p0[4 * rr + 2] + p0[4 * rr + 3]));
                    float bl = half ? p1[4 * rr + 3] : p0[4 * rr + 3];
                    a += __shfl_xor(a, 1); a += __shfl_xor(a, 2); bl += __shfl_xor(bl, 1); bl += __shfl_xor(bl, 2);
                    const float other = __shfl_xor(bl, 32);
                    const float add = hi ? other : carry;
                    carry = other;
                    const int j = 16 * t + 8 * half + 2 * rr + hi;
                    if ((r32 & 3) == 0) impA[(r32 >> 2) * 64 + j] = a + add;
                }
            bf16x8 pa0, pa1, pa2, pa3; pack_p(p0, p1, pa0, pa1, pa2, pa3);
            pv_tile(o, vb0, pa0, pa1, pa2, pa3);
        } else {
            float pmax = rowmax32(p0, p1); pmax = rowok ? pmax : NEGINF;
            float mn, alpha;
            if (__all((pmax - m_reg) * SCALE <= 8.f)) { mn = m_reg; alpha = 1.f; }
            else { mn = fmaxf(m_reg, pmax); alpha = __builtin_amdgcn_exp2f((m_reg - mn) * C2); m_reg = mn; }
            const float mnL = rowok ? -mn * C2 : NEGINF;
#pragma unroll
            for (int r = 0; r < 16; ++r) { p0[r] = __builtin_amdgcn_exp2f(fmaf(p0[r], C2, mnL)); p1[r] = __builtin_amdgcn_exp2f(fmaf(p1[r], C2, mnL)); }
            l_reg = l_reg * alpha + rowsum32(p0, p1);
            bf16x8 pa0, pa1, pa2, pa3; pack_p(p0, p1, pa0, pa1, pa2, pa3);
            if (__any(alpha < 1.f)) {
                if (hi == 0) al_l[r32] = alpha;
                asm volatile("s_waitcnt lgkmcnt(0)" ::: "memory");
#pragma unroll
                for (int r = 0; r < 16; ++r) { const float f = al_l[crow(r, hi)];
#pragma unroll
                    for (int d_ = 0; d_ < 4; ++d_) o[d_][r] *= f; }
            }
            pv_tile(o, vb0, pa0, pa1, pa2, pa3);
        }
        }
        __syncthreads();
    }
    __builtin_amdgcn_s_setprio(0);
#undef LOADT
#undef WRITET
}

template <bool NSA, bool ACCUM>
__device__ __forceinline__ void store_o(const f32x16 (&o)[4], float f, bf16_t* OB, size_t rowbase, int tok0, int hbase, char* lds, int wid, int lane) {
    asm volatile("" : "+v"(lane));
    const int r32 = lane & 31, hi = lane >> 5;
    float* li_l = (float*)(lds + OFF_WS) + wid * 64 + 32;
    if (hi == 0) li_l[r32] = f;
    asm volatile("s_waitcnt lgkmcnt(0)" ::: "memory");
#pragma unroll
    for (int r = 0; r < 16; ++r) {
        const int rw = crow(r, hi); const float fr = li_l[rw];
        const int tok = NSA ? tok0 + (rw >> 2) : tok0 + rw, hd = NSA ? hbase + (rw & 3) : hbase;
        bf16_t* op = OB + (rowbase + tok) * D + hd * HD + r32;
#pragma unroll
        for (int d0 = 0; d0 < 4; ++d0) {
            float v = o[d0][r] * fr; float vn = __shfl_xor(v, 1);
            if ((r32 & 1) == 0) { unsigned* wp = (unsigned*)(op + d0 * 32);
                if (ACCUM) { const unsigned old = *wp; v += bflo(old); vn += bfhi(old); }
                *wp = cvtpk(v, vn); }
        }
    }
}
}

__device__ __forceinline__ void moba_unit(const Params& P, int b, int h, int own, char* lds, int tid, int wid, int lane) {
    using namespace at;
    const bf16_t* BIG = (const bf16_t*)(P.ws + WS_BIG); const float* KMEAN = (const float*)(P.ws + WS_KMEAN); bf16_t* OB = (bf16_t*)(P.ws + WS_OB);
    const int r32 = lane & 31, hi = lane >> 5;
    const int tokl = own * 256 + wid * 32 + r32; const size_t row = (size_t)b * S + tokl;
    char* Qw = lds + OFF_Q + wid * 8192;
#pragma unroll
    for (int d0 = 0; d0 < 8; ++d0) q_park(Qw, r32, hi, d0, *(const bf16x8*)(BIG + row * MQ_LD + h * HD + d0 * 16 + hi * 8));
    char* K_lds = lds + OFF_K;
    { const int sr = tid >> 4, sc = (tid & 15) * 8; const int kws = KSWZ(sr, sc * 2);
      bf16x8 z0 = (bf16x8){0, 0, 0, 0, 0, 0, 0, 0}; const bf16x8 z1 = z0;
      if (sr < 16) { const float* km = KMEAN + (size_t)((b * NH + h) * 16 + sr) * HD + sc; z0 = pack8(*(const f32x4*)km, *(const f32x4*)(km + 4)); }
      __syncthreads();
      *(bf16x8*)(K_lds + kws) = z0; *(bf16x8*)(K_lds + kws + 32 * 256) = z1;
      __syncthreads(); }
    unsigned sel = 0u;
    { f32x16 p0, p1; qkt(p0, p1, K_lds, r32, hi, Qw);
      float g[16];
#pragma unroll
      for (int r = 0; r < 8; ++r) { const float mine = p0[r], other = __shfl_xor(mine, 32); const int nb = (r & 3) + 8 * (r >> 2);
          g[nb] = hi == 0 ? mine : other; g[nb + 4] = hi == 0 ? other : mine; }
      if (own <= 3) sel = (1u << own) - 1u;
      else {
#pragma unroll
          for (int pass = 0; pass < 3; ++pass) { float best = 0.f; int bi = -1;
#pragma unroll
              for (int n = 0; n < 16; ++n) { const bool cand = (n < own) && (((sel >> n) & 1u) == 0u); if (cand && (bi < 0 || g[n] > best)) { best = g[n]; bi = n; } }
              sel |= 1u << bi; }
      } }
    f32x16 o[4]; o[0] = f32x16{}; o[1] = f32x16{}; o[2] = f32x16{}; o[3] = f32x16{};
    float m_reg = -1e30f, l_reg = 0.f;
    const bf16_t* Kb = BIG + (size_t)b * S * MQ_LD + D + h * HD; const bf16_t* Vb = Kb + D;
    attn_tiles<0>(o, m_reg, l_reg, Qw, Kb, Vb, MQ_LD, 0, 4 * own + 4, tokl, (unsigned long long)sel, own, 0.f, lds, tid, wid, lane);
    store_o<false, false>(o, 1.f / l_reg, OB, (size_t)b * S, own * 256 + wid * 32, h, lds, wid, lane);
}
__device__ __forceinline__ void phase_moba_attn(const Params& P, char* lds, int bid, int G, int tid, int wid, int lane) {
    asm volatile("" : "+v"(tid)); asm volatile("" : "+v"(lane));
    for (int p0 = bid; p0 < NB * NH * 8; p0 += G) {
        int pr = p0; if (G == 256) { const int xcd = p0 & 7, slot = p0 >> 3; pr = (xcd * 4 + (slot >> 3)) * 8 + (slot & 7); }
        const int x = pr & 7, h = (pr >> 3) & 15, b = pr >> 7;
        moba_unit(P, b, h, 15 - x, lds, tid, wid, lane);
        moba_unit(P, b, h, x, lds, tid, wid, lane);
    }
}

__device__ __forceinline__ void nsa_unit(const Params& P, int b, int g, int c, char* lds, int tid, int wid, int lane) {
    using namespace at;
    const bf16_t* BIG = (const bf16_t*)(P.ws + WS_BIG); const bf16_t* QROT = (const bf16_t*)(P.ws + WS_PP); bf16_t* OB = (bf16_t*)(P.ws + WS_OB);
    const int r32 = lane & 31, hi = lane >> 5;
    const int tokl = 64 * c + 8 * wid + (r32 >> 2), head = 4 * g + (r32 & 3); const size_t row = (size_t)b * S + tokl;
    char* Qw = lds + OFF_Q + wid * 8192;
#pragma unroll
    for (int d0 = 0; d0 < 8; ++d0) q_park(Qw, r32, hi, d0, *(const bf16x8*)(BIG + row * NQ_LD + head * HD + d0 * 16 + hi * 8));
    f32x16 o[4]; o[0] = f32x16{}; o[1] = f32x16{}; o[2] = f32x16{}; o[3] = f32x16{};
    float m_reg = -1e30f, l_reg = 0.f;
    const bf16_t* Kc = (const bf16_t*)(P.ws + WS_KC) + (size_t)(b * 4 + g) * 256 * HD; const bf16_t* Vc = (const bf16_t*)(P.ws + WS_VC) + (size_t)(b * 4 + g) * 256 * HD;
    const int tq = (tokl - 31) >> 4;
    const int ncmp = ((4 * c + 2) >> 6) + 1;
    attn_tiles<3>(o, m_reg, l_reg, Qw, Kc, Vc, HD, 0, ncmp, tq, 0ull, 0, 0.f, lds, tid, wid, lane);
    const float rl = l_reg > 0.f ? 1.f / l_reg : 0.f;
    attn_tiles<4>(o, m_reg, l_reg, Qw, Kc, Vc, HD, 0, ncmp, tq, 0ull, 0, rl, lds, tid, wid, lane);
    store_o<true, false>(o, sigmoidf_(bf1(BIG[row * NQ_LD + 5120 + head * 3 + 0])), OB, (size_t)b * S, 64 * c + 8 * wid, 4 * g, lds, wid, lane);
    unsigned long long sel;
    { float* impA = (float*)(lds + OFF_IMP + wid * 2048);
      unsigned long long* selm = (unsigned long long*)(lds + OFF_SELM + wid * 64);
      asm volatile("s_waitcnt lgkmcnt(0)" ::: "memory");
      const float INF = __builtin_inff();
      for (int tk = 0; tk < 8; ++tk) {
          float val = impA[tk * 64 + lane];
          if (lane == 0 || lane == c) val = INF; else if (lane > c) val = -INF;
          const unsigned u_ = __float_as_uint(val); const unsigned key = (u_ & 0x80000000u) ? ~u_ : (u_ | 0x80000000u);
          unsigned thr = 0u;
#pragma unroll
          for (int bit = 31; bit >= 0; --bit) { const unsigned cand = thr | (1u << bit); if (__popcll(__ballot(key >= cand)) >= 16) thr = cand; }
          const unsigned long long gt_ = __ballot(key > thr), eq_ = __ballot(key == thr);
          const int need = 16 - __popcll(gt_), eqrank = __popcll(eq_ & ((1ull << lane) - 1ull));
          const bool s = ((key > thr) || (key == thr && eqrank < need)) && (val > -INF);
          const unsigned long long mk = __ballot(s);
          if (lane == 0) selm[tk] = mk;
      }
      asm volatile("s_waitcnt lgkmcnt(0)" ::: "memory");
      sel = selm[r32 >> 2]; }
    {
      const int pos_ = ((const int*)P.in[2])[row];
      const u32x4 w1 = *(const u32x4*)(Qw + KSWZ(r32, (0 * 16 + hi * 8) * 2)), w2 = *(const u32x4*)(Qw + KSWZ(r32, (1 * 16 + hi * 8) * 2));
      float x1[8] = {bflo(w1.x), bfhi(w1.x), bflo(w1.y), bfhi(w1.y), bflo(w1.z), bfhi(w1.z), bflo(w1.w), bfhi(w1.w)};
      float x2[8] = {bflo(w2.x), bfhi(w2.x), bflo(w2.y), bfhi(w2.y), bflo(w2.z), bfhi(w2.z), bflo(w2.w), bfhi(w2.w)};
#pragma unroll
      for (int j = 0; j < 8; ++j) { const int i_ = hi * 8 + j;
          const float freq = __builtin_amdgcn_exp2f(-(float)i_ * (18.931568569324174f / 16.0f));
          const float ang = (float)pos_ * freq; const double rev = (double)ang * 0.15915494309189535; const float fr_ = (float)(rev - floor(rev));
          const float c_ = __builtin_amdgcn_cosf(fr_), s_ = __builtin_amdgcn_sinf(fr_);
          const float a1 = x1[j], a2 = x2[j]; x1[j] = a1 * c_ - a2 * s_; x2[j] = a2 * c_ + a1 * s_; }
      q_park(Qw, r32, hi, 0, pack8((f32x4){x1[0], x1[1], x1[2], x1[3]}, (f32x4){x1[4], x1[5], x1[6], x1[7]}));
      q_park(Qw, r32, hi, 1, pack8((f32x4){x2[0], x2[1], x2[2], x2[3]}, (f32x4){x2[4], x2[5], x2[6], x2[7]})); }
    o[0] = f32x16{}; o[1] = f32x16{}; o[2] = f32x16{}; o[3] = f32x16{}; m_reg = -1e30f; l_reg = 0.f;
    const bf16_t* kvb = BIG + (size_t)b * S * NQ_LD + D + g * HD;
    attn_tiles<1>(o, m_reg, l_reg, Qw, kvb + 2 * 512, kvb + 3 * 512, NQ_LD, 0, c + 1, tokl, sel, 0, 0.f, lds, tid, wid, lane);
    store_o<true, true>(o, sigmoidf_(bf1(BIG[row * NQ_LD + 5120 + head * 3 + 1])) / l_reg, OB, (size_t)b * S, 64 * c + 8 * wid, 4 * g, lds, wid, lane);
    o[0] = f32x16{}; o[1] = f32x16{}; o[2] = f32x16{}; o[3] = f32x16{}; m_reg = -1e30f; l_reg = 0.f;
    attn_tiles<2>(o, m_reg, l_reg, Qw, kvb + 4 * 512, kvb + 5 * 512, NQ_LD, (c > 8 ? c - 8 : 0), c + 1, tokl, 0ull, 0, 0.f, lds, tid, wid, lane);
    store_o<true, true>(o, sigmoidf_(bf1(BIG[row * NQ_LD + 5120 + head * 3 + 2])) / l_reg, OB, (size_t)b * S, 64 * c + 8 * wid, 4 * g, lds, wid, lane);
}
__device__ __forceinline__ void phase_nsa_attn(const Params& P, char* lds, int bid, int G, int tid, int wid, int lane) {
    asm volatile("" : "+v"(tid)); asm volatile("" : "+v"(lane));
    for (int p0 = bid; p0 < NB * 4 * 32; p0 += G) {
        int pr = p0; if (G == 256) { const int xcd = p0 & 7, slot = p0 >> 3; pr = xcd * 32 + slot; }
        const int x = pr & 31, g = (pr >> 5) & 3, b = pr >> 7;
        nsa_unit(P, b, g, 63 - x, lds, tid, wid, lane);
        nsa_unit(P, b, g, x, lds, tid, wid, lane);
    }
}
typedef unsigned v4u __attribute__((ext_vector_type(4)));
#define XB_TMO      128
#define XB_XCNT(j)  (256  + 64 * (j))
#define XB_XSUB(j)  (1280 + 64 * (j))
#define XB_XGEN(j)  (2304 + 64 * (j))
#define XB_TOP      3328
#define XB_TOPGEN   3392
#define XCD_BAR_WORDS 3456
#define XB_SPIN_CAP (1u << 18)

__device__ __forceinline__ unsigned xb_ld(unsigned* p)              { return __hip_atomic_load(p, __ATOMIC_RELAXED, __HIP_MEMORY_SCOPE_AGENT); }
__device__ __forceinline__ unsigned xb_add(unsigned* p, unsigned v) { return __hip_atomic_fetch_add(p, v, __ATOMIC_RELAXED, __HIP_MEMORY_SCOPE_AGENT); }
__device__ __forceinline__ unsigned xb_xcc_id() { return (unsigned)__builtin_amdgcn_s_getreg((3 << 11) | 20) & 0xFu; }
#define XB_SPIN(cond, bar) do { unsigned _sp = 0; while (cond) { __builtin_amdgcn_s_sleep(1); \
    if ((++_sp & 255u) == 0u) { if (xb_ld(&(bar)[XB_TMO])) break; if (_sp > XB_SPIN_CAP) { atomicAdd(&(bar)[XB_TMO], 1u); break; } } } } while (0)

struct XcdBarrier {
    unsigned* bar; unsigned x;
    volatile LAS unsigned* st;
};

__device__ __forceinline__ XcdBarrier xcd_barrier_post(unsigned* bar, volatile LAS unsigned* st) {
    XcdBarrier b; b.bar = bar; b.x = xb_xcc_id(); b.st = st;
    if (threadIdx.x == 0) (void)xb_add(&bar[XB_XCNT(b.x)], 1u);
    return b;
}
__device__ __forceinline__ void xcd_barrier_complete(unsigned* bar, unsigned x, unsigned& nloc, unsigned& nx) {
    const unsigned G = gridDim.x * gridDim.y * gridDim.z;
    unsigned sum, cnt, mine, sp = 0u;
    for (;;) {
        sum = 0u; cnt = 0u; mine = 0u;
#pragma unroll
        for (unsigned j = 0; j < 16; ++j) { const unsigned c = xb_ld(&bar[XB_XCNT(j)]); sum += c; cnt += (c > 0u) ? 1u : 0u; mine = (j == x) ? c : mine; }
        if (sum == G) break;
        __builtin_amdgcn_s_sleep(1);
        if ((++sp & 255u) == 0u) { if (xb_ld(&bar[XB_TMO])) break; if (sp > XB_SPIN_CAP) { atomicAdd(&bar[XB_TMO], 1u); break; } }
    }
    nloc = mine > 0u ? mine : 1u; nx = cnt > 0u ? cnt : 1u;
}

__device__ __forceinline__ void xcd_barrier(const XcdBarrier& b) {
    asm volatile("s_waitcnt vmcnt(0)" ::: "memory");
    __syncthreads();
    if (threadIdx.x == 0) {
        unsigned* bar = b.bar;
        __builtin_amdgcn_s_waitcnt(0);
        unsigned nloc = b.st[0], nx = b.st[1];
        if (nloc == 0u) { xcd_barrier_complete(bar, b.x, nloc, nx); b.st[0] = nloc; b.st[1] = nx; }
        const unsigned old = xb_add(&bar[XB_XSUB(b.x)], 1u);
        const unsigned gen = old / nloc;
        if (old + 1u == (gen + 1u) * nloc) {
            __builtin_amdgcn_fence(__ATOMIC_RELEASE, "agent");
            asm volatile("s_waitcnt vmcnt(0)" ::: "memory");
            const unsigned og = xb_add(&bar[XB_TOP], 1u);
            const unsigned tg = og / nx;
            if (og + 1u == (tg + 1u) * nx) xb_add(&bar[XB_TOPGEN], 1u);
            else XB_SPIN(xb_ld(&bar[XB_TOPGEN]) == tg, bar);
            __builtin_amdgcn_fence(__ATOMIC_ACQUIRE, "agent");
            xb_add(&bar[XB_XGEN(b.x)], 1u);
            asm volatile("s_waitcnt vmcnt(0)" ::: "memory");
        } else {
            XB_SPIN(xb_ld(&bar[XB_XGEN(b.x)]) == gen, bar);
            __builtin_amdgcn_fence(__ATOMIC_ACQUIRE, "agent");
            asm volatile("s_waitcnt vmcnt(0)" ::: "memory");
        }
    }
    __syncthreads();
}

__global__ void __launch_bounds__(NTHREADS, 2) trunk_fwd(Params P) {
    extern __shared__ __attribute__((aligned(16))) unsigned char lds_raw[];
    char* lds = (char*)lds_raw;
    cg::grid_group grid = cg::this_grid();
    const int tid = threadIdx.x, lane = tid & 63, wid = __builtin_amdgcn_readfirstlane(tid >> 6);
    const int bid = blockIdx.x, G = gridDim.x;
    const int gw = bid * NWAVES + wid, NGW = G * NWAVES, gtid = bid * NTHREADS + tid, NT = G * NTHREADS;
    unsigned char* ws = P.ws;
    const float* x = (const float*)P.in[0];
    float* out = P.out;
    bf16_t* XN = (bf16_t*)(ws + WS_XN); bf16_t* OB = (bf16_t*)(ws + WS_OB); bf16_t* PPB = (bf16_t*)(ws + WS_PP); bf16_t* BIG = (bf16_t*)(ws + WS_BIG);

    volatile LAS unsigned* bst = (volatile LAS unsigned*)((LAS unsigned char*)lds_raw + LDS_BYTES - 16);
    if (tid == 0) { bst[0] = 0u; bst[1] = 0u; }
    __syncthreads();
    const XcdBarrier bar = xcd_barrier_post((unsigned*)(ws + WS_CTL), bst);
#define GSYNC() do { XcdBarrier b2_ = bar; asm volatile("" : "+s"(b2_.x)); xcd_barrier(b2_); } while (0)
    phase_convert(P, lds, gw, NGW, gtid, NT, wid, lane);
    __syncthreads();
    if (P.out == nullptr) grid.sync();
    GSYNC();

    bf16_t* hbc = XN;
    bf16_t* hbo = (bf16_t*)(ws + WS_HB1);
    unsigned* SS = (unsigned*)(ws + WS_SS);
    for (int i = 0; i < 4; ++i) {
        if (i == 1) {
            phase_pool_prep(hbc, SS + (size_t)(3 * i) * T, (const float*)P.in[3] + (size_t)i * D, OB, lds, bid, G, tid, wid, lane);
            GSYNC();
            for (int gq = 0; gq < 4; ++gq) {
                pg8::EpiH<0> E{nullptr, hbc, nullptr, (const float*)P.in[15], gq * 512, nullptr, nullptr, hbc, SS + (size_t)(3 * i + 1) * T};
                gemm_run(lds, OB + gq * 512, D, (const bf16_t*)(ws + WS_POOL) + (size_t)gq * 512 * 512, 512, T, 512, 512, G, (bid + gq * (G / 4)) % G, E);
            }
            GSYNC();
        } else {
            { const bf16_t* Wt = (const bf16_t*)(ws + (i == 0 ? WS_MQKV : (i == 2 ? WS_NQKV : WS_CIN))); const int N = (i == 2) ? NQ_LD : MQ_LD;
              pg8::EpiB<0> E{BIG, N, SS + (size_t)(3 * i) * T};
              gemm_run(lds, hbc, D, Wt, D, T, N, D, G, bid, E); }
            GSYNC();
            if (i == 0) {
                phase_moba_prep(P, lds, bid, G, tid, wid, lane);
                GSYNC();
                phase_moba_attn(P, lds, bid, G, tid, wid, lane);
            } else if (i == 2) {
                phase_nsa_norm(P, gw, NGW, lane);
                phase_nsa_compress(P, lds, bid, G, tid, wid, lane);
                GSYNC();
                phase_nsa_attn(P, lds, bid, G, tid, wid, lane);
            } else {
                phase_conv_elem(P, gtid, NT);
            }
            __syncthreads();
            GSYNC();
            { const bf16_t* Wt = (const bf16_t*)(ws + (i == 0 ? WS_MWO : (i == 2 ? WS_NWO : WS_CWO)));
              pg8::EpiH<0> E{(i == 0) ? x : nullptr, hbc, nullptr, nullptr, 0, nullptr, nullptr, hbc, SS + (size_t)(3 * i + 1) * T};
              gemm_run(lds, OB, D, Wt, D, T, D, D, G, bid, E); }
            GSYNC();
        }
        { pg8::EpiB<2> E{BIG, FF, nullptr};
          gemm_run(lds, hbc, D, (const bf16_t*)(ws + WS_W1T + (size_t)i * 32 * MiB), D, T, FF, D, G, bid, E); }
        { pg8::EpiB<0> E{PPB, D, nullptr};
          gemm_run(lds, (const bf16_t*)(ws + WS_PB) + (size_t)i * T * 256, 256, (const bf16_t*)(ws + WS_PPT + (size_t)i * 1 * MiB), 256, T, D, 256, G, bid, E); }
        GSYNC();
        { pg8::EpiH<0> E{nullptr, hbc, nullptr, nullptr, 0, nullptr, SS + (size_t)(3 * i + 1) * T, hbc, SS + (size_t)(3 * i + 2) * T};
          gemm_run(lds, BIG, FF, (const bf16_t*)(ws + WS_W2T + (size_t)i * 32 * MiB), FF, T, D, FF, G, bid, E); }
        GSYNC();
        { pg8::EpiH<1> E{nullptr, hbc, (i == 3) ? out : nullptr, nullptr, 0, PPB, SS + (size_t)(3 * i + 2) * T, (i < 3) ? hbo : nullptr, (i < 3) ? SS + (size_t)(3 * i + 3) * T : nullptr};
          gemm_run(lds, hbc, D, (const bf16_t*)(ws + WS_PGT + (size_t)i * 8 * MiB), D, T, D, D, G, bid, E); }
        if (i < 3) { GSYNC(); bf16_t* tsw = hbc; hbc = hbo; hbo = tsw; }
    }
}

extern "C" void kernel_launch(void* const* d_in, const int* in_sizes, int n_in, void* d_out, int out_size, void* d_ws, size_t ws_size, hipStream_t stream) {
    static int grid = 0;
    if (grid == 0) {
        if (n_in != 29 || out_size != T * D || ws_size < WS_END) { fprintf(stderr, "kernel_launch: unexpected problem (n_in %d, out %d, ws %zu)\n", n_in, out_size, ws_size); grid = -1; return; }
        int dev = 0, cus = 0, per_cu = 0;
        hipGetDevice(&dev);
        hipDeviceGetAttribute(&cus, hipDeviceAttributeMultiprocessorCount, dev);
        hipFuncSetAttribute((const void*)trunk_fwd, hipFuncAttributeMaxDynamicSharedMemorySize, LDS_BYTES);
        hipOccupancyMaxActiveBlocksPerMultiprocessor(&per_cu, (const void*)trunk_fwd, NTHREADS, LDS_BYTES);
        (void)hipGetLastError();
        if (per_cu < 1) { fprintf(stderr, "kernel_launch: occupancy query says %d blocks per CU\n", per_cu); per_cu = 1; }
        grid = cus;
        fprintf(stderr, "kernel_launch: cus %d per_cu %d grid %d\n", cus, per_cu, grid);
    }
    if (grid < 0) return;
    if (hipMemsetAsync((char*)d_ws + WS_CTL, 0, 1048576, stream) != hipSuccess) { fprintf(stderr, "kernel_launch: memset failed\n"); return; }
    Params p{};
    for (int i = 0; i < 29; ++i) p.in[i] = d_in[i];
    p.out = (float*)d_out; p.ws = (unsigned char*)d_ws;
    void* args[] = {&p};
    hipError_t e = hipLaunchCooperativeKernel((const void*)trunk_fwd, dim3(grid), dim3(NTHREADS), args, LDS_BYTES, stream);
    if (e != hipSuccess) fprintf(stderr, "cooperative launch failed: %s (grid %d)\n", hipGetErrorString(e), grid);
}
```

```cpp
#include <hip/hip_runtime.h>
#include <hip/hip_cooperative_groups.h>
#include <cstdio>
#include <cstdint>
namespace cg = cooperative_groups;
namespace pg8 {
#define PG8_LAS __attribute__((address_space(3)))
typedef unsigned short bf16_t;
typedef short bf16x8 __attribute__((ext_vector_type(8)));
typedef float f32x4 __attribute__((ext_vector_type(4)));
typedef unsigned u32x4 __attribute__((ext_vector_type(4)));
typedef unsigned u32x2_ __attribute__((ext_vector_type(2)));
constexpr int BM = 256, BK = 64, HALF = 128, HTB = HALF * BK * 2  , STAGE_BYTES = 8 * HTB, NXCD = 8, WGM = 8;

__host__ __device__ __forceinline__ int lds_byte(int r, int c) { const int st = (r >> 4) * 2 + (c >> 5), rr = r & 15, cc = c & 31, ob = rr * 64 + cc * 2; return st * 1024 + (ob ^ (((ob >> 9) & 1) << 5)); }
__host__ __device__ __forceinline__ void stage_rc(int b, int& R, int& C) { const int st = b / 1024, sb = b % 1024, swz = sb ^ (((sb >> 9) & 1) << 5); R = (st >> 1) * 16 + swz / 64; C = (st & 1) * 32 + (swz % 64) / 2; }
__host__ __device__ __forceinline__ int perm32(int rho) { const int n = rho >> 4, i = rho & 15; return 8 * (i >> 2) + 4 * n + (i & 3); }

struct Unit { int pm, pn; };
struct Gemm { const bf16_t* A; const bf16_t* Bt; int M, N, K, lda, ldb; };

struct StaticOrder {
    int nM, nN, nwg, G, c;
    __host__ __device__ void init(int M, int N, int G_, int c_) { nM = M / BM; nN = N / BM; nwg = nM * nN; G = G_; c = c_; }
    __host__ __device__ bool next(int i, Unit& u) const {
        const long L = (long)i * G + c; if (L >= nwg) return false;
        int wgid = (int)L; { const int q = nwg / NXCD, r = nwg % NXCD, xcd = wgid % NXCD, off = wgid / NXCD; wgid = (xcd < r ? xcd * (q + 1) : r * (q + 1) + (xcd - r) * q) + off; }
        const int nig = WGM * nN, gid = wgid / nig, fm = gid * WGM, gsz = (nM - fm) < WGM ? (nM - fm) : WGM;
        u.pm = fm + ((wgid % nig) % gsz); u.pn = (wgid % nig) / gsz; return true;
    }
    __device__ __forceinline__ void a_ready(const Unit&) const {}
    __device__ __forceinline__ void done(const Unit&) const {}
};

__device__ __forceinline__ unsigned cvt_pk_bf16(float lo, float hi) { unsigned r; asm volatile("v_cvt_pk_bf16_f32 %0, %1, %2" : "=v"(r) : "v"(lo), "v"(hi)); return r; }
typedef float f32x2 __attribute__((ext_vector_type(2)));
__device__ __forceinline__ f32x2 gelu_pk(f32x2 v) {
    const f32x2 av = __builtin_elementwise_abs(v), d = av * 0.2316418882f + 1.0f;
    f32x2 t; t.x = __builtin_amdgcn_rcpf(d.x); t.y = __builtin_amdgcn_rcpf(d.y);
    f32x2 q = t * 0.5307027145f + (-0.7265760135f); q = q * t + 0.7107068705f; q = q * t + (-0.142248368f); q = q * t + 0.127414796f; q = q * t;
    const f32x2 s = (v * v) * (-0.72134752044f);
    f32x2 e; e.x = __builtin_amdgcn_exp2f(s.x); e.y = __builtin_amdgcn_exp2f(s.y);
    const f32x2 m = v * (q * e), r = v - m;
    f32x2 o; o.x = v.x < 0.f ? m.x : r.x; o.y = v.y < 0.f ? m.y : r.y; return o;
}

template <int ACT  > struct EpiBf16 {
    static constexpr bool PERM = true, AFTER_DRAIN = false; static_assert(ACT == 0 || ACT == 1, "EpiBf16: ACT is 0 (none) or 1 (gelu_pk)");
    bf16_t* O; int ldc; const float* bias; int split_cols; size_t split_stride; float scale0;
    __device__ __forceinline__ void operator()(const f32x4 (&acc)[2][2][4][2], const Unit& u, int wr, int wc, int fr, int fq) const {
        const int row0 = u.pm * BM + wr * 64 + fr; int colt = u.pn * BM; bf16_t* base = O;
        float sc = 1.f; if (split_cols) { const int t = colt / split_cols; base += (size_t)t * split_stride; colt -= t * split_cols; if (t == 0) sc = scale0; }
        const int col0 = colt + wc * 32 + 8 * fq, bcol0 = u.pn * BM + wc * 32 + 8 * fq;
        f32x4 bv[2][2];
#pragma unroll
        for (int bj = 0; bj < 2; ++bj)
#pragma unroll
            for (int n = 0; n < 2; ++n) bv[bj][n] = bias ? *(const f32x4*)(bias + bcol0 + bj * HALF + 4 * n) : (f32x4){0.f, 0.f, 0.f, 0.f};
#pragma unroll
        for (int ai = 0; ai < 2; ++ai)
#pragma unroll
            for (int m = 0; m < 4; ++m) { bf16_t* rowp = base + (size_t)(row0 + ai * HALF + m * 16) * ldc + col0;
#pragma unroll
                for (int bj = 0; bj < 2; ++bj) { f32x4 v0 = acc[ai][bj][m][0] + bv[bj][0], v1 = acc[ai][bj][m][1] + bv[bj][1];
                    if (ACT == 1) { f32x2 a = gelu_pk((f32x2){v0[0], v0[1]}), b = gelu_pk((f32x2){v0[2], v0[3]}), c = gelu_pk((f32x2){v1[0], v1[1]}), d = gelu_pk((f32x2){v1[2], v1[3]});
                        v0 = (f32x4){a.x, a.y, b.x, b.y}; v1 = (f32x4){c.x, c.y, d.x, d.y}; }
                    v0 = v0 * sc; v1 = v1 * sc; u32x4 w; w.x = cvt_pk_bf16(v0[0], v0[1]); w.y = cvt_pk_bf16(v0[2], v0[3]); w.z = cvt_pk_bf16(v1[0], v1[1]); w.w = cvt_pk_bf16(v1[2], v1[3]);
                    *(u32x4*)(rowp + bj * HALF) = w; } }
    }
};
template <class Epi, class Sched, bool ALIGN_EPI = false, bool SP2 = false>
__device__ __forceinline__ void gemm_phase(PG8_LAS unsigned char* lds, const Gemm g, const Sched& S, const Epi& E) {
    int tid_ = threadIdx.x; asm volatile("" : "+v"(tid_)); const int tid = tid_, wid = __builtin_amdgcn_readfirstlane(tid >> 6), lane = tid & 63, wr = wid >> 2, wc = wid & 3, fr = lane & 15, fq = lane >> 4;
    const int K = g.K, nt = K / BK;
    unsigned voffA[2], voffB[2];
#pragma unroll
    for (int i = 0; i < 2; ++i) { int R, C; stage_rc(tid * 16 + i * 8192, R, C); const int Rb = Epi::PERM ? ((R & ~31) + perm32(R & 31)) : R;
        voffA[i] = (unsigned)(R * g.lda + C) * 2u; voffB[i] = (unsigned)(Rb * g.ldb + C) * 2u; }
    const size_t kstep = (size_t)(BK * 2);
    const size_t hstepA = (size_t)HALF * g.lda * 2, hstepB = (size_t)HALF * g.ldb * 2;
    const size_t tstepA = 2 * hstepA, tstepB = 2 * hstepB;
    const unsigned ldsw = (unsigned)wid * 1024u;
    const int aoff = lds_byte(wr * 64 + fr, fq * 8), boff = lds_byte(wc * 32 + fr, fq * 8);
#define PG8_SA(b, h) (((b) * 2 + (h)) * HTB)
#define PG8_SB(b, h) ((4 + (b) * 2 + (h)) * HTB)
#define PG8_STAGE(bufoff, gbase, voff) do { _Pragma("unroll") for (int _i = 0; _i < 2; ++_i) \
        __builtin_amdgcn_global_load_lds((const unsigned*)((const char*)(gbase) + (voff)[_i]), (PG8_LAS unsigned*)(lds + (bufoff) + ldsw + _i * 8192), 16, 0, 0); } while (0)
#define PG8_LDA(dst, b, h) do { _Pragma("unroll") for (int m = 0; m < 4; ++m) _Pragma("unroll") for (int k = 0; k < 2; ++k) dst[m][k] = *(const PG8_LAS bf16x8*)(lds + PG8_SA(b, h) + aoff + m * 2048 + k * 1024); } while (0)
#define PG8_LDB(dst, b, h) do { _Pragma("unroll") for (int n = 0; n < 2; ++n) _Pragma("unroll") for (int k = 0; k < 2; ++k) dst[n][k] = *(const PG8_LAS bf16x8*)(lds + PG8_SB(b, h) + boff + n * 2048 + k * 1024); } while (0)
#define PG8_MMA(ai, bj, At, Bt) do { __builtin_amdgcn_s_setprio(1); _Pragma("unroll") for (int m = 0; m < 4; ++m) _Pragma("unroll") for (int n = 0; n < 2; ++n) _Pragma("unroll") for (int k = 0; k < 2; ++k) \
        acc[ai][bj][m][n] = __builtin_amdgcn_mfma_f32_16x16x32_bf16(Bt[n][k], At[m][k], acc[ai][bj][m][n], 0, 0, 0); __builtin_amdgcn_s_setprio(0); } while (0)
#define PG8_WAIT_V(n) asm volatile("s_waitcnt vmcnt(" #n ")" ::: "memory")
#define PG8_WAIT_L(n) asm volatile("s_waitcnt lgkmcnt(" #n ")" ::: "memory")
#define PG8_BAR __builtin_amdgcn_s_barrier()
#define PG8_SCHED __builtin_amdgcn_sched_barrier(0)
    Unit cur, nxt; int ui = 0;
    if (!S.next(0, cur)) return;
    f32x4 acc[2][2][4][2];
#pragma unroll
    for (int a = 0; a < 2; ++a)
#pragma unroll
        for (int b = 0; b < 2; ++b)
#pragma unroll
            for (int m = 0; m < 4; ++m)
#pragma unroll
                for (int n = 0; n < 2; ++n) acc[a][b][m][n] = (f32x4){0.f, 0.f, 0.f, 0.f};
    bf16x8 At[4][2], B0[2][2], B1[2][2];
    const char* cA = (const char*)g.A + (size_t)cur.pm * tstepA; const char* cB = (const char*)g.Bt + (size_t)cur.pn * tstepB;
    S.a_ready(cur);
    if constexpr (SP2) {
        PG8_STAGE(PG8_SB(0, 0), cB, voffB); PG8_STAGE(PG8_SB(0, 1), cB + hstepB, voffB); PG8_STAGE(PG8_SA(0, 0), cA, voffA); PG8_STAGE(PG8_SA(0, 1), cA + hstepA, voffA);
        if (wr == 1) PG8_BAR;
        PG8_WAIT_V(2); PG8_BAR;
        PG8_STAGE(PG8_SB(1, 0), cB + kstep, voffB); PG8_STAGE(PG8_SA(1, 0), cA + kstep, voffA); PG8_STAGE(PG8_SB(1, 1), cB + hstepB + kstep, voffB);
        PG8_WAIT_V(6); PG8_BAR;
    } else {
        PG8_STAGE(PG8_SB(0, 0), cB, voffB); PG8_STAGE(PG8_SA(0, 0), cA, voffA); PG8_STAGE(PG8_SB(0, 1), cB + hstepB, voffB); PG8_STAGE(PG8_SA(0, 1), cA + hstepA, voffA);
        if (wr == 1) PG8_BAR;
        PG8_WAIT_V(4); PG8_BAR;
        PG8_STAGE(PG8_SB(1, 0), cB + kstep, voffB); PG8_STAGE(PG8_SA(1, 0), cA + kstep, voffA); PG8_STAGE(PG8_SB(1, 1), cB + hstepB + kstep, voffB);
        PG8_WAIT_V(6); PG8_BAR;
    }
    for (;;) {
        const bool has_next = S.next(ui + 1, nxt);
        E.pre(lds + STAGE_BYTES, cur, wr, fr, wid);
        const char* nA = has_next ? (const char*)g.A + (size_t)nxt.pm * tstepA : cA; const char* nB = has_next ? (const char*)g.Bt + (size_t)nxt.pn * tstepB : cB;
        for (int t = 0; t < nt; t += 2) {
            const bool last = (t == nt - 2);
            const char* a1 = cA + (size_t)(t + 1) * kstep;
            const char* a2 = last ? nA : cA + (size_t)(t + 2) * kstep; const char* b2 = last ? nB : cB + (size_t)(t + 2) * kstep;
            const char* a3 = a2 + kstep; const char* b3 = b2 + kstep;
            if (last && has_next) S.a_ready(nxt);
            if constexpr (SP2) {
            PG8_LDB(B0, 0, 0); PG8_LDB(B1, 0, 1); PG8_SCHED; PG8_LDA(At, 0, 0); PG8_STAGE(PG8_SA(1, 1), a1 + hstepA, voffA);
            PG8_WAIT_V(8); PG8_WAIT_L(0); PG8_BAR; PG8_MMA(0, 0, At, B0); PG8_MMA(0, 1, At, B1); PG8_BAR; PG8_SCHED;
            PG8_LDA(At, 0, 1); PG8_STAGE(PG8_SB(0, 0), b2, voffB); PG8_STAGE(PG8_SB(0, 1), b2 + hstepB, voffB); PG8_STAGE(PG8_SA(0, 0), a2, voffA);
            PG8_WAIT_V(8); PG8_WAIT_L(0); PG8_BAR; PG8_MMA(1, 0, At, B0); PG8_MMA(1, 1, At, B1); PG8_BAR; PG8_SCHED;
            PG8_LDB(B0, 1, 0); PG8_LDB(B1, 1, 1); PG8_SCHED; PG8_LDA(At, 1, 0); PG8_STAGE(PG8_SA(0, 1), a2 + hstepA, voffA);
            PG8_WAIT_V(8); PG8_WAIT_L(0); PG8_BAR; PG8_MMA(0, 0, At, B0); PG8_MMA(0, 1, At, B1); PG8_BAR; PG8_SCHED;
            PG8_LDA(At, 1, 1); PG8_STAGE(PG8_SB(1, 0), b3, voffB); PG8_STAGE(PG8_SB(1, 1), b3 + hstepB, voffB); PG8_STAGE(PG8_SA(1, 0), a3, voffA);
            PG8_WAIT_V(8); PG8_WAIT_L(0); PG8_BAR; PG8_MMA(1, 0, At, B0); PG8_MMA(1, 1, At, B1); PG8_BAR; PG8_SCHED;
            } else {
            PG8_LDB(B0, 0, 0); PG8_SCHED; PG8_LDA(At, 0, 0); PG8_STAGE(PG8_SA(1, 1), a1 + hstepA, voffA);
            PG8_WAIT_L(8); PG8_BAR; PG8_WAIT_L(0); PG8_MMA(0, 0, At, B0); PG8_BAR; PG8_SCHED;
            PG8_LDB(B1, 0, 1); PG8_STAGE(PG8_SB(0, 0), b2, voffB);
            PG8_BAR; PG8_WAIT_L(0); PG8_MMA(0, 1, At, B1); PG8_BAR;
            PG8_LDA(At, 0, 1); PG8_STAGE(PG8_SA(0, 0), a2, voffA);
            PG8_BAR; PG8_WAIT_L(0); PG8_MMA(1, 0, At, B0); PG8_BAR; PG8_SCHED;
            PG8_STAGE(PG8_SB(0, 1), b2 + hstepB, voffB);
            PG8_WAIT_V(6); PG8_BAR; PG8_MMA(1, 1, At, B1); PG8_BAR;
            PG8_LDB(B0, 1, 0); PG8_SCHED; PG8_LDA(At, 1, 0); PG8_STAGE(PG8_SA(0, 1), a2 + hstepA, voffA);
            PG8_WAIT_L(8); PG8_BAR; PG8_WAIT_L(0); PG8_MMA(0, 0, At, B0); PG8_BAR; PG8_SCHED;
            PG8_LDB(B1, 1, 1); PG8_STAGE(PG8_SB(1, 0), b3, voffB);
            PG8_BAR; PG8_WAIT_L(0); PG8_MMA(0, 1, At, B1); PG8_BAR;
            PG8_LDA(At, 1, 1); PG8_STAGE(PG8_SA(1, 0), a3, voffA);
            PG8_BAR; PG8_WAIT_L(0); PG8_MMA(1, 0, At, B0); PG8_BAR; PG8_SCHED;
            PG8_STAGE(PG8_SB(1, 1), b3 + hstepB, voffB);
            PG8_WAIT_V(6); PG8_BAR; PG8_MMA(1, 1, At, B1); PG8_BAR;
            }
        }
        if constexpr (ALIGN_EPI) { if (wr == 0) PG8_BAR; }
        if constexpr (!Epi::AFTER_DRAIN) { E(acc, cur, wr, wc, fr, fq, lds + STAGE_BYTES, wid, lane); S.done(cur); }
        if (!has_next) break;
#pragma unroll
        for (int a = 0; a < 2; ++a)
#pragma unroll
            for (int b = 0; b < 2; ++b)
#pragma unroll
                for (int m = 0; m < 4; ++m)
#pragma unroll
                    for (int n = 0; n < 2; ++n) acc[a][b][m][n] = (f32x4){0.f, 0.f, 0.f, 0.f};
        cur = nxt; cA = nA; cB = nB; ++ui;
        if constexpr (ALIGN_EPI) { if (wr == 1) PG8_BAR; }
    }
    PG8_WAIT_V(0);
    if constexpr (!ALIGN_EPI) { if (wr == 0) PG8_BAR; }
    PG8_BAR;
    if constexpr (Epi::AFTER_DRAIN) { E.fused(acc, cur, wr, wc, fr, fq, lds, wid, lane); S.done(cur); }
#undef PG8_SA
#undef PG8_SB
#undef PG8_STAGE
#undef PG8_LDA
#undef PG8_LDB
#undef PG8_MMA
#undef PG8_WAIT_V
#undef PG8_WAIT_L
#undef PG8_BAR
#undef PG8_SCHED
}
}
namespace pg8 {
constexpr float NORM_EPS_ = 1e-6f;
__device__ __forceinline__ void stat_dma(PG8_LAS unsigned char* spare, const unsigned* ss, const Unit& u, int wr, int fr, int wid) {
#pragma unroll
    for (int k = 0; k < 8; ++k)
        __builtin_amdgcn_global_load_lds(ss + (u.pm * BM + wr * 64 + fr + (k >> 2) * HALF + (k & 3) * 16), (PG8_LAS unsigned*)(spare + wid * 2048 + k * 256), 4, 0, 0);
}
__device__ __forceinline__ float stat_rstd(PG8_LAS unsigned char* spare, int wid, int lane, int k) {
    const unsigned v = *(const PG8_LAS unsigned*)(spare + wid * 2048 + k * 256 + lane * 4);
    return 1.0f / sqrtf((float)v * (1.f / (1024.f * 2048.f)) + NORM_EPS_);
}
template <int ACT  > struct EpiB {
    static constexpr bool PERM = true, AFTER_DRAIN = false;
    bf16_t* O; int ldc; const unsigned* ss;
    __device__ __forceinline__ void pre(PG8_LAS unsigned char* spare, const Unit& u, int wr, int fr, int wid) const { if (ss) stat_dma(spare, ss, u, wr, fr, wid); }
    __device__ __forceinline__ void operator()(const f32x4 (&acc)[2][2][4][2], const Unit& u, int wr, int wc, int fr, int fq, PG8_LAS unsigned char* spare, int wid, int lane) const {
        const int row0 = u.pm * BM + wr * 64 + fr, col0 = u.pn * BM + wc * 32 + 8 * fq;
#pragma unroll
        for (int ai = 0; ai < 2; ++ai)
#pragma unroll
            for (int m = 0; m < 4; ++m) { const int row = row0 + ai * HALF + m * 16; bf16_t* rowp = O + (size_t)row * ldc + col0;
                const float rs = ss ? stat_rstd(spare, wid, lane, ai * 4 + m) : 1.f;
#pragma unroll
                for (int bj = 0; bj < 2; ++bj) { f32x4 v0 = acc[ai][bj][m][0] * rs, v1 = acc[ai][bj][m][1] * rs;
                    if (ACT == 2) {
#pragma unroll
                        for (int e = 0; e < 4; ++e) { float a = v0[e] > 0.f ? v0[e] : 0.f; v0[e] = a * a; float b = v1[e] > 0.f ? v1[e] : 0.f; v1[e] = b * b; } }
                    u32x4 w; w.x = cvt_pk_bf16(v0[0], v0[1]); w.y = cvt_pk_bf16(v0[2], v0[3]); w.z = cvt_pk_bf16(v1[0], v1[1]); w.w = cvt_pk_bf16(v1[2], v1[3]);
                    *(u32x4*)(rowp + bj * HALF) = w; } }
    }
};
template <int MODE> struct EpiH {
    static constexpr bool PERM = true, AFTER_DRAIN = false;
    const float* base_f; const bf16_t* hb_in; float* out; const float* cscale; int col_off; const bf16_t* pp; const unsigned* ss_in; bf16_t* hb; unsigned* ss_out;
    __device__ __forceinline__ void pre(PG8_LAS unsigned char* spare, const Unit& u, int wr, int fr, int wid) const { if (ss_in) stat_dma(spare, ss_in, u, wr, fr, wid); }
    __device__ __forceinline__ void operator()(const f32x4 (&acc)[2][2][4][2], const Unit& u, int wr, int wc, int fr, int fq, PG8_LAS unsigned char* spare, int wid, int lane) const {
        const int row0 = u.pm * BM + wr * 64 + fr, col0 = col_off + u.pn * BM + wc * 32 + 8 * fq;
        unsigned sqv[8];
#pragma unroll
        for (int ai = 0; ai < 2; ++ai)
#pragma unroll
            for (int mp = 0; mp < 2; ++mp) {
                f32x4 bv[2][2][2]; u32x4 pw[2][2]; float rs[2] = {1.f, 1.f};
#pragma unroll
                for (int mm = 0; mm < 2; ++mm) { const int row = row0 + ai * HALF + (2 * mp + mm) * 16; const size_t ro = (size_t)row * 2048;
                    if (ss_in) { const float r_ = stat_rstd(spare, wid, lane, ai * 4 + 2 * mp + mm); rs[mm] = (MODE == 0) ? r_ * r_ : r_; }
#pragma unroll
                    for (int bj = 0; bj < 2; ++bj) { const int c = col0 + bj * HALF;
                        if (base_f) { bv[mm][bj][0] = *(const f32x4*)(base_f + ro + c); bv[mm][bj][1] = *(const f32x4*)(base_f + ro + c + 4); }
                        else { const u32x4 w = *(const u32x4*)(hb_in + ro + c);
                            bv[mm][bj][0] = (f32x4){__uint_as_float(w.x << 16), __uint_as_float(w.x & 0xffff0000u), __uint_as_float(w.y << 16), __uint_as_float(w.y & 0xffff0000u)};
                            bv[mm][bj][1] = (f32x4){__uint_as_float(w.z << 16), __uint_as_float(w.z & 0xffff0000u), __uint_as_float(w.w << 16), __uint_as_float(w.w & 0xffff0000u)}; }
                        pw[mm][bj] = (MODE == 1) ? *(const u32x4*)(pp + ro + c) : (u32x4){0u, 0u, 0u, 0u}; } }
#pragma unroll
                for (int mm = 0; mm < 2; ++mm) { const int m = 2 * mp + mm; const int row = row0 + ai * HALF + m * 16; const size_t ro = (size_t)row * 2048;
                    float sq = 0.f;
#pragma unroll
                    for (int bj = 0; bj < 2; ++bj) { const int c = col0 + bj * HALF; f32x4 v0 = acc[ai][bj][m][0], v1 = acc[ai][bj][m][1];
                        if (MODE == 0) { if (cscale) { v0 = v0 * *(const f32x4*)(cscale + c); v1 = v1 * *(const f32x4*)(cscale + c + 4); } v0 = v0 * rs[mm]; v1 = v1 * rs[mm]; }
                        else { const u32x4 w = pw[mm][bj];
                            const f32x4 p0 = {__uint_as_float(w.x << 16), __uint_as_float(w.x & 0xffff0000u), __uint_as_float(w.y << 16), __uint_as_float(w.y & 0xffff0000u)};
                            const f32x4 p1 = {__uint_as_float(w.z << 16), __uint_as_float(w.z & 0xffff0000u), __uint_as_float(w.w << 16), __uint_as_float(w.w & 0xffff0000u)};
#pragma unroll
                            for (int e = 0; e < 4; ++e) { v0[e] = p0[e] / (1.f + __expf(-v0[e] * rs[mm])); v1[e] = p1[e] / (1.f + __expf(-v1[e] * rs[mm])); } }
                        const f32x4 h0 = bv[mm][bj][0] + v0, h1 = bv[mm][bj][1] + v1;
                        if (out) { *(f32x4*)(out + ro + c) = h0; *(f32x4*)(out + ro + c + 4) = h1; }
                        if (hb) { u32x4 w2; w2.x = cvt_pk_bf16(h0[0], h0[1]); w2.y = cvt_pk_bf16(h0[2], h0[3]); w2.z = cvt_pk_bf16(h1[0], h1[1]); w2.w = cvt_pk_bf16(h1[2], h1[3]); *(u32x4*)(hb + ro + c) = w2;
                            const float r0 = __uint_as_float(w2.x << 16), r1 = __uint_as_float(w2.x & 0xffff0000u), r2 = __uint_as_float(w2.y << 16), r3 = __uint_as_float(w2.y & 0xffff0000u);
                            const float r4 = __uint_as_float(w2.z << 16), r5 = __uint_as_float(w2.z & 0xffff0000u), r6 = __uint_as_float(w2.w << 16), r7 = __uint_as_float(w2.w & 0xffff0000u);
                            sq += ((r0 * r0 + r1 * r1) + (r2 * r2 + r3 * r3)) + ((r4 * r4 + r5 * r5) + (r6 * r6 + r7 * r7)); } }
                    sq += __shfl_xor(sq, 16); sq += __shfl_xor(sq, 32); sqv[ai * 4 + m] = __float2uint_rn(sq * 1024.f);
                }
            }
        if (ss_out) {
#pragma unroll
            for (int j = 0; j < 2; ++j) { const unsigned v = fq == 0 ? sqv[4 * j] : (fq == 1 ? sqv[4 * j + 1] : (fq == 2 ? sqv[4 * j + 2] : sqv[4 * j + 3]));
                atomicAdd(ss_out + row0 + j * HALF + fq * 16, v); }
        }
    }
};
}
using pg8::bf16_t; using pg8::bf16x8; using pg8::f32x4; using pg8::u32x4;
typedef float f32x16 __attribute__((ext_vector_type(16)));
typedef short s16x4 __attribute__((ext_vector_type(4)));
typedef unsigned u32x2 __attribute__((ext_vector_type(2)));
#define LAS __attribute__((address_space(3)))
constexpr int NB = 2, S = 4096, T = NB * S, D = 2048, FF = 8192, NH = 16, HD = 128;
constexpr int NQ_LD = 5376, MQ_LD = 6144;
constexpr float EPS = 1e-6f;
constexpr size_t MiB = 1u << 20;
constexpr size_t WS_W1T = 0, WS_W2T = 128 * MiB, WS_PGT = 256 * MiB, WS_PPT = 288 * MiB, WS_MQKV = 292 * MiB, WS_MWO = 316 * MiB, WS_POOL = 324 * MiB,
                 WS_NQKV = 326 * MiB, WS_NWO = 347 * MiB, WS_CW1 = 355 * MiB, WS_CIN = 357 * MiB, WS_CWO = 381 * MiB, WS_PB = 389 * MiB, WS_XN = 405 * MiB,
                 WS_OB = 437 * MiB, WS_PP = 469 * MiB, WS_BIG = 501 * MiB, WS_KMEAN = 629 * MiB, WS_KC = 630 * MiB, WS_VC = 631 * MiB, WS_CTL = 632 * MiB, WS_SS = 632 * MiB + 65536, WS_HB1 = 633 * MiB, WS_SSP = 665 * MiB, WS_END = 678 * MiB;
constexpr int LDS_BYTES = 155648;
constexpr int NWAVES = 8, NTHREADS = 512;

struct Params { const void* in[29]; float* out; unsigned char* ws; };

__device__ __forceinline__ float bflo(unsigned w) { return __uint_as_float(w << 16); }
__device__ __forceinline__ float bfhi(unsigned w) { return __uint_as_float(w & 0xffff0000u); }
__device__ __forceinline__ float bf1(bf16_t b) { return __uint_as_float((unsigned)b << 16); }
__device__ __forceinline__ unsigned pk2(float lo, float hi) { return pg8::cvt_pk_bf16(lo, hi); }
__device__ __forceinline__ bf16_t f2bf1(float f) { return (bf16_t)(pk2(f, 0.f) & 0xffffu); }
__device__ __forceinline__ float wave_sum(float v) {
#pragma unroll
    for (int o = 1; o < 64; o <<= 1) v += __shfl_xor(v, o);
    return v;
}
__device__ __forceinline__ bf16x8 pack8(f32x4 a, f32x4 b) { u32x4 w = {pk2(a[0], a[1]), pk2(a[2], a[3]), pk2(b[0], b[1]), pk2(b[2], b[3])}; return __builtin_bit_cast(bf16x8, w); }
__device__ __forceinline__ float sigmoidf_(float x) { return 1.f / (1.f + __expf(-x)); }

struct CJob { const float* W; bf16_t* WT; const float* gain; int K, N, row_off, item; };
__device__ __forceinline__ void tr_load(const CJob& J, int lane, float (&tv)[32]) {
    const int nblk = J.N / 32, kb = J.item / nblk, nb = J.item % nblk, k0 = 64 * kb, n0 = 32 * nb;
#pragma unroll
    for (int i = 0; i < 32; ++i) { const int kk = 2 * i + (lane >> 5); tv[i] = __builtin_nontemporal_load(J.W + (size_t)(k0 + kk) * J.N + n0 + (lane & 31)); }
}
__device__ __forceinline__ void tr_store(const CJob& J, int lane, const float (&tv)[32], float* scr) {
    const int nblk = J.N / 32, kb = J.item / nblk, nb = J.item % nblk, k0 = 64 * kb, n0 = 32 * nb;
#pragma unroll
    for (int i = 0; i < 32; ++i) { const int kk = 2 * i + (lane >> 5); scr[kk * 33 + (lane & 31)] = J.gain ? tv[i] * J.gain[k0 + kk] : tv[i]; }
    asm volatile("s_waitcnt lgkmcnt(0)" ::: "memory");
    const int c = lane & 7;
#pragma unroll
    for (int j = 0; j < 4; ++j) { const int n = (lane >> 3) + 8 * j; const float* s = scr + (8 * c) * 33 + n;
        u32x4 o; o.x = pk2(s[0 * 33], s[1 * 33]); o.y = pk2(s[2 * 33], s[3 * 33]); o.z = pk2(s[4 * 33], s[5 * 33]); o.w = pk2(s[6 * 33], s[7 * 33]);
        *(u32x4*)(J.WT + (size_t)(J.row_off + n0 + n) * J.K + k0 + 8 * c) = o; }
    asm volatile("s_waitcnt lgkmcnt(0)" ::: "memory");
}
#define CJOB(src, Kk, Nn, dst, roff, gn) if (!found) { const int ni_ = ((Kk) / 64) * ((Nn) / 32); if (r < ni_) { J.W = (const float*)(src); J.WT = (bf16_t*)(dst); J.gain = (const float*)(gn); J.K = (Kk); J.N = (Nn); J.row_off = (roff); J.item = r; found = true; } else r -= ni_; }
#define CJOB_LAYER(i) CJOB((const float*)P.in[5] + (size_t)(i) * D * FF, D, FF, ws + WS_W1T + (size_t)(i) * 32 * MiB, 0, (const float*)P.in[4] + (size_t)(i) * D) \
                      CJOB((const float*)P.in[6] + (size_t)(i) * D * FF, FF, D, ws + WS_W2T + (size_t)(i) * 32 * MiB, 0, nullptr) \
                      CJOB((const float*)P.in[8] + (size_t)(i) * D * D, D, D, ws + WS_PGT + (size_t)(i) * 8 * MiB, 0, (const float*)P.in[7] + (size_t)(i) * D) \
                      CJOB((const float*)P.in[9] + (size_t)(i) * 256 * D, 256, D, ws + WS_PPT + (size_t)(i) * 1 * MiB, 0, nullptr)
constexpr int NITEMS_CONV = 4 * (8192 + 8192 + 2048 + 256) + 6144 + 2048 + 4 * 128 + 2048 + 3072 + 2048 + 2 * 256 + 6144 + 2048;
__device__ __forceinline__ CJob conv_resolve(const Params& P, int it) {
    unsigned char* ws = P.ws; CJob J; J.W = nullptr; J.WT = nullptr; J.gain = nullptr; J.K = 64; J.N = 32; J.row_off = 0; J.item = 0;
    int r = it; bool found = false;
    CJOB_LAYER(0) CJOB_LAYER(1) CJOB_LAYER(2) CJOB_LAYER(3)
    CJOB(P.in[10], D, 3 * D, ws + WS_MQKV, 0, (const float*)P.in[3])
    CJOB(P.in[13], D, D, ws + WS_MWO, 0, nullptr)
    CJOB((const float*)P.in[14] + 0 * 512 * 512, 512, 512, ws + WS_POOL + 0 * 512 * 512 * 2, 0, nullptr)
    CJOB((const float*)P.in[14] + 1 * 512 * 512, 512, 512, ws + WS_POOL + 1 * 512 * 512 * 2, 0, nullptr)
    CJOB((const float*)P.in[14] + 2 * 512 * 512, 512, 512, ws + WS_POOL + 2 * 512 * 512 * 2, 0, nullptr)
    CJOB((const float*)P.in[14] + 3 * 512 * 512, 512, 512, ws + WS_POOL + 3 * 512 * 512 * 2, 0, nullptr)
    CJOB(P.in[16], D, D, ws + WS_NQKV, 0, (const float*)P.in[3] + 2 * D)
    CJOB(P.in[17], D, 3072, ws + WS_NQKV, 2048, (const float*)P.in[3] + 2 * D)
    CJOB(P.in[24], D, D, ws + WS_NWO, 0, nullptr)
    CJOB((const float*)P.in[21] + 0 * 4096 * 128, 4096, 128, ws + WS_CW1 + 0 * 128 * 4096 * 2, 0, nullptr)
    CJOB((const float*)P.in[21] + 1 * 4096 * 128, 4096, 128, ws + WS_CW1 + 1 * 128 * 4096 * 2, 0, nullptr)
    CJOB(P.in[25], D, 3 * D, ws + WS_CIN, 0, (const float*)P.in[3] + 3 * D)
    CJOB(P.in[28], D, D, ws + WS_CWO, 0, nullptr)
    return J;
}
__device__ __forceinline__ void phase_convert(const Params& P, char* lds, int gw, int NGW, int gtid, int NT, int wid, int lane) {
    asm volatile("" : "+v"(lane));
    unsigned char* ws = P.ws;
    float* scr = (float*)(lds + wid * 17408);
    for (int it = 2 * gw; it < NITEMS_CONV; it += 2 * NGW) {
        const CJob J0 = conv_resolve(P, it); const bool two = (it + 1 < NITEMS_CONV); const CJob J1 = conv_resolve(P, two ? it + 1 : it);
        float tv0[32], tv1[32];
        tr_load(J0, lane, tv0); tr_load(J1, lane, tv1);
        tr_store(J0, lane, tv0, scr);
        if (two) tr_store(J1, lane, tv1, scr);
    }
    { const float* Wg = (const float*)P.in[23]; bf16_t* dst = (bf16_t*)(ws + WS_NQKV) + (size_t)5120 * D;
      for (int idx = gtid; idx < 256 * D; idx += NT) { const int n = idx >> 11, k = idx & 2047; dst[idx] = (n < 48) ? f2bf1(Wg[(size_t)k * 48 + n] * ((const float*)P.in[3])[2 * D + k]) : (bf16_t)0; } }
    { const float* x = (const float*)P.in[0]; bf16_t* hb = (bf16_t*)(ws + WS_XN); unsigned* ss0 = (unsigned*)(ws + WS_SS);
      for (int m = gw; m < T; m += NGW) {
          const f32x4* xr = (const f32x4*)(x + (size_t)m * D) + lane; u32x2* o8 = (u32x2*)(hb + (size_t)m * D) + lane; float s = 0.f;
#pragma unroll
          for (int j = 0; j < 8; ++j) { const f32x4 v = xr[64 * j]; s += (v[0] * v[0] + v[1] * v[1]) + (v[2] * v[2] + v[3] * v[3]); u32x2 o; o.x = pk2(v[0], v[1]); o.y = pk2(v[2], v[3]); o8[64 * j] = o; }
          s = wave_sum(s); if (lane == 0) ss0[m] = __float2uint_rn(s * 1024.f); } }
    { const f32x4* ps = (const f32x4*)P.in[1]; u32x2* pd = (u32x2*)(ws + WS_PB);
      for (int idx = gtid; idx < 4 * T * 256 / 4; idx += NT) { const f32x4 v = ps[idx]; u32x2 o; o.x = pk2(v[0], v[1]); o.y = pk2(v[2], v[3]); pd[idx] = o; } }
}

__device__ __forceinline__ void phase_rms(const float* src, const float* gain, bf16_t* dst, int gw, int NGW, int lane) {
    asm volatile("" : "+v"(lane));
    for (int m = gw; m < T; m += NGW) {
        const f32x4* xr = (const f32x4*)(src + (size_t)m * D) + lane;
        f32x4 v[8]; float s = 0.f;
#pragma unroll
        for (int j = 0; j < 8; ++j) { v[j] = xr[64 * j]; s += (v[j][0] * v[j][0] + v[j][1] * v[j][1]) + (v[j][2] * v[j][2] + v[j][3] * v[j][3]); }
        const float rstd = 1.0f / sqrtf(wave_sum(s) * (1.f / D) + EPS);
        u32x2* o8 = (u32x2*)(dst + (size_t)m * D) + lane;
#pragma unroll
        for (int j = 0; j < 8; ++j) { const f32x4 g = ((const f32x4*)gain)[lane + 64 * j]; u32x2 o; o.x = pk2(v[j][0] * rstd * g[0], v[j][1] * rstd * g[1]); o.y = pk2(v[j][2] * rstd * g[2], v[j][3] * rstd * g[3]); o8[64 * j] = o; }
    }
}

template <class Epi>
__device__ __forceinline__ void gemm_run(char* lds, const bf16_t* A, int lda, const bf16_t* Bt, int ldb, int M, int N, int K, int G, int c, const Epi& E) {
    pg8::Gemm g{A, Bt, M, N, K, lda, ldb}; pg8::StaticOrder So; So.init(M, N, G, c);
    pg8::gemm_phase<Epi, pg8::StaticOrder, true, true>((PG8_LAS unsigned char*)lds, g, So, E);
}

__device__ __forceinline__ void rope_cs(int pos, int lane, float (&cs)[2], float (&sn)[2]) {
#pragma unroll
    for (int e = 0; e < 2; ++e) {
        const int i = 2 * (lane & 7) + e;
        const float freq = __builtin_amdgcn_exp2f(-(float)i * (18.931568569324174f / 16.0f));
        const float ang = (float)pos * freq;
        const double rev = (double)ang * 0.15915494309189535;
        const float fr = (float)(rev - floor(rev));
        cs[e] = __builtin_amdgcn_cosf(fr); sn[e] = __builtin_amdgcn_sinf(fr);
    }
}
__device__ __forceinline__ void head_norm_rope(unsigned w, const float* gain, int lane, const float (&cs)[2], const float (&sn)[2], float& n0, float& n1, float& r0, float& r1) {
    const float x0 = bflo(w), x1 = bfhi(w);
    const float ss = wave_sum(x0 * x0 + x1 * x1);
    const float rstd = 1.0f / sqrtf(ss * (1.f / HD) + EPS);
    n0 = x0 * rstd * gain[2 * lane]; n1 = x1 * rstd * gain[2 * lane + 1];
    const float p0 = __shfl_xor(n0, 8), p1 = __shfl_xor(n1, 8);
    r0 = n0; r1 = n1;
    if (lane < 8) { r0 = n0 * cs[0] - p0 * sn[0]; r1 = n1 * cs[1] - p1 * sn[1]; }
    else if (lane < 16) { r0 = n0 * cs[0] + p0 * sn[0]; r1 = n1 * cs[1] + p1 * sn[1]; }
}
__device__ __forceinline__ void phase_moba_prep(const Params& P, char* lds, int bid, int G, int tid, int wid, int lane) {
    asm volatile("" : "+v"(tid)); asm volatile("" : "+v"(lane));
    bf16_t* BIG = (bf16_t*)(P.ws + WS_BIG); float* KMEAN = (float*)(P.ws + WS_KMEAN);
    const int* pos = (const int*)P.in[2]; const float* qg = (const float*)P.in[11]; const float* kg = (const float*)P.in[12];
    float* red = (float*)(lds);
    const int sub = lane & 15, grp = lane >> 4;
    float qg8[8], kg8[8];
#pragma unroll
    for (int j = 0; j < 8; ++j) { qg8[j] = qg[8 * sub + j]; kg8[j] = kg[8 * sub + j]; }
    for (int u = bid; u < NB * 16 * NH; u += G) {
        const int h = u & 15, blk = (u >> 4) & 15, b = u >> 8;
        float ks[8];
#pragma unroll
        for (int j = 0; j < 8; ++j) ks[j] = 0.f;
        u32x4 qv[8], kv[8];
#pragma unroll
        for (int it = 0; it < 8; ++it) { const size_t row = (size_t)(b * S + blk * 256 + wid * 32 + it * 4 + grp);
            qv[it] = *(const u32x4*)(BIG + row * MQ_LD + h * HD + 8 * sub); kv[it] = *(const u32x4*)(BIG + row * MQ_LD + D + h * HD + 8 * sub); }
#pragma unroll
        for (int it = 0; it < 8; ++it) {
            const size_t row = (size_t)(b * S + blk * 256 + wid * 32 + it * 4 + grp);
            const int ps = pos[row];
            float cs[8], sn[8];
#pragma unroll
            for (int j = 0; j < 8; ++j) { const int i_ = 8 * (sub & 1) + j;
                const float freq = __builtin_amdgcn_exp2f(-(float)i_ * (18.931568569324174f / 16.0f));
                const float ang = (float)ps * freq; const double rev = (double)ang * 0.15915494309189535; const float fr_ = (float)(rev - floor(rev));
                cs[j] = __builtin_amdgcn_cosf(fr_); sn[j] = __builtin_amdgcn_sinf(fr_); }
#pragma unroll
            for (int which = 0; which < 2; ++which) {
                const u32x4 w = which ? kv[it] : qv[it];
                float x[8] = {bflo(w.x), bfhi(w.x), bflo(w.y), bfhi(w.y), bflo(w.z), bfhi(w.z), bflo(w.w), bfhi(w.w)};
                float ss = 0.f;
#pragma unroll
                for (int j = 0; j < 8; ++j) ss += x[j] * x[j];
                ss += __shfl_xor(ss, 1); ss += __shfl_xor(ss, 2); ss += __shfl_xor(ss, 4); ss += __shfl_xor(ss, 8);
                const float rstd = 1.0f / sqrtf(ss * (1.f / HD) + EPS);
                float y[8];
#pragma unroll
                for (int j = 0; j < 8; ++j) { y[j] = x[j] * rstd * (which ? kg8[j] : qg8[j]);
                    const float pr = __shfl_xor(y[j], 2);
                    const float rot = (sub < 2) ? (y[j] * cs[j] - pr * sn[j]) : (y[j] * cs[j] + pr * sn[j]);
                    y[j] = (sub < 4) ? rot : y[j]; }
                u32x4 ow = {pk2(y[0], y[1]), pk2(y[2], y[3]), pk2(y[4], y[5]), pk2(y[6], y[7])};
                *(u32x4*)(BIG + row * MQ_LD + (which ? D : 0) + h * HD + 8 * sub) = ow;
                if (which) {
#pragma unroll
                    for (int j = 0; j < 8; ++j) ks[j] += y[j]; }
            }
        }
#pragma unroll
        for (int j = 0; j < 8; ++j) { ks[j] += __shfl_xor(ks[j], 16); ks[j] += __shfl_xor(ks[j], 32); }
        if (grp == 0) {
#pragma unroll
            for (int j = 0; j < 8; ++j) red[wid * 128 + 8 * sub + j] = ks[j]; }
        __syncthreads();
        if (tid < 128) { float sm = 0.f;
#pragma unroll
            for (int w = 0; w < 8; ++w) sm += red[w * 128 + tid];
            KMEAN[(size_t)((b * NH + h) * 16 + blk) * HD + tid] = sm * (1.f / 256.f); }
        __syncthreads();
    }
}

__device__ __forceinline__ void phase_nsa_norm(const Params& P, int gw, int NGW, int lane) {
    asm volatile("" : "+v"(lane));
    bf16_t* BIG = (bf16_t*)(P.ws + WS_BIG);
    const int* pos = (const int*)P.in[2]; const float* qg = (const float*)P.in[18]; const float* kg = (const float*)P.in[19];
    const int sub = lane & 15, grp = lane >> 4;
    for (int row = gw; row < T; row += NGW) {
        bf16_t* base = BIG + (size_t)row * NQ_LD;
        u32x4 v[6];
#pragma unroll
        for (int st = 0; st < 6; ++st) { const int col = (st < 4) ? (st * 4 + grp) * HD : (D + (st == 4 ? 2 : 4) * 512 + grp * HD); v[st] = *(const u32x4*)(base + col + 8 * sub); }
        const int ps = pos[row];
        float cs[8], sn[8];
#pragma unroll
        for (int j = 0; j < 8; ++j) { const int i_ = 8 * (sub & 1) + j;
            const float freq = __builtin_amdgcn_exp2f(-(float)i_ * (18.931568569324174f / 16.0f));
            const float ang = (float)ps * freq; const double rev = (double)ang * 0.15915494309189535; const float fr_ = (float)(rev - floor(rev));
            cs[j] = __builtin_amdgcn_cosf(fr_); sn[j] = __builtin_amdgcn_sinf(fr_); }
#pragma unroll
        for (int st = 0; st < 6; ++st) {
            const int col = (st < 4) ? (st * 4 + grp) * HD : (D + (st == 4 ? 2 : 4) * 512 + grp * HD);
            const float* gn = (st < 4) ? qg : (st == 4 ? kg + 1 * HD : kg + 2 * HD);
            const u32x4 w = v[st];
            float x[8] = {bflo(w.x), bfhi(w.x), bflo(w.y), bfhi(w.y), bflo(w.z), bfhi(w.z), bflo(w.w), bfhi(w.w)};
            float ss = 0.f;
#pragma unroll
            for (int j = 0; j < 8; ++j) ss += x[j] * x[j];
            ss += __shfl_xor(ss, 1); ss += __shfl_xor(ss, 2); ss += __shfl_xor(ss, 4); ss += __shfl_xor(ss, 8);
            const float rstd = 1.0f / sqrtf(ss * (1.f / HD) + EPS);
            const f32x4 g0 = *(const f32x4*)(gn + 8 * sub), g1 = *(const f32x4*)(gn + 8 * sub + 4);
            float y[8];
#pragma unroll
            for (int j = 0; j < 8; ++j) { y[j] = x[j] * rstd * (j < 4 ? g0[j & 3] : g1[j & 3]);
                if (st >= 4) { const float pr = __shfl_xor(y[j], 2);
                    const float rot = (sub < 2) ? (y[j] * cs[j] - pr * sn[j]) : (y[j] * cs[j] + pr * sn[j]);
                    y[j] = (sub < 4) ? rot : y[j]; } }
            u32x4 ow = {pk2(y[0], y[1]), pk2(y[2], y[3]), pk2(y[4], y[5]), pk2(y[6], y[7])};
            *(u32x4*)(base + col + 8 * sub) = ow;
        }
    }
}

__device__ __forceinline__ void phase_nsa_compress(const Params& P, char* lds, int bid, int G, int tid, int wid, int lane) {
    asm volatile("" : "+v"(tid)); asm volatile("" : "+v"(lane));
    const bf16_t* BIG = (const bf16_t*)(P.ws + WS_BIG); const bf16_t* CW1 = (const bf16_t*)(P.ws + WS_CW1);
    const float* cpos = (const float*)P.in[20]; const float* w2 = (const float*)P.in[22]; const float* kg0 = (const float*)P.in[19];
    float* red = (float*)lds;
    float* h1s = (float*)(lds + 65536);
    const int fr = lane & 15, fq = lane >> 4;
    for (int u = bid; u < 256; u += G) {
        const int ng = u & 15, j = (u >> 4) & 1, g = (u >> 5) & 3, b = u >> 7;
        const int n = 16 * ng + fr;
        { const f32x4* w2g = (const f32x4*)(w2 + (size_t)j * 128 * 128); f32x4* w2s4 = (f32x4*)(lds + 73728);
#pragma unroll
          for (int i = 0; i < 8; ++i) w2s4[tid + 512 * i] = w2g[tid + 512 * i]; }
        f32x4 acc[8];
#pragma unroll
        for (int i = 0; i < 8; ++i) acc[i] = (f32x4){0.f, 0.f, 0.f, 0.f};
        for (int l = 4 * wid; l < 4 * wid + 4; ++l) {
            int tokl = 16 * n + l; tokl = tokl > S - 1 ? S - 1 : tokl;
            const bf16_t* rowp = BIG + (size_t)(b * S + tokl) * NQ_LD + D + j * 512 + g * HD;
            const float* pp = cpos + (size_t)(j * 32 + l) * HD;
#pragma unroll
            for (int dd = 0; dd < 4; ++dd) {
                const int d = dd * 32 + 8 * fq;
                const u32x4 raw = *(const u32x4*)(rowp + d);
                const f32x4 pa = *(const f32x4*)(pp + d), pb = *(const f32x4*)(pp + d + 4);
                f32x4 a0 = {bflo(raw.x) + pa[0], bfhi(raw.x) + pa[1], bflo(raw.y) + pa[2], bfhi(raw.y) + pa[3]};
                f32x4 a1 = {bflo(raw.z) + pb[0], bfhi(raw.z) + pb[1], bflo(raw.w) + pb[2], bfhi(raw.w) + pb[3]};
                const bf16x8 Af = pack8(a0, a1);
                const int k0 = l * HD + dd * 32 + 8 * fq;
#pragma unroll
                for (int ns = 0; ns < 8; ++ns) {
                    const bf16x8 Bw = *(const bf16x8*)(CW1 + (size_t)(j * 128 + ns * 16 + fr) * 4096 + k0);
                    acc[ns] = __builtin_amdgcn_mfma_f32_16x16x32_bf16(Bw, Af, acc[ns], 0, 0, 0);
                }
            }
        }
#pragma unroll
        for (int ns = 0; ns < 8; ++ns) *(f32x4*)(red + (size_t)(wid * 16 + fr) * 128 + ns * 16 + 4 * fq) = acc[ns];
        __syncthreads();
        const int m = tid >> 5, c4 = (tid & 31) * 4;
        { f32x4 s = {0.f, 0.f, 0.f, 0.f};
#pragma unroll
          for (int w = 0; w < 8; ++w) s = s + *(const f32x4*)(red + (size_t)(w * 16 + m) * 128 + c4);
#pragma unroll
          for (int e = 0; e < 4; ++e) { const float x = s[e]; const float uu = 0.7978845608028654f * (x + 0.044715f * x * x * x); const float th = 1.f - 2.f / (__expf(2.f * uu) + 1.f); s[e] = 0.5f * x * (1.f + th); }
          *(f32x4*)(h1s + m * 128 + c4) = s; }
        __syncthreads();
        f32x4 o = {0.f, 0.f, 0.f, 0.f};
        const float* w2j = (const float*)(lds + 73728) + c4;
#pragma unroll 16
        for (int k = 0; k < 128; ++k) { const float hv = h1s[m * 128 + k]; const f32x4 wv = *(const f32x4*)(w2j + k * 128); o = o + wv * hv; }
        if (j == 0) {
            float ss = (o[0] * o[0] + o[1] * o[1]) + (o[2] * o[2] + o[3] * o[3]);
#pragma unroll
            for (int sh = 1; sh < 32; sh <<= 1) ss += __shfl_xor(ss, sh);
            const float rstd = 1.0f / sqrtf(ss * (1.f / HD) + EPS);
            const f32x4 gn = *(const f32x4*)(kg0 + c4);
            o = o * rstd * gn;
        }
        const int nn = 16 * ng + m;
        if (nn >= 255) o = (f32x4){0.f, 0.f, 0.f, 0.f};
        bf16_t* dst = (bf16_t*)(P.ws + (j == 0 ? WS_KC : WS_VC)) + (size_t)((b * 4 + g) * 256 + nn) * HD + c4;
        u32x2 ow; ow.x = pk2(o[0], o[1]); ow.y = pk2(o[2], o[3]); *(u32x2*)dst = ow;
        __syncthreads();
    }
}

__device__ __forceinline__ f32x4 ld4bf(const bf16_t* p) { const u32x2 w = *(const u32x2*)p; return (f32x4){bflo(w.x), bfhi(w.x), bflo(w.y), bfhi(w.y)}; }
__device__ __forceinline__ void phase_pool_prep(const bf16_t* hsrc, const unsigned* ssq, const float* gain, bf16_t* OB, char* lds, int bid, int G, int tid, int wid, int lane) {
    asm volatile("" : "+v"(tid)); asm volatile("" : "+v"(lane));
    float* rs = (float*)lds;
    for (int u = bid; u < T / 32; u += G) {
        const int b = u / (S / 32), s0 = (u % (S / 32)) * 32;
        if (tid < 47) { const int s = s0 - 15 + tid; rs[tid] = (s >= 0) ? 1.0f / sqrtf((float)ssq[b * S + s] * (1.f / (1024.f * 2048.f)) + EPS) : 0.f; }
        __syncthreads();
        const int col = (tid & 255) * 8, w = 2 << (col >> 9), r_lo = (tid >> 8) * 16;
        const f32x4 gn0 = *(const f32x4*)(gain + col), gn1 = *(const f32x4*)(gain + col + 4);
        for (int rr = r_lo; rr < r_lo + 16; ++rr) {
            const int s = s0 + rr; const int lo = (s + 1 - w) > 0 ? (s + 1 - w) : 0; const float inv = 1.0f / (float)(s + 1 - lo);
            f32x4 a0 = {0.f, 0.f, 0.f, 0.f}, a1 = {0.f, 0.f, 0.f, 0.f};
            for (int sp = lo; sp <= s; ++sp) { const u32x4 wv = *(const u32x4*)(hsrc + (size_t)(b * S + sp) * D + col); const float r_ = rs[sp - s0 + 15];
                a0 = a0 + (f32x4){bflo(wv.x), bfhi(wv.x), bflo(wv.y), bfhi(wv.y)} * r_; a1 = a1 + (f32x4){bflo(wv.z), bfhi(wv.z), bflo(wv.w), bfhi(wv.w)} * r_; }
            const u32x4 wx = *(const u32x4*)(hsrc + (size_t)(b * S + s) * D + col); const float rx = rs[rr + 15];
            const f32x4 d0 = (a0 * inv - (f32x4){bflo(wx.x), bfhi(wx.x), bflo(wx.y), bfhi(wx.y)} * rx) * gn0;
            const f32x4 d1 = (a1 * inv - (f32x4){bflo(wx.z), bfhi(wx.z), bflo(wx.w), bfhi(wx.w)} * rx) * gn1;
            u32x4 ow = {pk2(d0[0], d0[1]), pk2(d0[2], d0[3]), pk2(d1[0], d1[1]), pk2(d1[2], d1[3])};
            *(u32x4*)(OB + (size_t)(b * S + s) * D + col) = ow;
        }
        __syncthreads();
    }
}

__device__ __forceinline__ void phase_conv_elem(const Params& P, int gtid, int NT) {
    asm volatile("" : "+v"(gtid));
    const bf16_t* BIG = (const bf16_t*)(P.ws + WS_BIG); bf16_t* OB = (bf16_t*)(P.ws + WS_OB);
    const float* cw = (const float*)P.in[26]; const float* cb = (const float*)P.in[27];
    for (int it = gtid; it < T * 256; it += NT) {
        const int row = it >> 8, c8 = (it & 255) * 8, s = row & (S - 1);
        const bf16_t* base = BIG + (size_t)row * MQ_LD + c8;
        float u[3][8];
#pragma unroll
        for (int j = 0; j < 3; ++j) {
            const int back = 2 - j;
            if (s >= back) { const u32x4 cw4 = *(const u32x4*)(base - (size_t)back * MQ_LD + D), hw4 = *(const u32x4*)(base - (size_t)back * MQ_LD + 2 * D);
                u[j][0] = bflo(cw4.x) * bflo(hw4.x); u[j][1] = bfhi(cw4.x) * bfhi(hw4.x); u[j][2] = bflo(cw4.y) * bflo(hw4.y); u[j][3] = bfhi(cw4.y) * bfhi(hw4.y);
                u[j][4] = bflo(cw4.z) * bflo(hw4.z); u[j][5] = bfhi(cw4.z) * bfhi(hw4.z); u[j][6] = bflo(cw4.w) * bflo(hw4.w); u[j][7] = bfhi(cw4.w) * bfhi(hw4.w); }
            else {
#pragma unroll
                for (int e = 0; e < 8; ++e) u[j][e] = 0.f; }
        }
        const u32x4 bw4 = *(const u32x4*)base;
        float bv[8] = {bflo(bw4.x), bfhi(bw4.x), bflo(bw4.y), bfhi(bw4.y), bflo(bw4.z), bfhi(bw4.z), bflo(bw4.w), bfhi(bw4.w)};
        float y[8];
#pragma unroll
        for (int e = 0; e < 8; ++e) { const int c = c8 + e; y[e] = bv[e] * (cw[c] * u[0][e] + cw[D + c] * u[1][e] + cw[2 * D + c] * u[2][e] + cb[c]); }
        u32x4 ow = {pk2(y[0], y[1]), pk2(y[2], y[3]), pk2(y[4], y[5]), pk2(y[6], y[7])};
        *(u32x4*)(OB + (size_t)row * D + c8) = ow;
    }
}
namespace at {
constexpr float SCALE = 0.08838834764831845f;
constexpr float C2 = 1.4426950408889634f * SCALE;
constexpr int OFF_V = 0, OFF_K = 16384, KVBUF = 32768  , OFF_WS = 65536, OFF_IMP = 67584, OFF_SELM = 83968, OFF_Q = 86016;
#define KSWZ(row, colB) ((row) * 256 + ((colB) ^ (((row) & 7) << 4)))
#define SBAR() __builtin_amdgcn_sched_barrier(0)
__device__ __forceinline__ int v_st(int k, int c) { const int kk = (k & ~0xC) | ((k & 4) << 1) | ((k & 8) >> 1); return ((kk >> 3) * 4 + (c >> 5)) * 512 + ((kk & 7) * 32 + (c & 31)) * 2; }
__device__ __forceinline__ int v_rd_base(int lane) { return ((lane & 3) << 3) | (((lane >> 2) & 3) << 6) | (((lane >> 4) & 1) << 5) | (((lane >> 5) & 1) << 8); }
constexpr int v_rd_off(int d0, int ks, int half) { return d0 * 512 + ks * 4096 + half * 2048; }
__device__ __forceinline__ int crow(int r, int hi) { return (r & 3) + 8 * (r >> 2) + 4 * hi; }
__device__ __forceinline__ unsigned cvtpk(float lo, float hi) { unsigned r; asm volatile("v_cvt_pk_bf16_f32 %0, %1, %2" : "=v"(r) : "v"(lo), "v"(hi)); return r; }

__device__ __forceinline__ void mask_tile(f32x16& p0, f32x16& p1, int dq, unsigned W, bool rowok) {
    const float NEG = -__builtin_inff();
#pragma unroll
    for (int r = 0; r < 16; ++r) {
        const int c = (r & 3) + 8 * (r >> 2);
        if (!rowok || (unsigned)(dq - c) >= W) p0[r] = NEG;
        if (!rowok || (unsigned)(dq - c - 32) >= W) p1[r] = NEG;
    }
}
__device__ __forceinline__ float rowmax32(const f32x16& p0, const f32x16& p1) {
    float pmax = p0[0];
#pragma unroll
    for (int r = 1; r < 16; ++r) pmax = fmaxf(pmax, p0[r]);
#pragma unroll
    for (int r = 0; r < 16; ++r) pmax = fmaxf(pmax, p1[r]);
    auto rr = __builtin_amdgcn_permlane32_swap(__float_as_uint(pmax), __float_as_uint(pmax), false, false);
    return fmaxf(__uint_as_float(rr[0]), __uint_as_float(rr[1]));
}
__device__ __forceinline__ float rowsum32(const f32x16& p0, const f32x16& p1) {
    float ps = 0.f;
#pragma unroll
    for (int r = 0; r < 16; ++r) ps += p0[r];
#pragma unroll
    for (int r = 0; r < 16; ++r) ps += p1[r];
    auto rr = __builtin_amdgcn_permlane32_swap(__float_as_uint(ps), __float_as_uint(ps), false, false);
    return __uint_as_float(rr[0]) + __uint_as_float(rr[1]);
}
__device__ __forceinline__ void pack_p(const f32x16& p0, const f32x16& p1, bf16x8& pa0, bf16x8& pa1, bf16x8& pa2, bf16x8& pa3) {
#define PK4(P, B_, OUT) do { unsigned a0 = cvtpk(P[B_+0], P[B_+1]), a1 = cvtpk(P[B_+2], P[B_+3]);                          \
        unsigned b0 = cvtpk(P[B_+4], P[B_+5]), b1 = cvtpk(P[B_+6], P[B_+7]);                                             \
        auto r0 = __builtin_amdgcn_permlane32_swap(a0, b0, false, false); auto r1 = __builtin_amdgcn_permlane32_swap(a1, b1, false, false); \
        u32x4 w = {r0[0], r1[0], r0[1], r1[1]}; OUT = *reinterpret_cast<bf16x8*>(&w); } while (0)
    PK4(p0, 0, pa0); PK4(p0, 8, pa1); PK4(p1, 0, pa2); PK4(p1, 8, pa3);
#undef PK4
}
__device__ __forceinline__ void qkt(f32x16& p0, f32x16& p1, const char* K_lds, int r32, int hi, const char* Qw) {
    p0 = f32x16{}; p1 = f32x16{};
    int ko[4];
#pragma unroll
    for (int dd = 0; dd < 4; ++dd) ko[dd] = KSWZ(r32, (dd * 16 + hi * 8) * 2);
#pragma unroll
    for (int d0 = 0; d0 < 8; ++d0) { const int off = ko[d0 & 3] + (d0 >> 2) * 128; const char* a = K_lds + off;
        bf16x8 b0 = *reinterpret_cast<const bf16x8*>(a);
        bf16x8 b1 = *reinterpret_cast<const bf16x8*>(a + 32 * 256);
        bf16x8 q = *reinterpret_cast<const bf16x8*>(Qw + off);
        p0 = __builtin_amdgcn_mfma_f32_32x32x16_bf16(b0, q, p0, 0, 0, 0);
        p1 = __builtin_amdgcn_mfma_f32_32x32x16_bf16(b1, q, p1, 0, 0, 0); }
}
__device__ __forceinline__ void q_park(char* Qw, int r32, int hi, int d0, bf16x8 v) { *(bf16x8*)(Qw + KSWZ(r32, (d0 * 16 + hi * 8) * 2)) = v; }
__device__ __forceinline__ void pv_tile(f32x16 (&o)[4], int vb0, bf16x8 pa0, bf16x8 pa1, bf16x8 pa2, bf16x8 pa3) {
#define TRRD(dst, off) asm volatile("ds_read_b64_tr_b16 %0, %1 offset:%2" : "=&v"(dst) : "v"(vb0), "i"(off) : "memory")
#define PV_RD(S_, d0) do { constexpr int b_ = v_rd_off(d0, 0, 0); \
        TRRD(S_##l0, b_); TRRD(S_##h0, b_ + 2048); TRRD(S_##l1, b_ + 4096); TRRD(S_##h1, b_ + 6144); TRRD(S_##l2, b_ + 8192); TRRD(S_##h2, b_ + 10240); TRRD(S_##l3, b_ + 12288); TRRD(S_##h3, b_ + 14336); } while (0)
#define PV_MM(S_, d0) do { \
        o[d0] = __builtin_amdgcn_mfma_f32_32x32x16_bf16(pa0, (bf16x8){S_##l0[0], S_##l0[1], S_##l0[2], S_##l0[3], S_##h0[0], S_##h0[1], S_##h0[2], S_##h0[3]}, o[d0], 0, 0, 0);   \
        o[d0] = __builtin_amdgcn_mfma_f32_32x32x16_bf16(pa1, (bf16x8){S_##l1[0], S_##l1[1], S_##l1[2], S_##l1[3], S_##h1[0], S_##h1[1], S_##h1[2], S_##h1[3]}, o[d0], 0, 0, 0);   \
        o[d0] = __builtin_amdgcn_mfma_f32_32x32x16_bf16(pa2, (bf16x8){S_##l2[0], S_##l2[1], S_##l2[2], S_##l2[3], S_##h2[0], S_##h2[1], S_##h2[2], S_##h2[3]}, o[d0], 0, 0, 0);   \
        o[d0] = __builtin_amdgcn_mfma_f32_32x32x16_bf16(pa3, (bf16x8){S_##l3[0], S_##l3[1], S_##l3[2], S_##l3[3], S_##h3[0], S_##h3[1], S_##h3[2], S_##h3[3]}, o[d0], 0, 0, 0); } while (0)
#define LWAIT() do { asm volatile("s_waitcnt lgkmcnt(0)" ::: "memory"); SBAR(); } while (0)
    s16x4 Al0, Al1, Al2, Al3, Ah0, Ah1, Ah2, Ah3, Bl0, Bl1, Bl2, Bl3, Bh0, Bh1, Bh2, Bh3;
    PV_RD(A, 0); LWAIT();
    PV_RD(B, 1); SBAR(); PV_MM(A, 0); LWAIT();
    PV_RD(A, 2); SBAR(); PV_MM(B, 1); LWAIT();
    PV_RD(B, 3); SBAR(); PV_MM(A, 2); LWAIT();
    PV_MM(B, 3);
#undef LWAIT
#undef PV_MM
#undef PV_RD
#undef TRRD
}

template <int MODE>
__device__ __forceinline__ void attn_tiles(f32x16 (&o)[4], float& m_reg, float& l_reg, const char* Qw, const bf16_t* Kb, const bf16_t* Vb, int ldk,
                                           int t_lo, int t_hi, int tpos, unsigned long long sel, int own, float rl, char* lds, int tid, int wid, int lane) {
    asm volatile("" : "+v"(tid)); asm volatile("" : "+v"(lane));
    const int r32 = lane & 31, hi = lane >> 5;
    float* al_l = (float*)(lds + OFF_WS) + wid * 64;
    const int sr = tid >> 4, sc = (tid & 15) * 8;
    const int kws = KSWZ(sr, sc * 2), vst0 = v_st(sr, sc), vst1 = v_st(32 + sr, sc);
    const int vbase = (int)(uintptr_t)(lds + OFF_V) + v_rd_base(lane);
    bf16x8 sk0, sk1, sv0, sv1;
    sk0 = sk1 = sv0 = sv1 = (bf16x8){0, 0, 0, 0, 0, 0, 0, 0};
    float carry = 0.f;
#define LOADT(tt) do { const bf16_t* kp_ = Kb + (size_t)((tt) * 64 + sr) * ldk + sc; sk0 = *(const bf16x8*)kp_; sk1 = *(const bf16x8*)(kp_ + (size_t)32 * ldk); \
        if (MODE != 3) { const bf16_t* vp_ = Vb + (size_t)((tt) * 64 + sr) * ldk + sc; sv0 = *(const bf16x8*)vp_; sv1 = *(const bf16x8*)(vp_ + (size_t)32 * ldk); } } while (0)
#define WRITET(bo) do { *(bf16x8*)(lds + (bo) + OFF_K + kws) = sk0; *(bf16x8*)(lds + (bo) + OFF_K + kws + 32 * 256) = sk1; \
        if (MODE != 3) { *(bf16x8*)(lds + (bo) + OFF_V + vst0) = sv0; *(bf16x8*)(lds + (bo) + OFF_V + vst1) = sv1; } } while (0)
    if (t_lo < t_hi) { LOADT(t_lo); __syncthreads(); WRITET(0); if (t_lo + 1 < t_hi) LOADT(t_lo + 1); __syncthreads(); }
    if (wid >= 4) __builtin_amdgcn_s_setprio(1);
    for (int t = t_lo; t < t_hi; ++t) {
        const int bo = ((t - t_lo) & 1) * KVBUF;
        if (t + 1 < t_hi) { WRITET(bo ^ KVBUF); if (t + 2 < t_hi) LOADT(t + 2); }
        const char* K_lds = lds + bo + OFF_K; const int vb0 = vbase + bo;
        bool rowok = true, needm = true; unsigned Wm = 0x7fffffffu;
        if (MODE == 0) { const int kb = t >> 2; if (kb < own) { rowok = ((sel >> kb) & 1ull) != 0ull; needm = false; } else needm = ((t - 4 * own) * 64 + 63 > 32 * wid); }
        if (MODE == 1) { rowok = ((sel >> t) & 1ull) != 0ull; needm = (t == t_hi - 1); }
        if (MODE == 2) { Wm = 512u; needm = (t == t_hi - 1) || (t == t_hi - 9); }
        bool skipw = (MODE == 0) && ((t >> 2) >= own) && ((t - 4 * own) * 64 > 32 * wid + 31);
        if (MODE == 0 || MODE == 1) skipw = skipw || !__any(rowok);
        if (!skipw) {
        f32x16 p0, p1;
        qkt(p0, p1, K_lds, r32, hi, Qw);
        if (needm) mask_tile(p0, p1, tpos - t * 64 - 4 * hi, Wm, true);
        const float NEGINF = -__builtin_inff();
        if (MODE == 3) {
            const float pmax = rowmax32(p0, p1);
            const float mn = fmaxf(m_reg, pmax); const float alpha = __builtin_amdgcn_exp2f((m_reg - mn) * C2); m_reg = mn;
            const float mnL = -mn * C2;
#pragma unroll
            for (int r = 0; r < 16; ++r) { p0[r] = __builtin_amdgcn_exp2f(fmaf(p0[r], C2, mnL)); p1[r] = __builtin_amdgcn_exp2f(fmaf(p1[r], C2, mnL)); }
            l_reg = l_reg * alpha + rowsum32(p0, p1);
        } else if (MODE == 4) {
            const float mnL = -m_reg * C2;
#pragma unroll
            for (int r = 0; r < 16; ++r) { p0[r] = __builtin_amdgcn_exp2f(fmaf(p0[r], C2, mnL)) * rl; p1[r] = __builtin_amdgcn_exp2f(fmaf(p1[r], C2, mnL)) * rl; }
            float* impA = (float*)(lds + OFF_IMP + wid * 2048);
#pragma unroll
            for (int half = 0; half < 2; ++half)
#pragma unroll
                for (int rr = 0; rr < 4; ++rr) {
                    float a = half ? ((p1[4 * rr] + p1[4 * rr + 1]) + (p1[4 * rr + 2] + p1[4 * rr + 3])) : ((p0[4 * rr] + p0[4 * rr + 1]) + (p0[4 * rr + 2] + p0[4 * rr + 3]));
                    float bl = half ? p1[4 * rr + 3] : p0[4 * rr + 3];
                    a += __shfl_xor(a, 1); a += __shfl_xor(a, 2); bl += __shfl_xor(bl, 1); bl += __shfl_xor(bl, 2);
                    const float other = __shfl_xor(bl, 32);
                    const float add = hi ? other : carry;
                    carry = other;
                    const int j = 16 * t + 8 * half + 2 * rr + hi;
                    if ((r32 & 3) == 0) impA[(r32 >> 2) * 64 + j] = a + add;
                }
            bf16x8 pa0, pa1, pa2, pa3; pack_p(p0, p1, pa0, pa1, pa2, pa3);
            pv_tile(o, vb0, pa0, pa1, pa2, pa3);
        } else {
            float pmax = rowmax32(p0, p1); pmax = rowok ? pmax : NEGINF;
            float mn, alpha;
            if (__all((pmax - m_reg) * SCALE <= 8.f)) { mn = m_reg; alpha = 1.f; }
            else { mn = fmaxf(m_reg, pmax); alpha = __builtin_amdgcn_exp2f((m_reg - mn) * C2); m_reg = mn; }
            const float mnL = rowok ? -mn * C2 : NEGINF;
#pragma unroll
            for (int r = 0; r < 16; ++r) { p0[r] = __builtin_amdgcn_exp2f(fmaf(p0[r], C2, mnL)); p1[r] = __builtin_amdgcn_exp2f(fmaf(p1[r], C2, mnL)); }
            l_reg = l_reg * alpha + rowsum32(p0, p1);
            bf16x8 pa0, pa1, pa2, pa3; pack_p(p0, p1, pa0, pa1, pa2, pa3);
            if (__any(alpha < 1.f)) {
                if (hi == 0) al_l[r32] = alpha;
                asm volatile("s_waitcnt lgkmcnt(0)" ::: "memory");
#pragma unroll
                for (int r = 0; r < 16; ++r) { const float f = al_l[crow(r, hi)];
#pragma unroll
                    for (int d_ = 0; d_ < 4; ++d_) o[d_][r] *= f; }
            }
            pv_tile(o, vb0, pa0, pa1, pa2, pa3);
        }
        }
        __syncthreads();
    }
    __builtin_amdgcn_s_setprio(0);
#undef LOADT
#undef WRITET
}

template <bool NSA, bool ACCUM>
__device__ __forceinline__ void store_o(const f32x16 (&o)[4], float f, bf16_t* OB, size_t rowbase, int tok0, int hbase, char* lds, int wid, int lane) {
    asm volatile("" : "+v"(lane));
    const int r32 = lane & 31, hi = lane >> 5;
    float* li_l = (float*)(lds + OFF_WS) + wid * 64 + 32;
    if (hi == 0) li_l[r32] = f;
    asm volatile("s_waitcnt lgkmcnt(0)" ::: "memory");
#pragma unroll
    for (int r = 0; r < 16; ++r) {
        const int rw = crow(r, hi); const float fr = li_l[rw];
        const int tok = NSA ? tok0 + (rw >> 2) : tok0 + rw, hd = NSA ? hbase + (rw & 3) : hbase;
        bf16_t* op = OB + (rowbase + tok) * D + hd * HD + r32;
#pragma unroll
        for (int d0 = 0; d0 < 4; ++d0) {
            float v = o[d0][r] * fr; float vn = __shfl_xor(v, 1);
            if ((r32 & 1) == 0) { unsigned* wp = (unsigned*)(op + d0 * 32);
                if (ACCUM) { const unsigned old = *wp; v += bflo(old); vn += bfhi(old); }
                *wp = cvtpk(v, vn); }
        }
    }
}
}

__device__ __forceinline__ void moba_unit(const Params& P, int b, int h, int own, char* lds, int tid, int wid, int lane) {
    using namespace at;
    const bf16_t* BIG = (const bf16_t*)(P.ws + WS_BIG); const float* KMEAN = (const float*)(P.ws + WS_KMEAN); bf16_t* OB = (bf16_t*)(P.ws + WS_OB);
    const int r32 = lane & 31, hi = lane >> 5;
    const int tokl = own * 256 + wid * 32 + r32; const size_t row = (size_t)b * S + tokl;
    char* Qw = lds + OFF_Q + wid * 8192;
#pragma unroll
    for (int d0 = 0; d0 < 8; ++d0) q_park(Qw, r32, hi, d0, *(const bf16x8*)(BIG + row * MQ_LD + h * HD + d0 * 16 + hi * 8));
    char* K_lds = lds + OFF_K;
    { const int sr = tid >> 4, sc = (tid & 15) * 8; const int kws = KSWZ(sr, sc * 2);
      bf16x8 z0 = (bf16x8){0, 0, 0, 0, 0, 0, 0, 0}; const bf16x8 z1 = z0;
      if (sr < 16) { const float* km = KMEAN + (size_t)((b * NH + h) * 16 + sr) * HD + sc; z0 = pack8(*(const f32x4*)km, *(const f32x4*)(km + 4)); }
      __syncthreads();
      *(bf16x8*)(K_lds + kws) = z0; *(bf16x8*)(K_lds + kws + 32 * 256) = z1;
      __syncthreads(); }
    unsigned sel = 0u;
    { f32x16 p0, p1; qkt(p0, p1, K_lds, r32, hi, Qw);
      float g[16];
#pragma unroll
      for (int r = 0; r < 8; ++r) { const float mine = p0[r], other = __shfl_xor(mine, 32); const int nb = (r & 3) + 8 * (r >> 2);
          g[nb] = hi == 0 ? mine : other; g[nb + 4] = hi == 0 ? other : mine; }
      if (own <= 3) sel = (1u << own) - 1u;
      else {
#pragma unroll
          for (int pass = 0; pass < 3; ++pass) { float best = 0.f; int bi = -1;
#pragma unroll
              for (int n = 0; n < 16; ++n) { const bool cand = (n < own) && (((sel >> n) & 1u) == 0u); if (cand && (bi < 0 || g[n] > best)) { best = g[n]; bi = n; } }
              sel |= 1u << bi; }
      } }
    f32x16 o[4]; o[0] = f32x16{}; o[1] = f32x16{}; o[2] = f32x16{}; o[3] = f32x16{};
    float m_reg = -1e30f, l_reg = 0.f;
    const bf16_t* Kb = BIG + (size_t)b * S * MQ_LD + D + h * HD; const bf16_t* Vb = Kb + D;
    attn_tiles<0>(o, m_reg, l_reg, Qw, Kb, Vb, MQ_LD, 0, 4 * own + 4, tokl, (unsigned long long)sel, own, 0.f, lds, tid, wid, lane);
    store_o<false, false>(o, 1.f / l_reg, OB, (size_t)b * S, own * 256 + wid * 32, h, lds, wid, lane);
}
__device__ __forceinline__ void phase_moba_attn(const Params& P, char* lds, int bid, int G, int tid, int wid, int lane) {
    asm volatile("" : "+v"(tid)); asm volatile("" : "+v"(lane));
    for (int p0 = bid; p0 < NB * NH * 8; p0 += G) {
        int pr = p0; if (G == 256) { const int xcd = p0 & 7, slot = p0 >> 3; pr = (xcd * 4 + (slot >> 3)) * 8 + (slot & 7); }
        const int x = pr & 7, h = (pr >> 3) & 15, b = pr >> 7;
        moba_unit(P, b, h, 15 - x, lds, tid, wid, lane);
        moba_unit(P, b, h, x, lds, tid, wid, lane);
    }
}

__device__ __forceinline__ void nsa_unit(const Params& P, int b, int g, int c, char* lds, int tid, int wid, int lane) {
    using namespace at;
    const bf16_t* BIG = (const bf16_t*)(P.ws + WS_BIG); const bf16_t* QROT = (const bf16_t*)(P.ws + WS_PP); bf16_t* OB = (bf16_t*)(P.ws + WS_OB);
    const int r32 = lane & 31, hi = lane >> 5;
    const int tokl = 64 * c + 8 * wid + (r32 >> 2), head = 4 * g + (r32 & 3); const size_t row = (size_t)b * S + tokl;
    char* Qw = lds + OFF_Q + wid * 8192;
#pragma unroll
    for (int d0 = 0; d0 < 8; ++d0) q_park(Qw, r32, hi, d0, *(const bf16x8*)(BIG + row * NQ_LD + head * HD + d0 * 16 + hi * 8));
    f32x16 o[4]; o[0] = f32x16{}; o[1] = f32x16{}; o[2] = f32x16{}; o[3] = f32x16{};
    float m_reg = -1e30f, l_reg = 0.f;
    const bf16_t* Kc = (const bf16_t*)(P.ws + WS_KC) + (size_t)(b * 4 + g) * 256 * HD; const bf16_t* Vc = (const bf16_t*)(P.ws + WS_VC) + (size_t)(b * 4 + g) * 256 * HD;
    const int tq = (tokl - 31) >> 4;
    const int ncmp = ((4 * c + 2) >> 6) + 1;
    attn_tiles<3>(o, m_reg, l_reg, Qw, Kc, Vc, HD, 0, ncmp, tq, 0ull, 0, 0.f, lds, tid, wid, lane);
    const float rl = l_reg > 0.f ? 1.f / l_reg : 0.f;
    attn_tiles<4>(o, m_reg, l_reg, Qw, Kc, Vc, HD, 0, ncmp, tq, 0ull, 0, rl, lds, tid, wid, lane);
    store_o<true, false>(o, sigmoidf_(bf1(BIG[row * NQ_LD + 5120 + head * 3 + 0])), OB, (size_t)b * S, 64 * c + 8 * wid, 4 * g, lds, wid, lane);
    unsigned long long sel;
    { float* impA = (float*)(lds + OFF_IMP + wid * 2048);
      unsigned long long* selm = (unsigned long long*)(lds + OFF_SELM + wid * 64);
      asm volatile("s_waitcnt lgkmcnt(0)" ::: "memory");
      const float INF = __builtin_inff();
      for (int tk = 0; tk < 8; ++tk) {
          float val = impA[tk * 64 + lane];
          if (lane == 0 || lane == c) val = INF; else if (lane > c) val = -INF;
          const unsigned u_ = __float_as_uint(val); const unsigned key = (u_ & 0x80000000u) ? ~u_ : (u_ | 0x80000000u);
          unsigned thr = 0u;
#pragma unroll
          for (int bit = 31; bit >= 0; --bit) { const unsigned cand = thr | (1u << bit); if (__popcll(__ballot(key >= cand)) >= 16) thr = cand; }
          const unsigned long long gt_ = __ballot(key > thr), eq_ = __ballot(key == thr);
          const int need = 16 - __popcll(gt_), eqrank = __popcll(eq_ & ((1ull << lane) - 1ull));
          const bool s = ((key > thr) || (key == thr && eqrank < need)) && (val > -INF);
          const unsigned long long mk = __ballot(s);
          if (lane == 0) selm[tk] = mk;
      }
      asm volatile("s_waitcnt lgkmcnt(0)" ::: "memory");
      sel = selm[r32 >> 2]; }
    {
      const int pos_ = ((const int*)P.in[2])[row];
      const u32x4 w1 = *(const u32x4*)(Qw + KSWZ(r32, (0 * 16 + hi * 8) * 2)), w2 = *(const u32x4*)(Qw + KSWZ(r32, (1 * 16 + hi * 8) * 2));
      float x1[8] = {bflo(w1.x), bfhi(w1.x), bflo(w1.y), bfhi(w1.y), bflo(w1.z), bfhi(w1.z), bflo(w1.w), bfhi(w1.w)};
      float x2[8] = {bflo(w2.x), bfhi(w2.x), bflo(w2.y), bfhi(w2.y), bflo(w2.z), bfhi(w2.z), bflo(w2.w), bfhi(w2.w)};
#pragma unroll
      for (int j = 0; j < 8; ++j) { const int i_ = hi * 8 + j;
          const float freq = __builtin_amdgcn_exp2f(-(float)i_ * (18.931568569324174f / 16.0f));
          const float ang = (float)pos_ * freq; const double rev = (double)ang * 0.15915494309189535; const float fr_ = (float)(rev - floor(rev));
          const float c_ = __builtin_amdgcn_cosf(fr_), s_ = __builtin_amdgcn_sinf(fr_);
          const float a1 = x1[j], a2 = x2[j]; x1[j] = a1 * c_ - a2 * s_; x2[j] = a2 * c_ + a1 * s_; }
      q_park(Qw, r32, hi, 0, pack8((f32x4){x1[0], x1[1], x1[2], x1[3]}, (f32x4){x1[4], x1[5], x1[6], x1[7]}));
      q_park(Qw, r32, hi, 1, pack8((f32x4){x2[0], x2[1], x2[2], x2[3]}, (f32x4){x2[4], x2[5], x2[6], x2[7]})); }
    o[0] = f32x16{}; o[1] = f32x16{}; o[2] = f32x16{}; o[3] = f32x16{}; m_reg = -1e30f; l_reg = 0.f;
    const bf16_t* kvb = BIG + (size_t)b * S * NQ_LD + D + g * HD;
    attn_tiles<1>(o, m_reg, l_reg, Qw, kvb + 2 * 512, kvb + 3 * 512, NQ_LD, 0, c + 1, tokl, sel, 0, 0.f, lds, tid, wid, lane);
    store_o<true, true>(o, sigmoidf_(bf1(BIG[row * NQ_LD + 5120 + head * 3 + 1])) / l_reg, OB, (size_t)b * S, 64 * c + 8 * wid, 4 * g, lds, wid, lane);
    o[0] = f32x16{}; o[1] = f32x16{}; o[2] = f32x16{}; o[3] = f32x16{}; m_reg = -1e30f; l_reg = 0.f;
    attn_tiles<2>(o, m_reg, l_reg, Qw, kvb + 4 * 512, kvb + 5 * 512, NQ_LD, (c > 8 ? c - 8 : 0), c + 1, tokl, 0ull, 0, 0.f, lds, tid, wid, lane);
    store_o<true, true>(o, sigmoidf_(bf1(BIG[row * NQ_LD + 5120 + head * 3 + 2])) / l_reg, OB, (size_t)b * S, 64 * c + 8 * wid, 4 * g, lds, wid, lane);
}
__device__ __forceinline__ void phase_nsa_attn(const Params& P, char* lds, int bid, int G, int tid, int wid, int lane) {
    asm volatile("" : "+v"(tid)); asm volatile("" : "+v"(lane));
    for (int p0 = bid; p0 < NB * 4 * 32; p0 += G) {
        int pr = p0; if (G == 256) { const int xcd = p0 & 7, slot = p0 >> 3; pr = xcd * 32 + slot; }
        const int x = pr & 31, g = (pr >> 5) & 3, b = pr >> 7;
        nsa_unit(P, b, g, 63 - x, lds, tid, wid, lane);
        nsa_unit(P, b, g, x, lds, tid, wid, lane);
    }
}
typedef unsigned v4u __attribute__((ext_vector_type(4)));
#define XB_TMO      128
#define XB_XCNT(j)  (256  + 64 * (j))
#define XB_XSUB(j)  (1280 + 64 * (j))
#define XB_XGEN(j)  (2304 + 64 * (j))
#define XB_TOP      3328
#define XB_TOPGEN   3392
#define XCD_BAR_WORDS 3456
#define XB_SPIN_CAP (1u << 18)

__device__ __forceinline__ unsigned xb_ld(unsigned* p)              { return __hip_atomic_load(p, __ATOMIC_RELAXED, __HIP_MEMORY_SCOPE_AGENT); }
__device__ __forceinline__ unsigned xb_add(unsigned* p, unsigned v) { return __hip_atomic_fetch_add(p, v, __ATOMIC_RELAXED, __HIP_MEMORY_SCOPE_AGENT); }
__device__ __forceinline__ unsigned xb_xcc_id() { return (unsigned)__builtin_amdgcn_s_getreg((3 << 11) | 20) & 0xFu; }
#define XB_SPIN(cond, bar) do { unsigned _sp = 0; while (cond) { __builtin_amdgcn_s_sleep(1); \
    if ((++_sp & 255u) == 0u) { if (xb_ld(&(bar)[XB_TMO])) break; if (_sp > XB_SPIN_CAP) { atomicAdd(&(bar)[XB_TMO], 1u); break; } } } } while (0)

struct XcdBarrier {
    unsigned* bar; unsigned x;
    volatile LAS unsigned* st;
};

__device__ __forceinline__ XcdBarrier xcd_barrier_post(unsigned* bar, volatile LAS unsigned* st) {
    XcdBarrier b; b.bar = bar; b.x = xb_xcc_id(); b.st = st;
    if (threadIdx.x == 0) (void)xb_add(&bar[XB_XCNT(b.x)], 1u);
    return b;
}
__device__ __forceinline__ void xcd_barrier_complete(unsigned* bar, unsigned x, unsigned& nloc, unsigned& nx) {
    const unsigned G = gridDim.x * gridDim.y * gridDim.z;
    unsigned sum, cnt, mine, sp = 0u;
    for (;;) {
        sum = 0u; cnt = 0u; mine = 0u;
#pragma unroll
        for (unsigned j = 0; j < 16; ++j) { const unsigned c = xb_ld(&bar[XB_XCNT(j)]); sum += c; cnt += (c > 0u) ? 1u : 0u; mine = (j == x) ? c : mine; }
        if (sum == G) break;
        __builtin_amdgcn_s_sleep(1);
        if ((++sp & 255u) == 0u) { if (xb_ld(&bar[XB_TMO])) break; if (sp > XB_SPIN_CAP) { atomicAdd(&bar[XB_TMO], 1u); break; } }
    }
    nloc = mine > 0u ? mine : 1u; nx = cnt > 0u ? cnt : 1u;
}

__device__ __forceinline__ void xcd_barrier(const XcdBarrier& b) {
    asm volatile("s_waitcnt vmcnt(0)" ::: "memory");
    __syncthreads();
    if (threadIdx.x == 0) {
        unsigned* bar = b.bar;
        __builtin_amdgcn_s_waitcnt(0);
        unsigned nloc = b.st[0], nx = b.st[1];
        if (nloc == 0u) { xcd_barrier_complete(bar, b.x, nloc, nx); b.st[0] = nloc; b.st[1] = nx; }
        const unsigned old = xb_add(&bar[XB_XSUB(b.x)], 1u);
        const unsigned gen = old / nloc;
        if (old + 1u == (gen + 1u) * nloc) {
            __builtin_amdgcn_fence(__ATOMIC_RELEASE, "agent");
            asm volatile("s_waitcnt vmcnt(0)" ::: "memory");
            const unsigned og = xb_add(&bar[XB_TOP], 1u);
            const unsigned tg = og / nx;
            if (og + 1u == (tg + 1u) * nx) xb_add(&bar[XB_TOPGEN], 1u);
            else XB_SPIN(xb_ld(&bar[XB_TOPGEN]) == tg, bar);
            __builtin_amdgcn_fence(__ATOMIC_ACQUIRE, "agent");
            xb_add(&bar[XB_XGEN(b.x)], 1u);
            asm volatile("s_waitcnt vmcnt(0)" ::: "memory");
        } else {
            XB_SPIN(xb_ld(&bar[XB_XGEN(b.x)]) == gen, bar);
            __builtin_amdgcn_fence(__ATOMIC_ACQUIRE, "agent");
            asm volatile("s_waitcnt vmcnt(0)" ::: "memory");
        }
    }
    __syncthreads();
}

__global__ void __launch_bounds__(NTHREADS, 2) trunk_fwd(Params P) {
    extern __shared__ __attribute__((aligned(16))) unsigned char lds_raw[];
    char* lds = (char*)lds_raw;
    cg::grid_group grid = cg::this_grid();
    const int tid = threadIdx.x, lane = tid & 63, wid = __builtin_amdgcn_readfirstlane(tid >> 6);
    const int bid = blockIdx.x, G = gridDim.x;
    const int gw = bid * NWAVES + wid, NGW = G * NWAVES, gtid = bid * NTHREADS + tid, NT = G * NTHREADS;
    unsigned char* ws = P.ws;
    const float* x = (const float*)P.in[0];
    float* out = P.out;
    bf16_t* XN = (bf16_t*)(ws + WS_XN); bf16_t* OB = (bf16_t*)(ws + WS_OB); bf16_t* PPB = (bf16_t*)(ws + WS_PP); bf16_t* BIG = (bf16_t*)(ws + WS_BIG);

    volatile LAS unsigned* bst = (volatile LAS unsigned*)((LAS unsigned char*)lds_raw + LDS_BYTES - 16);
    if (tid == 0) { bst[0] = 0u; bst[1] = 0u; }
    __syncthreads();
    const XcdBarrier bar = xcd_barrier_post((unsigned*)(ws + WS_CTL), bst);
#define GSYNC() do { XcdBarrier b2_ = bar; asm volatile("" : "+s"(b2_.x)); xcd_barrier(b2_); } while (0)
    phase_convert(P, lds, gw, NGW, gtid, NT, wid, lane);
    __syncthreads();
    if (P.out == nullptr) grid.sync();
    GSYNC();

    bf16_t* hbc = XN;
    bf16_t* hbo = (bf16_t*)(ws + WS_HB1);
    unsigned* SS = (unsigned*)(ws + WS_SS);
    for (int i = 0; i < 4; ++i) {
        if (i == 1) {
            phase_pool_prep(hbc, SS + (size_t)(3 * i) * T, (const float*)P.in[3] + (size_t)i * D, OB, lds, bid, G, tid, wid, lane);
            GSYNC();
            for (int gq = 0; gq < 4; ++gq) {
                pg8::EpiH<0> E{nullptr, hbc, nullptr, (const float*)P.in[15], gq * 512, nullptr, nullptr, hbc, SS + (size_t)(3 * i + 1) * T};
                gemm_run(lds, OB + gq * 512, D, (const bf16_t*)(ws + WS_POOL) + (size_t)gq * 512 * 512, 512, T, 512, 512, G, (bid + gq * (G / 4)) % G, E);
            }
            GSYNC();
        } else {
            { const bf16_t* Wt = (const bf16_t*)(ws + (i == 0 ? WS_MQKV : (i == 2 ? WS_NQKV : WS_CIN))); const int N = (i == 2) ? NQ_LD : MQ_LD;
              pg8::EpiB<0> E{BIG, N, SS + (size_t)(3 * i) * T};
              gemm_run(lds, hbc, D, Wt, D, T, N, D, G, bid, E); }
            GSYNC();
            if (i == 0) {
                phase_moba_prep(P, lds, bid, G, tid, wid, lane);
                GSYNC();
                phase_moba_attn(P, lds, bid, G, tid, wid, lane);
            } else if (i == 2) {
                phase_nsa_norm(P, gw, NGW, lane);
                phase_nsa_compress(P, lds, bid, G, tid, wid, lane);
                GSYNC();
                phase_nsa_attn(P, lds, bid, G, tid, wid, lane);
            } else {
                phase_conv_elem(P, gtid, NT);
            }
            __syncthreads();
            GSYNC();
            { const bf16_t* Wt = (const bf16_t*)(ws + (i == 0 ? WS_MWO : (i == 2 ? WS_NWO : WS_CWO)));
              pg8::EpiH<0> E{(i == 0) ? x : nullptr, hbc, nullptr, nullptr, 0, nullptr, nullptr, hbc, SS + (size_t)(3 * i + 1) * T};
              gemm_run(lds, OB, D, Wt, D, T, D, D, G, bid, E); }
            GSYNC();
        }
        { pg8::EpiB<2> E{BIG, FF, nullptr};
          gemm_run(lds, hbc, D, (const bf16_t*)(ws + WS_W1T + (size_t)i * 32 * MiB), D, T, FF, D, G, bid, E); }
        { pg8::EpiB<0> E{PPB, D, nullptr};
          gemm_run(lds, (const bf16_t*)(ws + WS_PB) + (size_t)i * T * 256, 256, (const bf16_t*)(ws + WS_PPT + (size_t)i * 1 * MiB), 256, T, D, 256, G, bid, E); }
        GSYNC();
        { pg8::EpiH<0> E{nullptr, hbc, nullptr, nullptr, 0, nullptr, SS + (size_t)(3 * i + 1) * T, hbc, SS + (size_t)(3 * i + 2) * T};
          gemm_run(lds, BIG, FF, (const bf16_t*)(ws + WS_W2T + (size_t)i * 32 * MiB), FF, T, D, FF, G, bid, E); }
        GSYNC();
        { pg8::EpiH<1> E{nullptr, hbc, (i == 3) ? out : nullptr, nullptr, 0, PPB, SS + (size_t)(3 * i + 2) * T, (i < 3) ? hbo : nullptr, (i < 3) ? SS + (size_t)(3 * i + 3) * T : nullptr};
          gemm_run(lds, hbc, D, (const bf16_t*)(ws + WS_PGT + (size_t)i * 8 * MiB), D, T, D, D, G, bid, E); }
        if (i < 3) { GSYNC(); bf16_t* tsw = hbc; hbc = hbo; hbo = tsw; }
    }
}

extern "C" void kernel_launch(void* const* d_in, const int* in_sizes, int n_in, void* d_out, int out_size, void* d_ws, size_t ws_size, hipStream_t stream) {
    static int grid = 0;
    if (grid == 0) {
        if (n_in != 29 || out_size != T * D || ws_size < WS_END) { fprintf(stderr, "kernel_launch: unexpected problem (n_in %d, out %d, ws %zu)\n", n_in, out_size, ws_size); grid = -1; return; }
        int dev = 0, cus = 0, per_cu = 0;
        hipGetDevice(&dev);
        hipDeviceGetAttribute(&cus, hipDeviceAttributeMultiprocessorCount, dev);
        hipFuncSetAttribute((const void*)trunk_fwd, hipFuncAttributeMaxDynamicSharedMemorySize, LDS_BYTES);
        hipOccupancyMaxActiveBlocksPerMultiprocessor(&per_cu, (const void*)trunk_fwd, NTHREADS, LDS_BYTES);
        (void)hipGetLastError();
        if (per_cu < 1) { fprintf(stderr, "kernel_launch: occupancy query says %d blocks per CU\n", per_cu); per_cu = 1; }
        grid = cus;
        fprintf(stderr, "kernel_launch: cus %d per_cu %d grid %d\n", cus, per_cu, grid);
    }
    if (grid < 0) return;
    if (hipMemsetAsync((char*)d_ws + WS_CTL, 0, 1048576, stream) != hipSuccess) { fprintf(stderr, "kernel_launch: memset failed\n"); return; }
    Params p{};
    for (int i = 0; i < 29; ++i) p.in[i] = d_in[i];
    p.out = (float*)d_out; p.ws = (unsigned char*)d_ws;
    void* args[] = {&p};
    hipError_t e = hipLaunchCooperativeKernel((const void*)trunk_fwd, dim3(grid), dim3(NTHREADS), args, LDS_BYTES, stream);
    if (e != hipSuccess) fprintf(stderr, "cooperative launch failed: %s (grid %d)\n", hipGetErrorString(e), grid);
}
```

```cpp
#include <hip/hip_runtime.h>
#include <hip/hip_cooperative_groups.h>
#include <cstdio>
#include <cstdint>
namespace cg = cooperative_groups;
namespace pg8 {
#define PG8_LAS __attribute__((address_space(3)))
typedef unsigned short bf16_t;
typedef short bf16x8 __attribute__((ext_vector_type(8)));
typedef float f32x4 __attribute__((ext_vector_type(4)));
typedef unsigned u32x4 __attribute__((ext_vector_type(4)));
typedef unsigned u32x2_ __attribute__((ext_vector_type(2)));
constexpr int BM = 256, BK = 64, HALF = 128, HTB = HALF * BK * 2  , STAGE_BYTES = 8 * HTB, NXCD = 8, WGM = 8;

__host__ __device__ __forceinline__ int lds_byte(int r, int c) { const int st = (r >> 4) * 2 + (c >> 5), rr = r & 15, cc = c & 31, ob = rr * 64 + cc * 2; return st * 1024 + (ob ^ (((ob >> 9) & 1) << 5)); }
__host__ __device__ __forceinline__ void stage_rc(int b, int& R, int& C) { const int st = b / 1024, sb = b % 1024, swz = sb ^ (((sb >> 9) & 1) << 5); R = (st >> 1) * 16 + swz / 64; C = (st & 1) * 32 + (swz % 64) / 2; }
__host__ __device__ __forceinline__ int perm32(int rho) { const int n = rho >> 4, i = rho & 15; return 8 * (i >> 2) + 4 * n + (i & 3); }

struct Unit { int pm, pn; };
struct Gemm { const bf16_t* A; const bf16_t* Bt; int M, N, K, lda, ldb; };

struct StaticOrder {
    int nM, nN, nwg, G, c;
    __host__ __device__ void init(int M, int N, int G_, int c_) { nM = M / BM; nN = N / BM; nwg = nM * nN; G = G_; c = c_; }
    __host__ __device__ bool next(int i, Unit& u) const {
        const long L = (long)i * G + c; if (L >= nwg) return false;
        int wgid = (int)L; { const int q = nwg / NXCD, r = nwg % NXCD, xcd = wgid % NXCD, off = wgid / NXCD; wgid = (xcd < r ? xcd * (q + 1) : r * (q + 1) + (xcd - r) * q) + off; }
        const int nig = WGM * nN, gid = wgid / nig, fm = gid * WGM, gsz = (nM - fm) < WGM ? (nM - fm) : WGM;
        u.pm = fm + ((wgid % nig) % gsz); u.pn = (wgid % nig) / gsz; return true;
    }
    __device__ __forceinline__ void a_ready(const Unit&) const {}
    __device__ __forceinline__ void done(const Unit&) const {}
};

__device__ __forceinline__ unsigned cvt_pk_bf16(float lo, float hi) { unsigned r; asm volatile("v_cvt_pk_bf16_f32 %0, %1, %2" : "=v"(r) : "v"(lo), "v"(hi)); return r; }
typedef float f32x2 __attribute__((ext_vector_type(2)));
__device__ __forceinline__ f32x2 gelu_pk(f32x2 v) {
    const f32x2 av = __builtin_elementwise_abs(v), d = av * 0.2316418882f + 1.0f;
    f32x2 t; t.x = __builtin_amdgcn_rcpf(d.x); t.y = __builtin_amdgcn_rcpf(d.y);
    f32x2 q = t * 0.5307027145f + (-0.7265760135f); q = q * t + 0.7107068705f; q = q * t + (-0.142248368f); q = q * t + 0.127414796f; q = q * t;
    const f32x2 s = (v * v) * (-0.72134752044f);
    f32x2 e; e.x = __builtin_amdgcn_exp2f(s.x); e.y = __builtin_amdgcn_exp2f(s.y);
    const f32x2 m = v * (q * e), r = v - m;
    f32x2 o; o.x = v.x < 0.f ? m.x : r.x; o.y = v.y < 0.f ? m.y : r.y; return o;
}

template <int ACT  > struct EpiBf16 {
    static constexpr bool PERM = true, AFTER_DRAIN = false; static_assert(ACT == 0 || ACT == 1, "EpiBf16: ACT is 0 (none) or 1 (gelu_pk)");
    bf16_t* O; int ldc; const float* bias; int split_cols; size_t split_stride; float scale0;
    __device__ __forceinline__ void operator()(const f32x4 (&acc)[2][2][4][2], const Unit& u, int wr, int wc, int fr, int fq) const {
        const int row0 = u.pm * BM + wr * 64 + fr; int colt = u.pn * BM; bf16_t* base = O;
        float sc = 1.f; if (split_cols) { const int t = colt / split_cols; base += (size_t)t * split_stride; colt -= t * split_cols; if (t == 0) sc = scale0; }
        const int col0 = colt + wc * 32 + 8 * fq, bcol0 = u.pn * BM + wc * 32 + 8 * fq;
        f32x4 bv[2][2];
#pragma unroll
        for (int bj = 0; bj < 2; ++bj)
#pragma unroll
            for (int n = 0; n < 2; ++n) bv[bj][n] = bias ? *(const f32x4*)(bias + bcol0 + bj * HALF + 4 * n) : (f32x4){0.f, 0.f, 0.f, 0.f};
#pragma unroll
        for (int ai = 0; ai < 2; ++ai)
#pragma unroll
            for (int m = 0; m < 4; ++m) { bf16_t* rowp = base + (size_t)(row0 + ai * HALF + m * 16) * ldc + col0;
#pragma unroll
                for (int bj = 0; bj < 2; ++bj) { f32x4 v0 = acc[ai][bj][m][0] + bv[bj][0], v1 = acc[ai][bj][m][1] + bv[bj][1];
                    if (ACT == 1) { f32x2 a = gelu_pk((f32x2){v0[0], v0[1]}), b = gelu_pk((f32x2){v0[2], v0[3]}), c = gelu_pk((f32x2){v1[0], v1[1]}), d = gelu_pk((f32x2){v1[2], v1[3]});
                        v0 = (f32x4){a.x, a.y, b.x, b.y}; v1 = (f32x4){c.x, c.y, d.x, d.y}; }
                    v0 = v0 * sc; v1 = v1 * sc; u32x4 w; w.x = cvt_pk_bf16(v0[0], v0[1]); w.y = cvt_pk_bf16(v0[2], v0[3]); w.z = cvt_pk_bf16(v1[0], v1[1]); w.w = cvt_pk_bf16(v1[2], v1[3]);
                    *(u32x4*)(rowp + bj * HALF) = w; } }
    }
};
template <class Epi, class Sched, bool ALIGN_EPI = false, bool SP2 = false>
__device__ __forceinline__ void gemm_phase(PG8_LAS unsigned char* lds, const Gemm g, const Sched& S, const Epi& E) {
    int tid_ = threadIdx.x; asm volatile("" : "+v"(tid_)); const int tid = tid_, wid = __builtin_amdgcn_readfirstlane(tid >> 6), lane = tid & 63, wr = wid >> 2, wc = wid & 3, fr = lane & 15, fq = lane >> 4;
    const int K = g.K, nt = K / BK;
    unsigned voffA[2], voffB[2];
#pragma unroll
    for (int i = 0; i < 2; ++i) { int R, C; stage_rc(tid * 16 + i * 8192, R, C); const int Rb = Epi::PERM ? ((R & ~31) + perm32(R & 31)) : R;
        voffA[i] = (unsigned)(R * g.lda + C) * 2u; voffB[i] = (unsigned)(Rb * g.ldb + C) * 2u; }
    const size_t kstep = (size_t)(BK * 2);
    const size_t hstepA = (size_t)HALF * g.lda * 2, hstepB = (size_t)HALF * g.ldb * 2;
    const size_t tstepA = 2 * hstepA, tstepB = 2 * hstepB;
    const unsigned ldsw = (unsigned)wid * 1024u;
    const int aoff = lds_byte(wr * 64 + fr, fq * 8), boff = lds_byte(wc * 32 + fr, fq * 8);
#define PG8_SA(b, h) (((b) * 2 + (h)) * HTB)
#define PG8_SB(b, h) ((4 + (b) * 2 + (h)) * HTB)
#define PG8_STAGE(bufoff, gbase, voff) do { _Pragma("unroll") for (int _i = 0; _i < 2; ++_i) \
        __builtin_amdgcn_global_load_lds((const unsigned*)((const char*)(gbase) + (voff)[_i]), (PG8_LAS unsigned*)(lds + (bufoff) + ldsw + _i * 8192), 16, 0, 0); } while (0)
#define PG8_LDA(dst, b, h) do { _Pragma("unroll") for (int m = 0; m < 4; ++m) _Pragma("unroll") for (int k = 0; k < 2; ++k) dst[m][k] = *(const PG8_LAS bf16x8*)(lds + PG8_SA(b, h) + aoff + m * 2048 + k * 1024); } while (0)
#define PG8_LDB(dst, b, h) do { _Pragma("unroll") for (int n = 0; n < 2; ++n) _Pragma("unroll") for (int k = 0; k < 2; ++k) dst[n][k] = *(const PG8_LAS bf16x8*)(lds + PG8_SB(b, h) + boff + n * 2048 + k * 1024); } while (0)
#define PG8_MMA(ai, bj, At, Bt) do { __builtin_amdgcn_s_setprio(1); _Pragma("unroll") for (int m = 0; m < 4; ++m) _Pragma("unroll") for (int n = 0; n < 2; ++n) _Pragma("unroll") for (int k = 0; k < 2; ++k) \
        acc[ai][bj][m][n] = __builtin_amdgcn_mfma_f32_16x16x32_bf16(Bt[n][k], At[m][k], acc[ai][bj][m][n], 0, 0, 0); __builtin_amdgcn_s_setprio(0); } while (0)
#define PG8_WAIT_V(n) asm volatile("s_waitcnt vmcnt(" #n ")" ::: "memory")
#define PG8_WAIT_L(n) asm volatile("s_waitcnt lgkmcnt(" #n ")" ::: "memory")
#define PG8_BAR __builtin_amdgcn_s_barrier()
#define PG8_SCHED __builtin_amdgcn_sched_barrier(0)
    Unit cur, nxt; int ui = 0;
    if (!S.next(0, cur)) return;
    f32x4 acc[2][2][4][2];
#pragma unroll
    for (int a = 0; a < 2; ++a)
#pragma unroll
        for (int b = 0; b < 2; ++b)
#pragma unroll
            for (int m = 0; m < 4; ++m)
#pragma unroll
                for (int n = 0; n < 2; ++n) acc[a][b][m][n] = (f32x4){0.f, 0.f, 0.f, 0.f};
    bf16x8 At[4][2], B0[2][2], B1[2][2];
    const char* cA = (const char*)g.A + (size_t)cur.pm * tstepA; const char* cB = (const char*)g.Bt + (size_t)cur.pn * tstepB;
    S.a_ready(cur);
    if constexpr (SP2) {
        PG8_STAGE(PG8_SB(0, 0), cB, voffB); PG8_STAGE(PG8_SB(0, 1), cB + hstepB, voffB); PG8_STAGE(PG8_SA(0, 0), cA, voffA); PG8_STAGE(PG8_SA(0, 1), cA + hstepA, voffA);
        if (wr == 1) PG8_BAR;
        PG8_WAIT_V(2); PG8_BAR;
        PG8_STAGE(PG8_SB(1, 0), cB + kstep, voffB); PG8_STAGE(PG8_SA(1, 0), cA + kstep, voffA); PG8_STAGE(PG8_SB(1, 1), cB + hstepB + kstep, voffB);
        PG8_WAIT_V(6); PG8_BAR;
    } else {
        PG8_STAGE(PG8_SB(0, 0), cB, voffB); PG8_STAGE(PG8_SA(0, 0), cA, voffA); PG8_STAGE(PG8_SB(0, 1), cB + hstepB, voffB); PG8_STAGE(PG8_SA(0, 1), cA + hstepA, voffA);
        if (wr == 1) PG8_BAR;
        PG8_WAIT_V(4); PG8_BAR;
        PG8_STAGE(PG8_SB(1, 0), cB + kstep, voffB); PG8_STAGE(PG8_SA(1, 0), cA + kstep, voffA); PG8_STAGE(PG8_SB(1, 1), cB + hstepB + kstep, voffB);
        PG8_WAIT_V(6); PG8_BAR;
    }
    for (;;) {
        const bool has_next = S.next(ui + 1, nxt);
        E.pre(lds + STAGE_BYTES, cur, wr, fr, wid);
        const char* nA = has_next ? (const char*)g.A + (size_t)nxt.pm * tstepA : cA; const char* nB = has_next ? (const char*)g.Bt + (size_t)nxt.pn * tstepB : cB;
        for (int t = 0; t < nt; t += 2) {
            const bool last = (t == nt - 2);
            const char* a1 = cA + (size_t)(t + 1) * kstep;
            const char* a2 = last ? nA : cA + (size_t)(t + 2) * kstep; const char* b2 = last ? nB : cB + (size_t)(t + 2) * kstep;
            const char* a3 = a2 + kstep; const char* b3 = b2 + kstep;
            if (last && has_next) S.a_ready(nxt);
            if constexpr (SP2) {
            PG8_LDB(B0, 0, 0); PG8_LDB(B1, 0, 1); PG8_SCHED; PG8_LDA(At, 0, 0); PG8_STAGE(PG8_SA(1, 1), a1 + hstepA, voffA);
            PG8_WAIT_V(8); PG8_WAIT_L(0); PG8_BAR; PG8_MMA(0, 0, At, B0); PG8_MMA(0, 1, At, B1); PG8_BAR; PG8_SCHED;
            PG8_LDA(At, 0, 1); PG8_STAGE(PG8_SB(0, 0), b2, voffB); PG8_STAGE(PG8_SB(0, 1), b2 + hstepB, voffB); PG8_STAGE(PG8_SA(0, 0), a2, voffA);
            PG8_WAIT_V(8); PG8_WAIT_L(0); PG8_BAR; PG8_MMA(1, 0, At, B0); PG8_MMA(1, 1, At, B1); PG8_BAR; PG8_SCHED;
            PG8_LDB(B0, 1, 0); PG8_LDB(B1, 1, 1); PG8_SCHED; PG8_LDA(At, 1, 0); PG8_STAGE(PG8_SA(0, 1), a2 + hstepA, voffA);
            PG8_WAIT_V(8); PG8_WAIT_L(0); PG8_BAR; PG8_MMA(0, 0, At, B0); PG8_MMA(0, 1, At, B1); PG8_BAR; PG8_SCHED;
            PG8_LDA(At, 1, 1); PG8_STAGE(PG8_SB(1, 0), b3, voffB); PG8_STAGE(PG8_SB(1, 1), b3 + hstepB, voffB); PG8_STAGE(PG8_SA(1, 0), a3, voffA);
            PG8_WAIT_V(8); PG8_WAIT_L(0); PG8_BAR; PG8_MMA(1, 0, At, B0); PG8_MMA(1, 1, At, B1); PG8_BAR; PG8_SCHED;
            } else {
            PG8_LDB(B0, 0, 0); PG8_SCHED; PG8_LDA(At, 0, 0); PG8_STAGE(PG8_SA(1, 1), a1 + hstepA, voffA);
            PG8_WAIT_L(8); PG8_BAR; PG8_WAIT_L(0); PG8_MMA(0, 0, At, B0); PG8_BAR; PG8_SCHED;
            PG8_LDB(B1, 0, 1); PG8_STAGE(PG8_SB(0, 0), b2, voffB);
            PG8_BAR; PG8_WAIT_L(0); PG8_MMA(0, 1, At, B1); PG8_BAR;
            PG8_LDA(At, 0, 1); PG8_STAGE(PG8_SA(0, 0), a2, voffA);
            PG8_BAR; PG8_WAIT_L(0); PG8_MMA(1, 0, At, B0); PG8_BAR; PG8_SCHED;
            PG8_STAGE(PG8_SB(0, 1), b2 + hstepB, voffB);
            PG8_WAIT_V(6); PG8_BAR; PG8_MMA(1, 1, At, B1); PG8_BAR;
            PG8_LDB(B0, 1, 0); PG8_SCHED; PG8_LDA(At, 1, 0); PG8_STAGE(PG8_SA(0, 1), a2 + hstepA, voffA);
            PG8_WAIT_L(8); PG8_BAR; PG8_WAIT_L(0); PG8_MMA(0, 0, At, B0); PG8_BAR; PG8_SCHED;
            PG8_LDB(B1, 1, 1); PG8_STAGE(PG8_SB(1, 0), b3, voffB);
            PG8_BAR; PG8_WAIT_L(0); PG8_MMA(0, 1, At, B1); PG8_BAR;
            PG8_LDA(At, 1, 1); PG8_STAGE(PG8_SA(1, 0), a3, voffA);
            PG8_BAR; PG8_WAIT_L(0); PG8_MMA(1, 0, At, B0); PG8_BAR; PG8_SCHED;
            PG8_STAGE(PG8_SB(1, 1), b3 + hstepB, voffB);
            PG8_WAIT_V(6); PG8_BAR; PG8_MMA(1, 1, At, B1); PG8_BAR;
            }
        }
        if constexpr (ALIGN_EPI) { if (wr == 0) PG8_BAR; }
        if constexpr (!Epi::AFTER_DRAIN) { E(acc, cur, wr, wc, fr, fq, lds + STAGE_BYTES, wid, lane); S.done(cur); }
        if (!has_next) break;
#pragma unroll
        for (int a = 0; a < 2; ++a)
#pragma unroll
            for (int b = 0; b < 2; ++b)
#pragma unroll
                for (int m = 0; m < 4; ++m)
#pragma unroll
                    for (int n = 0; n < 2; ++n) acc[a][b][m][n] = (f32x4){0.f, 0.f, 0.f, 0.f};
        cur = nxt; cA = nA; cB = nB; ++ui;
        if constexpr (ALIGN_EPI) { if (wr == 1) PG8_BAR; }
    }
    PG8_WAIT_V(0);
    if constexpr (!ALIGN_EPI) { if (wr == 0) PG8_BAR; }
    PG8_BAR;
    if constexpr (Epi::AFTER_DRAIN) { E.fused(acc, cur, wr, wc, fr, fq, lds, wid, lane); S.done(cur); }
#undef PG8_SA
#undef PG8_SB
#undef PG8_STAGE
#undef PG8_LDA
#undef PG8_LDB
#undef PG8_MMA
#undef PG8_WAIT_V
#undef PG8_WAIT_L
#undef PG8_BAR
#undef PG8_SCHED
}
}
namespace pg8 {
constexpr float NORM_EPS_ = 1e-6f;
__device__ __forceinline__ void stat_dma(PG8_LAS unsigned char* spare, const unsigned* ss, const Unit& u, int wr, int fr, int wid) {
#pragma unroll
    for (int k = 0; k < 8; ++k)
        __builtin_amdgcn_global_load_lds(ss + (u.pm * BM + wr * 64 + fr + (k >> 2) * HALF + (k & 3) * 16), (PG8_LAS unsigned*)(spare + wid * 2048 + k * 256), 4, 0, 0);
}
__device__ __forceinline__ float stat_rstd(PG8_LAS unsigned char* spare, int wid, int lane, int k) {
    const unsigned v = *(const PG8_LAS unsigned*)(spare + wid * 2048 + k * 256 + lane * 4);
    return 1.0f / sqrtf((float)v * (1.f / (1024.f * 2048.f)) + NORM_EPS_);
}
template <int ACT  > struct EpiB {
    static constexpr bool PERM = true, AFTER_DRAIN = false;
    bf16_t* O; int ldc; const unsigned* ss;
    __device__ __forceinline__ void pre(PG8_LAS unsigned char* spare, const Unit& u, int wr, int fr, int wid) const { if (ss) stat_dma(spare, ss, u, wr, fr, wid); }
    __device__ __forceinline__ void operator()(const f32x4 (&acc)[2][2][4][2], const Unit& u, int wr, int wc, int fr, int fq, PG8_LAS unsigned char* spare, int wid, int lane) const {
        const int row0 = u.pm * BM + wr * 64 + fr, col0 = u.pn * BM + wc * 32 + 8 * fq;
#pragma unroll
        for (int ai = 0; ai < 2; ++ai)
#pragma unroll
            for (int m = 0; m < 4; ++m) { const int row = row0 + ai * HALF + m * 16; bf16_t* rowp = O + (size_t)row * ldc + col0;
                const float rs = ss ? stat_rstd(spare, wid, lane, ai * 4 + m) : 1.f;
#pragma unroll
                for (int bj = 0; bj < 2; ++bj) { f32x4 v0 = acc[ai][bj][m][0] * rs, v1 = acc[ai][bj][m][1] * rs;
                    if (ACT == 2) {
#pragma unroll
                        for (int e = 0; e < 4; ++e) { float a = v0[e] > 0.f ? v0[e] : 0.f; v0[e] = a * a; float b = v1[e] > 0.f ? v1[e] : 0.f; v1[e] = b * b; } }
                    u32x4 w; w.x = cvt_pk_bf16(v0[0], v0[1]); w.y = cvt_pk_bf16(v0[2], v0[3]); w.z = cvt_pk_bf16(v1[0], v1[1]); w.w = cvt_pk_bf16(v1[2], v1[3]);
                    *(u32x4*)(rowp + bj * HALF) = w; } }
    }
};
template <int MODE> struct EpiH {
    static constexpr bool PERM = true, AFTER_DRAIN = false;
    const float* base_f; const bf16_t* hb_in; float* out; const float* cscale; int col_off; const bf16_t* pp; const unsigned* ss_in; bf16_t* hb; unsigned* ss_out;
    __device__ __forceinline__ void pre(PG8_LAS unsigned char* spare, const Unit& u, int wr, int fr, int wid) const { if (ss_in) stat_dma(spare, ss_in, u, wr, fr, wid); }
    __device__ __forceinline__ void operator()(const f32x4 (&acc)[2][2][4][2], const Unit& u, int wr, int wc, int fr, int fq, PG8_LAS unsigned char* spare, int wid, int lane) const {
        const int row0 = u.pm * BM + wr * 64 + fr, col0 = col_off + u.pn * BM + wc * 32 + 8 * fq;
        unsigned sqv[8];
#pragma unroll
        for (int ai = 0; ai < 2; ++ai)
#pragma unroll
            for (int mp = 0; mp < 2; ++mp) {
                f32x4 bv[2][2][2]; u32x4 pw[2][2]; float rs[2] = {1.f, 1.f};
#pragma unroll
                for (int mm = 0; mm < 2; ++mm) { const int row = row0 + ai * HALF + (2 * mp + mm) * 16; const size_t ro = (size_t)row * 2048;
                    if (ss_in) { const float r_ = stat_rstd(spare, wid, lane, ai * 4 + 2 * mp + mm); rs[mm] = (MODE == 0) ? r_ * r_ : r_; }
#pragma unroll
                    for (int bj = 0; bj < 2; ++bj) { const int c = col0 + bj * HALF;
                        if (base_f) { bv[mm][bj][0] = *(const f32x4*)(base_f + ro + c); bv[mm][bj][1] = *(const f32x4*)(base_f + ro + c + 4); }
                        else { const u32x4 w = *(const u32x4*)(hb_in + ro + c);
                            bv[mm][bj][0] = (f32x4){__uint_as_float(w.x << 16), __uint_as_float(w.x & 0xffff0000u), __uint_as_float(w.y << 16), __uint_as_float(w.y & 0xffff0000u)};
                            bv[mm][bj][1] = (f32x4){__uint_as_float(w.z << 16), __uint_as_float(w.z & 0xffff0000u), __uint_as_float(w.w << 16), __uint_as_float(w.w & 0xffff0000u)}; }
                        pw[mm][bj] = (MODE == 1) ? *(const u32x4*)(pp + ro + c) : (u32x4){0u, 0u, 0u, 0u}; } }
#pragma unroll
                for (int mm = 0; mm < 2; ++mm) { const int m = 2 * mp + mm; const int row = row0 + ai * HALF + m * 16; const size_t ro = (size_t)row * 2048;
                    float sq = 0.f;
#pragma unroll
                    for (int bj = 0; bj < 2; ++bj) { const int c = col0 + bj * HALF; f32x4 v0 = acc[ai][bj][m][0], v1 = acc[ai][bj][m][1];
                        if (MODE == 0) { if (cscale) { v0 = v0 * *(const f32x4*)(cscale + c); v1 = v1 * *(const f32x4*)(cscale + c + 4); } v0 = v0 * rs[mm]; v1 = v1 * rs[mm]; }
                        else { const u32x4 w = pw[mm][bj];
                            const f32x4 p0 = {__uint_as_float(w.x << 16), __uint_as_float(w.x & 0xffff0000u), __uint_as_float(w.y << 16), __uint_as_float(w.y & 0xffff0000u)};
                            const f32x4 p1 = {__uint_as_float(w.z << 16), __uint_as_float(w.z & 0xffff0000u), __uint_as_float(w.w << 16), __uint_as_float(w.w & 0xffff0000u)};
#pragma unroll
                            for (int e = 0; e < 4; ++e) { v0[e] = p0[e] / (1.f + __expf(-v0[e] * rs[mm])); v1[e] = p1[e] / (1.f + __expf(-v1[e] * rs[mm])); } }
                        const f32x4 h0 = bv[mm][bj][0] + v0, h1 = bv[mm][bj][1] + v1;
                        if (out) { *(f32x4*)(out + ro + c) = h0; *(f32x4*)(out + ro + c + 4) = h1; }
                        if (hb) { u32x4 w2; w2.x = cvt_pk_bf16(h0[0], h0[1]); w2.y = cvt_pk_bf16(h0[2], h0[3]); w2.z = cvt_pk_bf16(h1[0], h1[1]); w2.w = cvt_pk_bf16(h1[2], h1[3]); *(u32x4*)(hb + ro + c) = w2;
                            const float r0 = __uint_as_float(w2.x << 16), r1 = __uint_as_float(w2.x & 0xffff0000u), r2 = __uint_as_float(w2.y << 16), r3 = __uint_as_float(w2.y & 0xffff0000u);
                            const float r4 = __uint_as_float(w2.z << 16), r5 = __uint_as_float(w2.z & 0xffff0000u), r6 = __uint_as_float(w2.w << 16), r7 = __uint_as_float(w2.w & 0xffff0000u);
                            sq += ((r0 * r0 + r1 * r1) + (r2 * r2 + r3 * r3)) + ((r4 * r4 + r5 * r5) + (r6 * r6 + r7 * r7)); } }
                    sq += __shfl_xor(sq, 16); sq += __shfl_xor(sq, 32); sqv[ai * 4 + m] = __float2uint_rn(sq * 1024.f);
                }
            }
        if (ss_out) {
#pragma unroll
            for (int j = 0; j < 2; ++j) { const unsigned v = fq == 0 ? sqv[4 * j] : (fq == 1 ? sqv[4 * j + 1] : (fq == 2 ? sqv[4 * j + 2] : sqv[4 * j + 3]));
                atomicAdd(ss_out + row0 + j * HALF + fq * 16, v); }
        }
    }
};
}
using pg8::bf16_t; using pg8::bf16x8; using pg8::f32x4; using pg8::u32x4;
typedef float f32x16 __attribute__((ext_vector_type(16)));
typedef short s16x4 __attribute__((ext_vector_type(4)));
typedef unsigned u32x2 __attribute__((ext_vector_type(2)));
#define LAS __attribute__((address_space(3)))
constexpr int NB = 2, S = 4096, T = NB * S, D = 2048, FF = 8192, NH = 16, HD = 128;
constexpr int NQ_LD = 5376, MQ_LD = 6144;
constexpr float EPS = 1e-6f;
constexpr size_t MiB = 1u << 20;
constexpr size_t WS_W1T = 0, WS_W2T = 128 * MiB, WS_PGT = 256 * MiB, WS_PPT = 288 * MiB, WS_MQKV = 292 * MiB, WS_MWO = 316 * MiB, WS_POOL = 324 * MiB,
                 WS_NQKV = 326 * MiB, WS_NWO = 347 * MiB, WS_CW1 = 355 * MiB, WS_CIN = 357 * MiB, WS_CWO = 381 * MiB, WS_PB = 389 * MiB, WS_XN = 405 * MiB,
                 WS_OB = 437 * MiB, WS_PP = 469 * MiB, WS_BIG = 501 * MiB, WS_KMEAN = 629 * MiB, WS_KC = 630 * MiB, WS_VC = 631 * MiB, WS_CTL = 632 * MiB, WS_SS = 632 * MiB + 65536, WS_HB1 = 633 * MiB, WS_SSP = 665 * MiB, WS_END = 678 * MiB;
constexpr int LDS_BYTES = 155648;
constexpr int NWAVES = 8, NTHREADS = 512;

struct Params { const void* in[29]; float* out; unsigned char* ws; };

__device__ __forceinline__ float bflo(unsigned w) { return __uint_as_float(w << 16); }
__device__ __forceinline__ float bfhi(unsigned w) { return __uint_as_float(w & 0xffff0000u); }
__device__ __forceinline__ float bf1(bf16_t b) { return __uint_as_float((unsigned)b << 16); }
__device__ __forceinline__ unsigned pk2(float lo, float hi) { return pg8::cvt_pk_bf16(lo, hi); }
__device__ __forceinline__ bf16_t f2bf1(float f) { return (bf16_t)(pk2(f, 0.f) & 0xffffu); }
__device__ __forceinline__ float wave_sum(float v) {
#pragma unroll
    for (int o = 1; o < 64; o <<= 1) v += __shfl_xor(v, o);
    return v;
}
__device__ __forceinline__ bf16x8 pack8(f32x4 a, f32x4 b) { u32x4 w = {pk2(a[0], a[1]), pk2(a[2], a[3]), pk2(b[0], b[1]), pk2(b[2], b[3])}; return __builtin_bit_cast(bf16x8, w); }
__device__ __forceinline__ float sigmoidf_(float x) { return 1.f / (1.f + __expf(-x)); }

struct CJob { const float* W; bf16_t* WT; const float* gain; int K, N, row_off, item; };
__device__ __forceinline__ void tr_load(const CJob& J, int lane, float (&tv)[32]) {
    const int nblk = J.N / 32, kb = J.item / nblk, nb = J.item % nblk, k0 = 64 * kb, n0 = 32 * nb;
#pragma unroll
    for (int i = 0; i < 32; ++i) { const int kk = 2 * i + (lane >> 5); tv[i] = __builtin_nontemporal_load(J.W + (size_t)(k0 + kk) * J.N + n0 + (lane & 31)); }
}
__device__ __forceinline__ void tr_store(const CJob& J, int lane, const float (&tv)[32], float* scr) {
    const int nblk = J.N / 32, kb = J.item / nblk, nb = J.item % nblk, k0 = 64 * kb, n0 = 32 * nb;
#pragma unroll
    for (int i = 0; i < 32; ++i) { const int kk = 2 * i + (lane >> 5); scr[kk * 33 + (lane & 31)] = J.gain ? tv[i] * J.gain[k0 + kk] : tv[i]; }
    asm volatile("s_waitcnt lgkmcnt(0)" ::: "memory");
    const int c = lane & 7;
#pragma unroll
    for (int j = 0; j < 4; ++j) { const int n = (lane >> 3) + 8 * j; const float* s = scr + (8 * c) * 33 + n;
        u32x4 o; o.x = pk2(s[0 * 33], s[1 * 33]); o.y = pk2(s[2 * 33], s[3 * 33]); o.z = pk2(s[4 * 33], s[5 * 33]); o.w = pk2(s[6 * 33], s[7 * 33]);
        *(u32x4*)(J.WT + (size_t)(J.row_off + n0 + n) * J.K + k0 + 8 * c) = o; }
    asm volatile("s_waitcnt lgkmcnt(0)" ::: "memory");
}
#define CJOB(src, Kk, Nn, dst, roff, gn) if (!found) { const int ni_ = ((Kk) / 64) * ((Nn) / 32); if (r < ni_) { J.W = (const float*)(src); J.WT = (bf16_t*)(dst); J.gain = (const float*)(gn); J.K = (Kk); J.N = (Nn); J.row_off = (roff); J.item = r; found = true; } else r -= ni_; }
#define CJOB_LAYER(i) CJOB((const float*)P.in[5] + (size_t)(i) * D * FF, D, FF, ws + WS_W1T + (size_t)(i) * 32 * MiB, 0, (const float*)P.in[4] + (size_t)(i) * D) \
                      CJOB((const float*)P.in[6] + (size_t)(i) * D * FF, FF, D, ws + WS_W2T + (size_t)(i) * 32 * MiB, 0, nullptr) \
                      CJOB((const float*)P.in[8] + (size_t)(i) * D * D, D, D, ws + WS_PGT + (size_t)(i) * 8 * MiB, 0, (const float*)P.in[7] + (size_t)(i) * D) \
                      CJOB((const float*)P.in[9] + (size_t)(i) * 256 * D, 256, D, ws + WS_PPT + (size_t)(i) * 1 * MiB, 0, nullptr)
constexpr int NITEMS_CONV = 4 * (8192 + 8192 + 2048 + 256) + 6144 + 2048 + 4 * 128 + 2048 + 3072 + 2048 + 2 * 256 + 6144 + 2048;
__device__ __forceinline__ CJob conv_resolve(const Params& P, int it) {
    unsigned char* ws = P.ws; CJob J; J.W = nullptr; J.WT = nullptr; J.gain = nullptr; J.K = 64; J.N = 32; J.row_off = 0; J.item = 0;
    int r = it; bool found = false;
    CJOB_LAYER(0) CJOB_LAYER(1) CJOB_LAYER(2) CJOB_LAYER(3)
    CJOB(P.in[10], D, 3 * D, ws + WS_MQKV, 0, (const float*)P.in[3])
    CJOB(P.in[13], D, D, ws + WS_MWO, 0, nullptr)
    CJOB((const float*)P.in[14] + 0 * 512 * 512, 512, 512, ws + WS_POOL + 0 * 512 * 512 * 2, 0, nullptr)
    CJOB((const float*)P.in[14] + 1 * 512 * 512, 512, 512, ws + WS_POOL + 1 * 512 * 512 * 2, 0, nullptr)
    CJOB((const float*)P.in[14] + 2 * 512 * 512, 512, 512, ws + WS_POOL + 2 * 512 * 512 * 2, 0, nullptr)
    CJOB((const float*)P.in[14] + 3 * 512 * 512, 512, 512, ws + WS_POOL + 3 * 512 * 512 * 2, 0, nullptr)
    CJOB(P.in[16], D, D, ws + WS_NQKV, 0, (const float*)P.in[3] + 2 * D)
    CJOB(P.in[17], D, 3072, ws + WS_NQKV, 2048, (const float*)P.in[3] + 2 * D)
    CJOB(P.in[24], D, D, ws + WS_NWO, 0, nullptr)
    CJOB((const float*)P.in[21] + 0 * 4096 * 128, 4096, 128, ws + WS_CW1 + 0 * 128 * 4096 * 2, 0, nullptr)
    CJOB((const float*)P.in[21] + 1 * 4096 * 128, 4096, 128, ws + WS_CW1 + 1 * 128 * 4096 * 2, 0, nullptr)
    CJOB(P.in[25], D, 3 * D, ws + WS_CIN, 0, (const float*)P.in[3] + 3 * D)
    CJOB(P.in[28], D, D, ws + WS_CWO, 0, nullptr)
    return J;
}
__device__ __forceinline__ void phase_convert(const Params& P, char* lds, int gw, int NGW, int gtid, int NT, int wid, int lane) {
    asm volatile("" : "+v"(lane));
    unsigned char* ws = P.ws;
    float* scr = (float*)(lds + wid * 17408);
    for (int it = 2 * gw; it < NITEMS_CONV; it += 2 * NGW) {
        const CJob J0 = conv_resolve(P, it); const bool two = (it + 1 < NITEMS_CONV); const CJob J1 = conv_resolve(P, two ? it + 1 : it);
        float tv0[32], tv1[32];
        tr_load(J0, lane, tv0); tr_load(J1, lane, tv1);
        tr_store(J0, lane, tv0, scr);
        if (two) tr_store(J1, lane, tv1, scr);
    }
    { const float* Wg = (const float*)P.in[23]; bf16_t* dst = (bf16_t*)(ws + WS_NQKV) + (size_t)5120 * D;
      for (int idx = gtid; idx < 256 * D; idx += NT) { const int n = idx >> 11, k = idx & 2047; dst[idx] = (n < 48) ? f2bf1(Wg[(size_t)k * 48 + n] * ((const float*)P.in[3])[2 * D + k]) : (bf16_t)0; } }
    { const float* x = (const float*)P.in[0]; bf16_t* hb = (bf16_t*)(ws + WS_XN); unsigned* ss0 = (unsigned*)(ws + WS_SS);
      for (int m = gw; m < T; m += NGW) {
          const f32x4* xr = (const f32x4*)(x + (size_t)m * D) + lane; u32x2* o8 = (u32x2*)(hb + (size_t)m * D) + lane; float s = 0.f;
#pragma unroll
          for (int j = 0; j < 8; ++j) { const f32x4 v = xr[64 * j]; s += (v[0] * v[0] + v[1] * v[1]) + (v[2] * v[2] + v[3] * v[3]); u32x2 o; o.x = pk2(v[0], v[1]); o.y = pk2(v[2], v[3]); o8[64 * j] = o; }
          s = wave_sum(s); if (lane == 0) ss0[m] = __float2uint_rn(s * 1024.f); } }
    { const f32x4* ps = (const f32x4*)P.in[1]; u32x2* pd = (u32x2*)(ws + WS_PB);
      for (int idx = gtid; idx < 4 * T * 256 / 4; idx += NT) { const f32x4 v = ps[idx]; u32x2 o; o.x = pk2(v[0], v[1]); o.y = pk2(v[2], v[3]); pd[idx] = o; } }
}

__device__ __forceinline__ void phase_rms(const float* src, const float* gain, bf16_t* dst, int gw, int NGW, int lane) {
    asm volatile("" : "+v"(lane));
    for (int m = gw; m < T; m += NGW) {
        const f32x4* xr = (const f32x4*)(src + (size_t)m * D) + lane;
        f32x4 v[8]; float s = 0.f;
#pragma unroll
        for (int j = 0; j < 8; ++j) { v[j] = xr[64 * j]; s += (v[j][0] * v[j][0] + v[j][1] * v[j][1]) + (v[j][2] * v[j][2] + v[j][3] * v[j][3]); }
        const float rstd = 1.0f / sqrtf(wave_sum(s) * (1.f / D) + EPS);
        u32x2* o8 = (u32x2*)(dst + (size_t)m * D) + lane;
#pragma unroll
        for (int j = 0; j < 8; ++j) { const f32x4 g = ((const f32x4*)gain)[lane + 64 * j]; u32x2 o; o.x = pk2(v[j][0] * rstd * g[0], v[j][1] * rstd * g[1]); o.y = pk2(v[j][2] * rstd * g[2], v[j][3] * rstd * g[3]); o8[64 * j] = o; }
    }
}

template <class Epi>
__device__ __forceinline__ void gemm_run(char* lds, const bf16_t* A, int lda, const bf16_t* Bt, int ldb, int M, int N, int K, int G, int c, const Epi& E) {
    pg8::Gemm g{A, Bt, M, N, K, lda, ldb}; pg8::StaticOrder So; So.init(M, N, G, c);
    pg8::gemm_phase<Epi, pg8::StaticOrder, true, true>((PG8_LAS unsigned char*)lds, g, So, E);
}

__device__ __forceinline__ void rope_cs(int pos, int lane, float (&cs)[2], float (&sn)[2]) {
#pragma unroll
    for (int e = 0; e < 2; ++e) {
        const int i = 2 * (lane & 7) + e;
        const float freq = __builtin_amdgcn_exp2f(-(float)i * (18.931568569324174f / 16.0f));
        const float ang = (float)pos * freq;
        const double rev = (double)ang * 0.15915494309189535;
        const float fr = (float)(rev - floor(rev));
        cs[e] = __builtin_amdgcn_cosf(fr); sn[e] = __builtin_amdgcn_sinf(fr);
    }
}
__device__ __forceinline__ void head_norm_rope(unsigned w, const float* gain, int lane, const float (&cs)[2], const float (&sn)[2], float& n0, float& n1, float& r0, float& r1) {
    const float x0 = bflo(w), x1 = bfhi(w);
    const float ss = wave_sum(x0 * x0 + x1 * x1);
    const float rstd = 1.0f / sqrtf(ss * (1.f / HD) + EPS);
    n0 = x0 * rstd * gain[2 * lane]; n1 = x1 * rstd * gain[2 * lane + 1];
    const float p0 = __shfl_xor(n0, 8), p1 = __shfl_xor(n1, 8);
    r0 = n0; r1 = n1;
    if (lane < 8) { r0 = n0 * cs[0] - p0 * sn[0]; r1 = n1 * cs[1] - p1 * sn[1]; }
    else if (lane < 16) { r0 = n0 * cs[0] + p0 * sn[0]; r1 = n1 * cs[1] + p1 * sn[1]; }
}
__device__ __forceinline__ void phase_moba_prep(const Params& P, char* lds, int bid, int G, int tid, int wid, int lane) {
    asm volatile("" : "+v"(tid)); asm volatile("" : "+v"(lane));
    bf16_t* BIG = (bf16_t*)(P.ws + WS_BIG); float* KMEAN = (float*)(P.ws + WS_KMEAN);
    const int* pos = (const int*)P.in[2]; const float* qg = (const float*)P.in[11]; const float* kg = (const float*)P.in[12];
    float* red = (float*)(lds);
    const int sub = lane & 15, grp = lane >> 4;
    float qg8[8], kg8[8];
#pragma unroll
    for (int j = 0; j < 8; ++j) { qg8[j] = qg[8 * sub + j]; kg8[j] = kg[8 * sub + j]; }
    for (int u = bid; u < NB * 16 * NH; u += G) {
        const int h = u & 15, blk = (u >> 4) & 15, b = u >> 8;
        float ks[8];
#pragma unroll
        for (int j = 0; j < 8; ++j) ks[j] = 0.f;
        u32x4 qv[8], kv[8];
#pragma unroll
        for (int it = 0; it < 8; ++it) { const size_t row = (size_t)(b * S + blk * 256 + wid * 32 + it * 4 + grp);
            qv[it] = *(const u32x4*)(BIG + row * MQ_LD + h * HD + 8 * sub); kv[it] = *(const u32x4*)(BIG + row * MQ_LD + D + h * HD + 8 * sub); }
#pragma unroll
        for (int it = 0; it < 8; ++it) {
            const size_t row = (size_t)(b * S + blk * 256 + wid * 32 + it * 4 + grp);
            const int ps = pos[row];
            float cs[8], sn[8];
#pragma unroll
            for (int j = 0; j < 8; ++j) { const int i_ = 8 * (sub & 1) + j;
                const float freq = __builtin_amdgcn_exp2f(-(float)i_ * (18.931568569324174f / 16.0f));
                const float ang = (float)ps * freq; const double rev = (double)ang * 0.15915494309189535; const float fr_ = (float)(rev - floor(rev));
                cs[j] = __builtin_amdgcn_cosf(fr_); sn[j] = __builtin_amdgcn_sinf(fr_); }
#pragma unroll
            for (int which = 0; which < 2; ++which) {
                const u32x4 w = which ? kv[it] : qv[it];
                float x[8] = {bflo(w.x), bfhi(w.x), bflo(w.y), bfhi(w.y), bflo(w.z), bfhi(w.z), bflo(w.w), bfhi(w.w)};
                float ss = 0.f;
#pragma unroll
                for (int j = 0; j < 8; ++j) ss += x[j] * x[j];
                ss += __shfl_xor(ss, 1); ss += __shfl_xor(ss, 2); ss += __shfl_xor(ss, 4); ss += __shfl_xor(ss, 8);
                const float rstd = 1.0f / sqrtf(ss * (1.f / HD) + EPS);
                float y[8];
#pragma unroll
                for (int j = 0; j < 8; ++j) { y[j] = x[j] * rstd * (which ? kg8[j] : qg8[j]);
                    const float pr = __shfl_xor(y[j], 2);
                    const float rot = (sub < 2) ? (y[j] * cs[j] - pr * sn[j]) : (y[j] * cs[j] + pr * sn[j]);
                    y[j] = (sub < 4) ? rot : y[j]; }
                u32x4 ow = {pk2(y[0], y[1]), pk2(y[2], y[3]), pk2(y[4], y[5]), pk2(y[6], y[7])};
                *(u32x4*)(BIG + row * MQ_LD + (which ? D : 0) + h * HD + 8 * sub) = ow;
                if (which) {
#pragma unroll
                    for (int j = 0; j < 8; ++j) ks[j] += y[j]; }
            }
        }
#pragma unroll
        for (int j = 0; j < 8; ++j) { ks[j] += __shfl_xor(ks[j], 16); ks[j] += __shfl_xor(ks[j], 32); }
        if (grp == 0) {
#pragma unroll
            for (int j = 0; j < 8; ++j) red[wid * 128 + 8 * sub + j] = ks[j]; }
        __syncthreads();
        if (tid < 128) { float sm = 0.f;
#pragma unroll
            for (int w = 0; w < 8; ++w) sm += red[w * 128 + tid];
            KMEAN[(size_t)((b * NH + h) * 16 + blk) * HD + tid] = sm * (1.f / 256.f); }
        __syncthreads();
    }
}

__device__ __forceinline__ void phase_nsa_norm(const Params& P, int gw, int NGW, int lane) {
    asm volatile("" : "+v"(lane));
    bf16_t* BIG = (bf16_t*)(P.ws + WS_BIG);
    const int* pos = (const int*)P.in[2]; const float* qg = (const float*)P.in[18]; const float* kg = (const float*)P.in[19];
    const int sub = lane & 15, grp = lane >> 4;
    for (int row = gw; row < T; row += NGW) {
        bf16_t* base = BIG + (size_t)row * NQ_LD;
        u32x4 v[6];
#pragma unroll
        for (int st = 0; st < 6; ++st) { const int col = (st < 4) ? (st * 4 + grp) * HD : (D + (st == 4 ? 2 : 4) * 512 + grp * HD); v[st] = *(const u32x4*)(base + col + 8 * sub); }
        const int ps = pos[row];
        float cs[8], sn[8];
#pragma unroll
        for (int j = 0; j < 8; ++j) { const int i_ = 8 * (sub & 1) + j;
            const float freq = __builtin_amdgcn_exp2f(-(float)i_ * (18.931568569324174f / 16.0f));
            const float ang = (float)ps * freq; const double rev = (double)ang * 0.15915494309189535; const float fr_ = (float)(rev - floor(rev));
            cs[j] = __builtin_amdgcn_cosf(fr_); sn[j] = __builtin_amdgcn_sinf(fr_); }
#pragma unroll
        for (int st = 0; st < 6; ++st) {
            const int col = (st < 4) ? (st * 4 + grp) * HD : (D + (st == 4 ? 2 : 4) * 512 + grp * HD);
            const float* gn = (st < 4) ? qg : (st == 4 ? kg + 1 * HD : kg + 2 * HD);
            const u32x4 w = v[st];
            float x[8] = {bflo(w.x), bfhi(w.x), bflo(w.y), bfhi(w.y), bflo(w.z), bfhi(w.z), bflo(w.w), bfhi(w.w)};
            float ss = 0.f;
#pragma unroll
            for (int j = 0; j < 8; ++j) ss += x[j] * x[j];
            ss += __shfl_xor(ss, 1); ss += __shfl_xor(ss, 2); ss += __shfl_xor(ss, 4); ss += __shfl_xor(ss, 8);
            const float rstd = 1.0f / sqrtf(ss * (1.f / HD) + EPS);
            const f32x4 g0 = *(const f32x4*)(gn + 8 * sub), g1 = *(const f32x4*)(gn + 8 * sub + 4);
            float y[8];
#pragma unroll
            for (int j = 0; j < 8; ++j) { y[j] = x[j] * rstd * (j < 4 ? g0[j & 3] : g1[j & 3]);
                if (st >= 4) { const float pr = __shfl_xor(y[j], 2);
                    const float rot = (sub < 2) ? (y[j] * cs[j] - pr * sn[j]) : (y[j] * cs[j] + pr * sn[j]);
                    y[j] = (sub < 4) ? rot : y[j]; } }
            u32x4 ow = {pk2(y[0], y[1]), pk2(y[2], y[3]), pk2(y[4], y[5]), pk2(y[6], y[7])};
            *(u32x4*)(base + col + 8 * sub) = ow;
        }
    }
}

__device__ __forceinline__ void phase_nsa_compress(const Params& P, char* lds, int bid, int G, int tid, int wid, int lane) {
    asm volatile("" : "+v"(tid)); asm volatile("" : "+v"(lane));
    const bf16_t* BIG = (const bf16_t*)(P.ws + WS_BIG); const bf16_t* CW1 = (const bf16_t*)(P.ws + WS_CW1);
    const float* cpos = (const float*)P.in[20]; const float* w2 = (const float*)P.in[22]; const float* kg0 = (const float*)P.in[19];
    float* red = (float*)lds;
    float* h1s = (float*)(lds + 65536);
    const int fr = lane & 15, fq = lane >> 4;
    for (int u = bid; u < 256; u += G) {
        const int ng = u & 15, j = (u >> 4) & 1, g = (u >> 5) & 3, b = u >> 7;
        const int n = 16 * ng + fr;
        { const f32x4* w2g = (const f32x4*)(w2 + (size_t)j * 128 * 128); f32x4* w2s4 = (f32x4*)(lds + 73728);
#pragma unroll
          for (int i = 0; i < 8; ++i) w2s4[tid + 512 * i] = w2g[tid + 512 * i]; }
        f32x4 acc[8];
#pragma unroll
        for (int i = 0; i < 8; ++i) acc[i] = (f32x4){0.f, 0.f, 0.f, 0.f};
        for (int l = 4 * wid; l < 4 * wid + 4; ++l) {
            int tokl = 16 * n + l; tokl = tokl > S - 1 ? S - 1 : tokl;
            const bf16_t* rowp = BIG + (size_t)(b * S + tokl) * NQ_LD + D + j * 512 + g * HD;
            const float* pp = cpos + (size_t)(j * 32 + l) * HD;
#pragma unroll
            for (int dd = 0; dd < 4; ++dd) {
                const int d = dd * 32 + 8 * fq;
                const u32x4 raw = *(const u32x4*)(rowp + d);
                const f32x4 pa = *(const f32x4*)(pp + d), pb = *(const f32x4*)(pp + d + 4);
                f32x4 a0 = {bflo(raw.x) + pa[0], bfhi(raw.x) + pa[1], bflo(raw.y) + pa[2], bfhi(raw.y) + pa[3]};
                f32x4 a1 = {bflo(raw.z) + pb[0], bfhi(raw.z) + pb[1], bflo(raw.w) + pb[2], bfhi(raw.w) + pb[3]};
                const bf16x8 Af = pack8(a0, a1);
                const int k0 = l * HD + dd * 32 + 8 * fq;
#pragma unroll
                for (int ns = 0; ns < 8; ++ns) {
                    const bf16x8 Bw = *(const bf16x8*)(CW1 + (size_t)(j * 128 + ns * 16 + fr) * 4096 + k0);
                    acc[ns] = __builtin_amdgcn_mfma_f32_16x16x32_bf16(Bw, Af, acc[ns], 0, 0, 0);
                }
            }
        }
#pragma unroll
        for (int ns = 0; ns < 8; ++ns) *(f32x4*)(red + (size_t)(wid * 16 + fr) * 128 + ns * 16 + 4 * fq) = acc[ns];
        __syncthreads();
        const int m = tid >> 5, c4 = (tid & 31) * 4;
        { f32x4 s = {0.f, 0.f, 0.f, 0.f};
#pragma unroll
          for (int w = 0; w < 8; ++w) s = s + *(const f32x4*)(red + (size_t)(w * 16 + m) * 128 + c4);
#pragma unroll
          for (int e = 0; e < 4; ++e) { const float x = s[e]; const float uu = 0.7978845608028654f * (x + 0.044715f * x * x * x); const float th = 1.f - 2.f / (__expf(2.f * uu) + 1.f); s[e] = 0.5f * x * (1.f + th); }
          *(f32x4*)(h1s + m * 128 + c4) = s; }
        __syncthreads();
        f32x4 o = {0.f, 0.f, 0.f, 0.f};
        const float* w2j = (const float*)(lds + 73728) + c4;
#pragma unroll 16
        for (int k = 0; k < 128; ++k) { const float hv = h1s[m * 128 + k]; const f32x4 wv = *(const f32x4*)(w2j + k * 128); o = o + wv * hv; }
        if (j == 0) {
            float ss = (o[0] * o[0] + o[1] * o[1]) + (o[2] * o[2] + o[3] * o[3]);
#pragma unroll
            for (int sh = 1; sh < 32; sh <<= 1) ss += __shfl_xor(ss, sh);
            const float rstd = 1.0f / sqrtf(ss * (1.f / HD) + EPS);
            const f32x4 gn = *(const f32x4*)(kg0 + c4);
            o = o * rstd * gn;
        }
        const int nn = 16 * ng + m;
        if (nn >= 255) o = (f32x4){0.f, 0.f, 0.f, 0.f};
        bf16_t* dst = (bf16_t*)(P.ws + (j == 0 ? WS_KC : WS_VC)) + (size_t)((b * 4 + g) * 256 + nn) * HD + c4;
        u32x2 ow; ow.x = pk2(o[0], o[1]); ow.y = pk2(o[2], o[3]); *(u32x2*)dst = ow;
        __syncthreads();
    }
}

__device__ __forceinline__ f32x4 ld4bf(const bf16_t* p) { const u32x2 w = *(const u32x2*)p; return (f32x4){bflo(w.x), bfhi(w.x), bflo(w.y), bfhi(w.y)}; }
__device__ __forceinline__ void phase_pool_prep(const bf16_t* hsrc, const unsigned* ssq, const float* gain, bf16_t* OB, char* lds, int bid, int G, int tid, int wid, int lane) {
    asm volatile("" : "+v"(tid)); asm volatile("" : "+v"(lane));
    float* rs = (float*)lds;
    for (int u = bid; u < T / 32; u += G) {
        const int b = u / (S / 32), s0 = (u % (S / 32)) * 32;
        if (tid < 47) { const int s = s0 - 15 + tid; rs[tid] = (s >= 0) ? 1.0f / sqrtf((float)ssq[b * S + s] * (1.f / (1024.f * 2048.f)) + EPS) : 0.f; }
        __syncthreads();
        const int col = (tid & 255) * 8, w = 2 << (col >> 9), r_lo = (tid >> 8) * 16;
        const f32x4 gn0 = *(const f32x4*)(gain + col), gn1 = *(const f32x4*)(gain + col + 4);
        for (int rr = r_lo; rr < r_lo + 16; ++rr) {
            const int s = s0 + rr; const int lo = (s + 1 - w) > 0 ? (s + 1 - w) : 0; const float inv = 1.0f / (float)(s + 1 - lo);
            f32x4 a0 = {0.f, 0.f, 0.f, 0.f}, a1 = {0.f, 0.f, 0.f, 0.f};
            for (int sp = lo; sp <= s; ++sp) { const u32x4 wv = *(const u32x4*)(hsrc + (size_t)(b * S + sp) * D + col); const float r_ = rs[sp - s0 + 15];
                a0 = a0 + (f32x4){bflo(wv.x), bfhi(wv.x), bflo(wv.y), bfhi(wv.y)} * r_; a1 = a1 + (f32x4){bflo(wv.z), bfhi(wv.z), bflo(wv.w), bfhi(wv.w)} * r_; }
            const u32x4 wx = *(const u32x4*)(hsrc + (size_t)(b * S + s) * D + col); const float rx = rs[rr + 15];
            const f32x4 d0 = (a0 * inv - (f32x4){bflo(wx.x), bfhi(wx.x), bflo(wx.y), bfhi(wx.y)} * rx) * gn0;
            const f32x4 d1 = (a1 * inv - (f32x4){bflo(wx.z), bfhi(wx.z), bflo(wx.w), bfhi(wx.w)} * rx) * gn1;
            u32x4 ow = {pk2(d0[0], d0[1]), pk2(d0[2], d0[3]), pk2(d1[0], d1[1]), pk2(d1[2], d1[3])};
            *(u32x4*)(OB + (size_t)(b * S + s) * D + col) = ow;
        }
        __syncthreads();
    }
}

struct ConvIn { u32x4 c[3], h[3], b; };
__device__ __forceinline__ ConvIn conv_load(const bf16_t* BIG, int it) {
    const int row = it >> 8, c8 = (it & 255) * 8, s = row & (S - 1);
    const bf16_t* base = BIG + (size_t)row * MQ_LD + c8;
    ConvIn x; const u32x4 z = {0u, 0u, 0u, 0u};
#pragma unroll
    for (int j = 0; j < 3; ++j) { const int back = 2 - j;
        if (s >= back) { x.c[j] = *(const u32x4*)(base - (size_t)back * MQ_LD + D); x.h[j] = *(const u32x4*)(base - (size_t)back * MQ_LD + 2 * D); }
        else { x.c[j] = z; x.h[j] = z; } }
    x.b = *(const u32x4*)base;
    return x;
}
__device__ __forceinline__ void conv_finish(const ConvIn& x, const float* cw, const float* cb, bf16_t* OB, int it) {
    const int row = it >> 8, c8 = (it & 255) * 8;
    float u[3][8];
#pragma unroll
    for (int j = 0; j < 3; ++j) { const u32x4 cw4 = x.c[j], hw4 = x.h[j];
        u[j][0] = bflo(cw4.x) * bflo(hw4.x); u[j][1] = bfhi(cw4.x) * bfhi(hw4.x); u[j][2] = bflo(cw4.y) * bflo(hw4.y); u[j][3] = bfhi(cw4.y) * bfhi(hw4.y);
        u[j][4] = bflo(cw4.z) * bflo(hw4.z); u[j][5] = bfhi(cw4.z) * bfhi(hw4.z); u[j][6] = bflo(cw4.w) * bflo(hw4.w); u[j][7] = bfhi(cw4.w) * bfhi(hw4.w); }
    const u32x4 bw4 = x.b;
    float bv[8] = {bflo(bw4.x), bfhi(bw4.x), bflo(bw4.y), bfhi(bw4.y), bflo(bw4.z), bfhi(bw4.z), bflo(bw4.w), bfhi(bw4.w)};
    float y[8];
#pragma unroll
    for (int e = 0; e < 8; ++e) { const int c = c8 + e; y[e] = bv[e] * (cw[c] * u[0][e] + cw[D + c] * u[1][e] + cw[2 * D + c] * u[2][e] + cb[c]); }
    u32x4 ow = {pk2(y[0], y[1]), pk2(y[2], y[3]), pk2(y[4], y[5]), pk2(y[6], y[7])};
    *(u32x4*)(OB + (size_t)row * D + c8) = ow;
}
__device__ __forceinline__ void phase_conv_elem(const Params& P, int gtid, int NT) {
    asm volatile("" : "+v"(gtid));
    const bf16_t* BIG = (const bf16_t*)(P.ws + WS_BIG); bf16_t* OB = (bf16_t*)(P.ws + WS_OB);
    const float* cw = (const float*)P.in[26]; const float* cb = (const float*)P.in[27];
    for (int it = gtid; it < T * 256; it += 2 * NT) {
        const int it2 = it + NT; const bool two = it2 < T * 256;
        const ConvIn a = conv_load(BIG, it); const ConvIn b2 = conv_load(BIG, two ? it2 : it);
        conv_finish(a, cw, cb, OB, it);
        if (two) conv_finish(b2, cw, cb, OB, it2);
    }
}
namespace at {
constexpr float SCALE = 0.08838834764831845f;
constexpr float C2 = 1.4426950408889634f * SCALE;
constexpr int OFF_V = 0, OFF_K = 16384, KVBUF = 32768  , OFF_WS = 65536, OFF_IMP = 67584, OFF_SELM = 83968, OFF_Q = 86016;
#define KSWZ(row, colB) ((row) * 256 + ((colB) ^ (((row) & 7) << 4)))
#define SBAR() __builtin_amdgcn_sched_barrier(0)
__device__ __forceinline__ int v_st(int k, int c) { const int kk = (k & ~0xC) | ((k & 4) << 1) | ((k & 8) >> 1); return ((kk >> 3) * 4 + (c >> 5)) * 512 + ((kk & 7) * 32 + (c & 31)) * 2; }
__device__ __forceinline__ int v_rd_base(int lane) { return ((lane & 3) << 3) | (((lane >> 2) & 3) << 6) | (((lane >> 4) & 1) << 5) | (((lane >> 5) & 1) << 8); }
constexpr int v_rd_off(int d0, int ks, int half) { return d0 * 512 + ks * 4096 + half * 2048; }
__device__ __forceinline__ int crow(int r, int hi) { return (r & 3) + 8 * (r >> 2) + 4 * hi; }
__device__ __forceinline__ unsigned cvtpk(float lo, float hi) { unsigned r; asm volatile("v_cvt_pk_bf16_f32 %0, %1, %2" : "=v"(r) : "v"(lo), "v"(hi)); return r; }

__device__ __forceinline__ void mask_tile(f32x16& p0, f32x16& p1, int dq, unsigned W, bool rowok) {
    const float NEG = -__builtin_inff();
#pragma unroll
    for (int r = 0; r < 16; ++r) {
        const int c = (r & 3) + 8 * (r >> 2);
        if (!rowok || (unsigned)(dq - c) >= W) p0[r] = NEG;
        if (!rowok || (unsigned)(dq - c - 32) >= W) p1[r] = NEG;
    }
}
__device__ __forceinline__ float rowmax32(const f32x16& p0, const f32x16& p1) {
    float pmax = p0[0];
#pragma unroll
    for (int r = 1; r < 16; ++r) pmax = fmaxf(pmax, p0[r]);
#pragma unroll
    for (int r = 0; r < 16; ++r) pmax = fmaxf(pmax, p1[r]);
    auto rr = __builtin_amdgcn_permlane32_swap(__float_as_uint(pmax), __float_as_uint(pmax), false, false);
    return fmaxf(__uint_as_float(rr[0]), __uint_as_float(rr[1]));
}
__device__ __forceinline__ float rowsum32(const f32x16& p0, const f32x16& p1) {
    float ps = 0.f;
#pragma unroll
    for (int r = 0; r < 16; ++r) ps += p0[r];
#pragma unroll
    for (int r = 0; r < 16; ++r) ps += p1[r];
    auto rr = __builtin_amdgcn_permlane32_swap(__float_as_uint(ps), __float_as_uint(ps), false, false);
    return __uint_as_float(rr[0]) + __uint_as_float(rr[1]);
}
__device__ __forceinline__ void pack_p(const f32x16& p0, const f32x16& p1, bf16x8& pa0, bf16x8& pa1, bf16x8& pa2, bf16x8& pa3) {
#define PK4(P, B_, OUT) do { unsigned a0 = cvtpk(P[B_+0], P[B_+1]), a1 = cvtpk(P[B_+2], P[B_+3]);                          \
        unsigned b0 = cvtpk(P[B_+4], P[B_+5]), b1 = cvtpk(P[B_+6], P[B_+7]);                                             \
        auto r0 = __builtin_amdgcn_permlane32_swap(a0, b0, false, false); auto r1 = __builtin_amdgcn_permlane32_swap(a1, b1, false, false); \
        u32x4 w = {r0[0], r1[0], r0[1], r1[1]}; OUT = *reinterpret_cast<bf16x8*>(&w); } while (0)
    PK4(p0, 0, pa0); PK4(p0, 8, pa1); PK4(p1, 0, pa2); PK4(p1, 8, pa3);
#undef PK4
}
__device__ __forceinline__ void qkt(f32x16& p0, f32x16& p1, const char* K_lds, int r32, int hi, const char* Qw) {
    p0 = f32x16{}; p1 = f32x16{};
    int ko[4];
#pragma unroll
    for (int dd = 0; dd < 4; ++dd) ko[dd] = KSWZ(r32, (dd * 16 + hi * 8) * 2);
#pragma unroll
    for (int d0 = 0; d0 < 8; ++d0) { const int off = ko[d0 & 3] + (d0 >> 2) * 128; const char* a = K_lds + off;
        bf16x8 b0 = *reinterpret_cast<const bf16x8*>(a);
        bf16x8 b1 = *reinterpret_cast<const bf16x8*>(a + 32 * 256);
        bf16x8 q = *reinterpret_cast<const bf16x8*>(Qw + off);
        p0 = __builtin_amdgcn_mfma_f32_32x32x16_bf16(b0, q, p0, 0, 0, 0);
        p1 = __builtin_amdgcn_mfma_f32_32x32x16_bf16(b1, q, p1, 0, 0, 0); }
}
__device__ __forceinline__ void q_park(char* Qw, int r32, int hi, int d0, bf16x8 v) { *(bf16x8*)(Qw + KSWZ(r32, (d0 * 16 + hi * 8) * 2)) = v; }
__device__ __forceinline__ void pv_tile(f32x16 (&o)[4], int vb0, bf16x8 pa0, bf16x8 pa1, bf16x8 pa2, bf16x8 pa3) {
#define TRRD(dst, off) asm volatile("ds_read_b64_tr_b16 %0, %1 offset:%2" : "=&v"(dst) : "v"(vb0), "i"(off) : "memory")
#define PV_RD(S_, d0) do { constexpr int b_ = v_rd_off(d0, 0, 0); \
        TRRD(S_##l0, b_); TRRD(S_##h0, b_ + 2048); TRRD(S_##l1, b_ + 4096); TRRD(S_##h1, b_ + 6144); TRRD(S_##l2, b_ + 8192); TRRD(S_##h2, b_ + 10240); TRRD(S_##l3, b_ + 12288); TRRD(S_##h3, b_ + 14336); } while (0)
#define PV_MM(S_, d0) do { \
        o[d0] = __builtin_amdgcn_mfma_f32_32x32x16_bf16(pa0, (bf16x8){S_##l0[0], S_##l0[1], S_##l0[2], S_##l0[3], S_##h0[0], S_##h0[1], S_##h0[2], S_##h0[3]}, o[d0], 0, 0, 0);   \
        o[d0] = __builtin_amdgcn_mfma_f32_32x32x16_bf16(pa1, (bf16x8){S_##l1[0], S_##l1[1], S_##l1[2], S_##l1[3], S_##h1[0], S_##h1[1], S_##h1[2], S_##h1[3]}, o[d0], 0, 0, 0);   \
        o[d0] = __builtin_amdgcn_mfma_f32_32x32x16_bf16(pa2, (bf16x8){S_##l2[0], S_##l2[1], S_##l2[2], S_##l2[3], S_##h2[0], S_##h2[1], S_##h2[2], S_##h2[3]}, o[d0], 0, 0, 0);   \
        o[d0] = __builtin_amdgcn_mfma_f32_32x32x16_bf16(pa3, (bf16x8){S_##l3[0], S_##l3[1], S_##l3[2], S_##l3[3], S_##h3[0], S_##h3[1], S_##h3[2], S_##h3[3]}, o[d0], 0, 0, 0); } while (0)
#define LWAIT() do { asm volatile("s_waitcnt lgkmcnt(0)" ::: "memory"); SBAR(); } while (0)
    s16x4 Al0, Al1, Al2, Al3, Ah0, Ah1, Ah2, Ah3, Bl0, Bl1, Bl2, Bl3, Bh0, Bh1, Bh2, Bh3;
    PV_RD(A, 0); LWAIT();
    PV_RD(B, 1); SBAR(); PV_MM(A, 0); LWAIT();
    PV_RD(A, 2); SBAR(); PV_MM(B, 1); LWAIT();
    PV_RD(B, 3); SBAR(); PV_MM(A, 2); LWAIT();
    PV_MM(B, 3);
#undef LWAIT
#undef PV_MM
#undef PV_RD
#undef TRRD
}

template <int MODE>
__device__ __forceinline__ void attn_tiles(f32x16 (&o)[4], float& m_reg, float& l_reg, const char* Qw, const bf16_t* Kb, const bf16_t* Vb, int ldk,
                                           int t_lo, int t_hi, int tpos, unsigned long long sel, int own, float rl, char* lds, int tid, int wid, int lane) {
    asm volatile("" : "+v"(tid)); asm volatile("" : "+v"(lane));
    const int r32 = lane & 31, hi = lane >> 5;
    float* al_l = (float*)(lds + OFF_WS) + wid * 64;
    const int sr = tid >> 4, sc = (tid & 15) * 8;
    const int kws = KSWZ(sr, sc * 2), vst0 = v_st(sr, sc), vst1 = v_st(32 + sr, sc);
    const int vbase = (int)(uintptr_t)(lds + OFF_V) + v_rd_base(lane);
    bf16x8 sk0, sk1, sv0, sv1;
    sk0 = sk1 = sv0 = sv1 = (bf16x8){0, 0, 0, 0, 0, 0, 0, 0};
    float carry = 0.f;
#define LOADT(tt) do { const bf16_t* kp_ = Kb + (size_t)((tt) * 64 + sr) * ldk + sc; sk0 = *(const bf16x8*)kp_; sk1 = *(const bf16x8*)(kp_ + (size_t)32 * ldk); \
        if (MODE != 3) { const bf16_t* vp_ = Vb + (size_t)((tt) * 64 + sr) * ldk + sc; sv0 = *(const bf16x8*)vp_; sv1 = *(const bf16x8*)(vp_ + (size_t)32 * ldk); } } while (0)
#define WRITET(bo) do { *(bf16x8*)(lds + (bo) + OFF_K + kws) = sk0; *(bf16x8*)(lds + (bo) + OFF_K + kws + 32 * 256) = sk1; \
        if (MODE != 3) { *(bf16x8*)(lds + (bo) + OFF_V + vst0) = sv0; *(bf16x8*)(lds + (bo) + OFF_V + vst1) = sv1; } } while (0)
    if (t_lo < t_hi) { LOADT(t_lo); __syncthreads(); WRITET(0); if (t_lo + 1 < t_hi) LOADT(t_lo + 1); __syncthreads(); }
    if (wid >= 4) __builtin_amdgcn_s_setprio(1);
    for (int t = t_lo; t < t_hi; ++t) {
        const int bo = ((t - t_lo) & 1) * KVBUF;
        if (t + 1 < t_hi) { WRITET(bo ^ KVBUF); if (t + 2 < t_hi) LOADT(t + 2); }
        const char* K_lds = lds + bo + OFF_K; const int vb0 = vbase + bo;
        bool rowok = true, needm = true; unsigned Wm = 0x7fffffffu;
        if (MODE == 0) { const int kb = t >> 2; if (kb < own) { rowok = ((sel >> kb) & 1ull) != 0ull; needm = false; } else needm = ((t - 4 * own) * 64 + 63 > 32 * wid); }
        if (MODE == 1) { rowok = ((sel >> t) & 1ull) != 0ull; needm = (t == t_hi - 1); }
        if (MODE == 2) { Wm = 512u; needm = (t == t_hi - 1) || (t == t_hi - 9); }
        bool skipw = (MODE == 0) && ((t >> 2) >= own) && ((t - 4 * own) * 64 > 32 * wid + 31);
        if (MODE == 0 || MODE == 1) skipw = skipw || !__any(rowok);
        if (!skipw) {
        f32x16 p0, p1;
        qkt(p0, p1, K_lds, r32, hi, Qw);
        if (needm) mask_tile(p0, p1, tpos - t * 64 - 4 * hi, Wm, true);
        const float NEGINF = -__builtin_inff();
        if (MODE == 3) {
            const float pmax = rowmax32(p0, p1);
            const float mn = fmaxf(m_reg, pmax); const float alpha = __builtin_amdgcn_exp2f((m_reg - mn) * C2); m_reg = mn;
            const float mnL = -mn * C2;
#pragma unroll
            for (int r = 0; r < 16; ++r) { p0[r] = __builtin_amdgcn_exp2f(fmaf(p0[r], C2, mnL)); p1[r] = __builtin_amdgcn_exp2f(fmaf(p1[r], C2, mnL)); }
            l_reg = l_reg * alpha + rowsum32(p0, p1);
        } else if (MODE == 4) {
            const float mnL = -m_reg * C2;
#pragma unroll
            for (int r = 0; r < 16; ++r) { p0[r] = __builtin_amdgcn_exp2f(fmaf(p0[r], C2, mnL)) * rl; p1[r] = __builtin_amdgcn_exp2f(fmaf(p1[r], C2, mnL)) * rl; }
            float* impA = (float*)(lds + OFF_IMP + wid * 2048);
#pragma unroll
            for (int half = 0; half < 2; ++half)
#pragma unroll
                for (int rr = 0; rr < 4; ++rr) {
                    float a = half ? ((p1[4 * rr] + p1[4 * rr + 1]) + (p1[4 * rr + 2] + p1[4 * rr + 3])) : ((p0[4 * rr] + p0[4 * rr + 1]) + (p0[4 * rr + 2] + p0[4 * rr + 3]));
                    float bl = half ? p1[4 * rr + 3] : p0[4 * rr + 3];
                    a += __shfl_xor(a, 1); a += __shfl_xor(a, 2); bl += __shfl_xor(bl, 1); bl += __shfl_xor(bl, 2);
                    const float other = __shfl_xor(bl, 32);
                    const float add = hi ? other : carry;
                    carry = other;
                    const int j = 16 * t + 8 * half + 2 * rr + hi;
                    if ((r32 & 3) == 0) impA[(r32 >> 2) * 64 + j] = a + add;
                }
            bf16x8 pa0, pa1, pa2, pa3; pack_p(p0, p1, pa0, pa1, pa2, pa3);
            pv_tile(o, vb0, pa0, pa1, pa2, pa3);
        } else {
            float pmax = rowmax32(p0, p1); pmax = rowok ? pmax : NEGINF;
            float mn, alpha;
            if (__all((pmax - m_reg) * SCALE <= 8.f)) { mn = m_reg; alpha = 1.f; }
            else { mn = fmaxf(m_reg, pmax); alpha = __builtin_amdgcn_exp2f((m_reg - mn) * C2); m_reg = mn; }
            const float mnL = rowok ? -mn * C2 : NEGINF;
#pragma unroll
            for (int r = 0; r < 16; ++r) { p0[r] = __builtin_amdgcn_exp2f(fmaf(p0[r], C2, mnL)); p1[r] = __builtin_amdgcn_exp2f(fmaf(p1[r], C2, mnL)); }
            l_reg = l_reg * alpha + rowsum32(p0, p1);
            bf16x8 pa0, pa1, pa2, pa3; pack_p(p0, p1, pa0, pa1, pa2, pa3);
            if (__any(alpha < 1.f)) {
                if (hi == 0) al_l[r32] = alpha;
                asm volatile("s_waitcnt lgkmcnt(0)" ::: "memory");
#pragma unroll
                for (int r = 0; r < 16; ++r) { const float f = al_l[crow(r, hi)];
#pragma unroll
                    for (int d_ = 0; d_ < 4; ++d_) o[d_][r] *= f; }
            }
            pv_tile(o, vb0, pa0, pa1, pa2, pa3);
        }
        }
        __syncthreads();
    }
    __builtin_amdgcn_s_setprio(0);
#undef LOADT
#undef WRITET
}

template <bool NSA, bool ACCUM>
__device__ __forceinline__ void store_o(const f32x16 (&o)[4], float f, bf16_t* OB, size_t rowbase, int tok0, int hbase, char* lds, int wid, int lane) {
    asm volatile("" : "+v"(lane));
    const int r32 = lane & 31, hi = lane >> 5;
    float* li_l = (float*)(lds + OFF_WS) + wid * 64 + 32;
    if (hi == 0) li_l[r32] = f;
    asm volatile("s_waitcnt lgkmcnt(0)" ::: "memory");
#pragma unroll
    for (int r = 0; r < 16; ++r) {
        const int rw = crow(r, hi); const float fr = li_l[rw];
        const int tok = NSA ? tok0 + (rw >> 2) : tok0 + rw, hd = NSA ? hbase + (rw & 3) : hbase;
        bf16_t* op = OB + (rowbase + tok) * D + hd * HD + r32;
#pragma unroll
        for (int d0 = 0; d0 < 4; ++d0) {
            float v = o[d0][r] * fr; float vn = __shfl_xor(v, 1);
            if ((r32 & 1) == 0) { unsigned* wp = (unsigned*)(op + d0 * 32);
                if (ACCUM) { const unsigned old = *wp; v += bflo(old); vn += bfhi(old); }
                *wp = cvtpk(v, vn); }
        }
    }
}
}

__device__ __forceinline__ void moba_unit(const Params& P, int b, int h, int own, char* lds, int tid, int wid, int lane) {
    using namespace at;
    const bf16_t* BIG = (const bf16_t*)(P.ws + WS_BIG); const float* KMEAN = (const float*)(P.ws + WS_KMEAN); bf16_t* OB = (bf16_t*)(P.ws + WS_OB);
    const int r32 = lane & 31, hi = lane >> 5;
    const int tokl = own * 256 + wid * 32 + r32; const size_t row = (size_t)b * S + tokl;
    char* Qw = lds + OFF_Q + wid * 8192;
#pragma unroll
    for (int d0 = 0; d0 < 8; ++d0) q_park(Qw, r32, hi, d0, *(const bf16x8*)(BIG + row * MQ_LD + h * HD + d0 * 16 + hi * 8));
    char* K_lds = lds + OFF_K;
    { const int sr = tid >> 4, sc = (tid & 15) * 8; const int kws = KSWZ(sr, sc * 2);
      bf16x8 z0 = (bf16x8){0, 0, 0, 0, 0, 0, 0, 0}; const bf16x8 z1 = z0;
      if (sr < 16) { const float* km = KMEAN + (size_t)((b * NH + h) * 16 + sr) * HD + sc; z0 = pack8(*(const f32x4*)km, *(const f32x4*)(km + 4)); }
      __syncthreads();
      *(bf16x8*)(K_lds + kws) = z0; *(bf16x8*)(K_lds + kws + 32 * 256) = z1;
      __syncthreads(); }
    unsigned sel = 0u;
    { f32x16 p0, p1; qkt(p0, p1, K_lds, r32, hi, Qw);
      float g[16];
#pragma unroll
      for (int r = 0; r < 8; ++r) { const float mine = p0[r], other = __shfl_xor(mine, 32); const int nb = (r & 3) + 8 * (r >> 2);
          g[nb] = hi == 0 ? mine : other; g[nb + 4] = hi == 0 ? other : mine; }
      if (own <= 3) sel = (1u << own) - 1u;
      else {
#pragma unroll
          for (int pass = 0; pass < 3; ++pass) { float best = 0.f; int bi = -1;
#pragma unroll
              for (int n = 0; n < 16; ++n) { const bool cand = (n < own) && (((sel >> n) & 1u) == 0u); if (cand && (bi < 0 || g[n] > best)) { best = g[n]; bi = n; } }
              sel |= 1u << bi; }
      } }
    f32x16 o[4]; o[0] = f32x16{}; o[1] = f32x16{}; o[2] = f32x16{}; o[3] = f32x16{};
    float m_reg = -1e30f, l_reg = 0.f;
    const bf16_t* Kb = BIG + (size_t)b * S * MQ_LD + D + h * HD; const bf16_t* Vb = Kb + D;
    attn_tiles<0>(o, m_reg, l_reg, Qw, Kb, Vb, MQ_LD, 0, 4 * own + 4, tokl, (unsigned long long)sel, own, 0.f, lds, tid, wid, lane);
    store_o<false, false>(o, 1.f / l_reg, OB, (size_t)b * S, own * 256 + wid * 32, h, lds, wid, lane);
}
__device__ __forceinline__ void phase_moba_attn(const Params& P, char* lds, int bid, int G, int tid, int wid, int lane) {
    asm volatile("" : "+v"(tid)); asm volatile("" : "+v"(lane));
    for (int p0 = bid; p0 < NB * NH * 8; p0 += G) {
        int pr = p0; if (G == 256) { const int xcd = p0 & 7, slot = p0 >> 3; pr = (xcd * 4 + (slot >> 3)) * 8 + (slot & 7); }
        const int x = pr & 7, h = (pr >> 3) & 15, b = pr >> 7;
        moba_unit(P, b, h, 15 - x, lds, tid, wid, lane);
        moba_unit(P, b, h, x, lds, tid, wid, lane);
    }
}

__device__ __forceinline__ void nsa_unit(const Params& P, int b, int g, int c, char* lds, int tid, int wid, int lane) {
    using namespace at;
    const bf16_t* BIG = (const bf16_t*)(P.ws + WS_BIG); const bf16_t* QROT = (const bf16_t*)(P.ws + WS_PP); bf16_t* OB = (bf16_t*)(P.ws + WS_OB);
    const int r32 = lane & 31, hi = lane >> 5;
    const int tokl = 64 * c + 8 * wid + (r32 >> 2), head = 4 * g + (r32 & 3); const size_t row = (size_t)b * S + tokl;
    char* Qw = lds + OFF_Q + wid * 8192;
#pragma unroll
    for (int d0 = 0; d0 < 8; ++d0) q_park(Qw, r32, hi, d0, *(const bf16x8*)(BIG + row * NQ_LD + head * HD + d0 * 16 + hi * 8));
    f32x16 o[4]; o[0] = f32x16{}; o[1] = f32x16{}; o[2] = f32x16{}; o[3] = f32x16{};
    float m_reg = -1e30f, l_reg = 0.f;
    const bf16_t* Kc = (const bf16_t*)(P.ws + WS_KC) + (size_t)(b * 4 + g) * 256 * HD; const bf16_t* Vc = (const bf16_t*)(P.ws + WS_VC) + (size_t)(b * 4 + g) * 256 * HD;
    const int tq = (tokl - 31) >> 4;
    const int ncmp = ((4 * c + 2) >> 6) + 1;
    attn_tiles<3>(o, m_reg, l_reg, Qw, Kc, Vc, HD, 0, ncmp, tq, 0ull, 0, 0.f, lds, tid, wid, lane);
    const float rl = l_reg > 0.f ? 1.f / l_reg : 0.f;
    attn_tiles<4>(o, m_reg, l_reg, Qw, Kc, Vc, HD, 0, ncmp, tq, 0ull, 0, rl, lds, tid, wid, lane);
    store_o<true, false>(o, sigmoidf_(bf1(BIG[row * NQ_LD + 5120 + head * 3 + 0])), OB, (size_t)b * S, 64 * c + 8 * wid, 4 * g, lds, wid, lane);
    unsigned long long sel;
    { float* impA = (float*)(lds + OFF_IMP + wid * 2048);
      unsigned long long* selm = (unsigned long long*)(lds + OFF_SELM + wid * 64);
      asm volatile("s_waitcnt lgkmcnt(0)" ::: "memory");
      const float INF = __builtin_inff();
      for (int tk = 0; tk < 8; ++tk) {
          float val = impA[tk * 64 + lane];
          if (lane == 0 || lane == c) val = INF; else if (lane > c) val = -INF;
          const unsigned u_ = __float_as_uint(val); const unsigned key = (u_ & 0x80000000u) ? ~u_ : (u_ | 0x80000000u);
          unsigned thr = 0u;
#pragma unroll
          for (int bit = 31; bit >= 0; --bit) { const unsigned cand = thr | (1u << bit); if (__popcll(__ballot(key >= cand)) >= 16) thr = cand; }
          const unsigned long long gt_ = __ballot(key > thr), eq_ = __ballot(key == thr);
          const int need = 16 - __popcll(gt_), eqrank = __popcll(eq_ & ((1ull << lane) - 1ull));
          const bool s = ((key > thr) || (key == thr && eqrank < need)) && (val > -INF);
          const unsigned long long mk = __ballot(s);
          if (lane == 0) selm[tk] = mk;
      }
      asm volatile("s_waitcnt lgkmcnt(0)" ::: "memory");
      sel = selm[r32 >> 2]; }
    {
      const int pos_ = ((const int*)P.in[2])[row];
      const u32x4 w1 = *(const u32x4*)(Qw + KSWZ(r32, (0 * 16 + hi * 8) * 2)), w2 = *(const u32x4*)(Qw + KSWZ(r32, (1 * 16 + hi * 8) * 2));
      float x1[8] = {bflo(w1.x), bfhi(w1.x), bflo(w1.y), bfhi(w1.y), bflo(w1.z), bfhi(w1.z), bflo(w1.w), bfhi(w1.w)};
      float x2[8] = {bflo(w2.x), bfhi(w2.x), bflo(w2.y), bfhi(w2.y), bflo(w2.z), bfhi(w2.z), bflo(w2.w), bfhi(w2.w)};
#pragma unroll
      for (int j = 0; j < 8; ++j) { const int i_ = hi * 8 + j;
          const float freq = __builtin_amdgcn_exp2f(-(float)i_ * (18.931568569324174f / 16.0f));
          const float ang = (float)pos_ * freq; const double rev = (double)ang * 0.15915494309189535; const float fr_ = (float)(rev - floor(rev));
          const float c_ = __builtin_amdgcn_cosf(fr_), s_ = __builtin_amdgcn_sinf(fr_);
          const float a1 = x1[j], a2 = x2[j]; x1[j] = a1 * c_ - a2 * s_; x2[j] = a2 * c_ + a1 * s_; }
      q_park(Qw, r32, hi, 0, pack8((f32x4){x1[0], x1[1], x1[2], x1[3]}, (f32x4){x1[4], x1[5], x1[6], x1[7]}));
      q_park(Qw, r32, hi, 1, pack8((f32x4){x2[0], x2[1], x2[2], x2[3]}, (f32x4){x2[4], x2[5], x2[6], x2[7]})); }
    o[0] = f32x16{}; o[1] = f32x16{}; o[2] = f32x16{}; o[3] = f32x16{}; m_reg = -1e30f; l_reg = 0.f;
    const bf16_t* kvb = BIG + (size_t)b * S * NQ_LD + D + g * HD;
    attn_tiles<1>(o, m_reg, l_reg, Qw, kvb + 2 * 512, kvb + 3 * 512, NQ_LD, 0, c + 1, tokl, sel, 0, 0.f, lds, tid, wid, lane);
    store_o<true, true>(o, sigmoidf_(bf1(BIG[row * NQ_LD + 5120 + head * 3 + 1])) / l_reg, OB, (size_t)b * S, 64 * c + 8 * wid, 4 * g, lds, wid, lane);
    o[0] = f32x16{}; o[1] = f32x16{}; o[2] = f32x16{}; o[3] = f32x16{}; m_reg = -1e30f; l_reg = 0.f;
    attn_tiles<2>(o, m_reg, l_reg, Qw, kvb + 4 * 512, kvb + 5 * 512, NQ_LD, (c > 8 ? c - 8 : 0), c + 1, tokl, 0ull, 0, 0.f, lds, tid, wid, lane);
    store_o<true, true>(o, sigmoidf_(bf1(BIG[row * NQ_LD + 5120 + head * 3 + 2])) / l_reg, OB, (size_t)b * S, 64 * c + 8 * wid, 4 * g, lds, wid, lane);
}
__device__ __forceinline__ void phase_nsa_attn(const Params& P, char* lds, int bid, int G, int tid, int wid, int lane) {
    asm volatile("" : "+v"(tid)); asm volatile("" : "+v"(lane));
    for (int p0 = bid; p0 < NB * 4 * 32; p0 += G) {
        int pr = p0; if (G == 256) { const int xcd = p0 & 7, slot = p0 >> 3; pr = xcd * 32 + slot; }
        const int x = pr & 31, g = (pr >> 5) & 3, b = pr >> 7;
        nsa_unit(P, b, g, 63 - x, lds, tid, wid, lane);
        nsa_unit(P, b, g, x, lds, tid, wid, lane);
    }
}
typedef unsigned v4u __attribute__((ext_vector_type(4)));
#define XB_TMO      128
#define XB_XCNT(j)  (256  + 64 * (j))
#define XB_XSUB(j)  (1280 + 64 * (j))
#define XB_XGEN(j)  (2304 + 64 * (j))
#define XB_TOP      3328
#define XB_TOPGEN   3392
#define XCD_BAR_WORDS 3456
#define XB_SPIN_CAP (1u << 18)

__device__ __forceinline__ unsigned xb_ld(unsigned* p)              { return __hip_atomic_load(p, __ATOMIC_RELAXED, __HIP_MEMORY_SCOPE_AGENT); }
__device__ __forceinline__ unsigned xb_add(unsigned* p, unsigned v) { return __hip_atomic_fetch_add(p, v, __ATOMIC_RELAXED, __HIP_MEMORY_SCOPE_AGENT); }
__device__ __forceinline__ unsigned xb_xcc_id() { return (unsigned)__builtin_amdgcn_s_getreg((3 << 11) | 20) & 0xFu; }
#define XB_SPIN(cond, bar) do { unsigned _sp = 0; while (cond) { __builtin_amdgcn_s_sleep(1); \
    if ((++_sp & 255u) == 0u) { if (xb_ld(&(bar)[XB_TMO])) break; if (_sp > XB_SPIN_CAP) { atomicAdd(&(bar)[XB_TMO], 1u); break; } } } } while (0)

struct XcdBarrier {
    unsigned* bar; unsigned x;
    volatile LAS unsigned* st;
};

__device__ __forceinline__ XcdBarrier xcd_barrier_post(unsigned* bar, volatile LAS unsigned* st) {
    XcdBarrier b; b.bar = bar; b.x = xb_xcc_id(); b.st = st;
    if (threadIdx.x == 0) (void)xb_add(&bar[XB_XCNT(b.x)], 1u);
    return b;
}
__device__ __forceinline__ void xcd_barrier_complete(unsigned* bar, unsigned x, unsigned& nloc, unsigned& nx) {
    const unsigned G = gridDim.x * gridDim.y * gridDim.z;
    unsigned sum, cnt, mine, sp = 0u;
    for (;;) {
        sum = 0u; cnt = 0u; mine = 0u;
#pragma unroll
        for (unsigned j = 0; j < 16; ++j) { const unsigned c = xb_ld(&bar[XB_XCNT(j)]); sum += c; cnt += (c > 0u) ? 1u : 0u; mine = (j == x) ? c : mine; }
        if (sum == G) break;
        __builtin_amdgcn_s_sleep(1);
        if ((++sp & 255u) == 0u) { if (xb_ld(&bar[XB_TMO])) break; if (sp > XB_SPIN_CAP) { atomicAdd(&bar[XB_TMO], 1u); break; } }
    }
    nloc = mine > 0u ? mine : 1u; nx = cnt > 0u ? cnt : 1u;
}

__device__ __forceinline__ void xcd_barrier(const XcdBarrier& b) {
    asm volatile("s_waitcnt vmcnt(0)" ::: "memory");
    __syncthreads();
    if (threadIdx.x == 0) {
        unsigned* bar = b.bar;
        __builtin_amdgcn_s_waitcnt(0);
        unsigned nloc = b.st[0], nx = b.st[1];
        if (nloc == 0u) { xcd_barrier_complete(bar, b.x, nloc, nx); b.st[0] = nloc; b.st[1] = nx; }
        const unsigned old = xb_add(&bar[XB_XSUB(b.x)], 1u);
        const unsigned gen = old / nloc;
        if (old + 1u == (gen + 1u) * nloc) {
            __builtin_amdgcn_fence(__ATOMIC_RELEASE, "agent");
            asm volatile("s_waitcnt vmcnt(0)" ::: "memory");
            const unsigned og = xb_add(&bar[XB_TOP], 1u);
            const unsigned tg = og / nx;
            if (og + 1u == (tg + 1u) * nx) xb_add(&bar[XB_TOPGEN], 1u);
            else XB_SPIN(xb_ld(&bar[XB_TOPGEN]) == tg, bar);
            __builtin_amdgcn_fence(__ATOMIC_ACQUIRE, "agent");
            xb_add(&bar[XB_XGEN(b.x)], 1u);
            asm volatile("s_waitcnt vmcnt(0)" ::: "memory");
        } else {
            XB_SPIN(xb_ld(&bar[XB_XGEN(b.x)]) == gen, bar);
            __builtin_amdgcn_fence(__ATOMIC_ACQUIRE, "agent");
            asm volatile("s_waitcnt vmcnt(0)" ::: "memory");
        }
    }
    __syncthreads();
}

__global__ void __launch_bounds__(NTHREADS, 2) trunk_fwd(Params P) {
    extern __shared__ __attribute__((aligned(16))) unsigned char lds_raw[];
    char* lds = (char*)lds_raw;
    cg::grid_group grid = cg::this_grid();
    const int tid = threadIdx.x, lane = tid & 63, wid = __builtin_amdgcn_readfirstlane(tid >> 6);
    const int bid = blockIdx.x, G = gridDim.x;
    const int gw = bid * NWAVES + wid, NGW = G * NWAVES, gtid = bid * NTHREADS + tid, NT = G * NTHREADS;
    unsigned char* ws = P.ws;
    const float* x = (const float*)P.in[0];
    float* out = P.out;
    bf16_t* XN = (bf16_t*)(ws + WS_XN); bf16_t* OB = (bf16_t*)(ws + WS_OB); bf16_t* PPB = (bf16_t*)(ws + WS_PP); bf16_t* BIG = (bf16_t*)(ws + WS_BIG);

    volatile LAS unsigned* bst = (volatile LAS unsigned*)((LAS unsigned char*)lds_raw + LDS_BYTES - 16);
    if (tid == 0) { bst[0] = 0u; bst[1] = 0u; }
    __syncthreads();
    const XcdBarrier bar = xcd_barrier_post((unsigned*)(ws + WS_CTL), bst);
#define GSYNC() do { XcdBarrier b2_ = bar; asm volatile("" : "+s"(b2_.x)); xcd_barrier(b2_); } while (0)
    phase_convert(P, lds, gw, NGW, gtid, NT, wid, lane);
    __syncthreads();
    if (P.out == nullptr) grid.sync();
    GSYNC();

    bf16_t* hbc = XN;
    bf16_t* hbo = (bf16_t*)(ws + WS_HB1);
    unsigned* SS = (unsigned*)(ws + WS_SS);
    for (int i = 0; i < 4; ++i) {
        if (i == 1) {
            phase_pool_prep(hbc, SS + (size_t)(3 * i) * T, (const float*)P.in[3] + (size_t)i * D, OB, lds, bid, G, tid, wid, lane);
            GSYNC();
            for (int gq = 0; gq < 4; ++gq) {
                pg8::EpiH<0> E{nullptr, hbc, nullptr, (const float*)P.in[15], gq * 512, nullptr, nullptr, hbc, SS + (size_t)(3 * i + 1) * T};
                gemm_run(lds, OB + gq * 512, D, (const bf16_t*)(ws + WS_POOL) + (size_t)gq * 512 * 512, 512, T, 512, 512, G, (bid + gq * (G / 4)) % G, E);
            }
            GSYNC();
        } else {
            { const bf16_t* Wt = (const bf16_t*)(ws + (i == 0 ? WS_MQKV : (i == 2 ? WS_NQKV : WS_CIN))); const int N = (i == 2) ? NQ_LD : MQ_LD;
              pg8::EpiB<0> E{BIG, N, SS + (size_t)(3 * i) * T};
              gemm_run(lds, hbc, D, Wt, D, T, N, D, G, bid, E); }
            GSYNC();
            if (i == 0) {
                phase_moba_prep(P, lds, bid, G, tid, wid, lane);
                GSYNC();
                phase_moba_attn(P, lds, bid, G, tid, wid, lane);
            } else if (i == 2) {
                phase_nsa_norm(P, gw, NGW, lane);
                phase_nsa_compress(P, lds, bid, G, tid, wid, lane);
                GSYNC();
                phase_nsa_attn(P, lds, bid, G, tid, wid, lane);
            } else {
                phase_conv_elem(P, gtid, NT);
            }
            __syncthreads();
            GSYNC();
            { const bf16_t* Wt = (const bf16_t*)(ws + (i == 0 ? WS_MWO : (i == 2 ? WS_NWO : WS_CWO)));
              pg8::EpiH<0> E{(i == 0) ? x : nullptr, hbc, nullptr, nullptr, 0, nullptr, nullptr, hbc, SS + (size_t)(3 * i + 1) * T};
              gemm_run(lds, OB, D, Wt, D, T, D, D, G, bid, E); }
            GSYNC();
        }
        { pg8::EpiB<2> E{BIG, FF, nullptr};
          gemm_run(lds, hbc, D, (const bf16_t*)(ws + WS_W1T + (size_t)i * 32 * MiB), D, T, FF, D, G, bid, E); }
        { pg8::EpiB<0> E{PPB, D, nullptr};
          gemm_run(lds, (const bf16_t*)(ws + WS_PB) + (size_t)i * T * 256, 256, (const bf16_t*)(ws + WS_PPT + (size_t)i * 1 * MiB), 256, T, D, 256, G, bid, E); }
        GSYNC();
        { pg8::EpiH<0> E{nullptr, hbc, nullptr, nullptr, 0, nullptr, SS + (size_t)(3 * i + 1) * T, hbc, SS + (size_t)(3 * i + 2) * T};
          gemm_run(lds, BIG, FF, (const bf16_t*)(ws + WS_W2T + (size_t)i * 32 * MiB), FF, T, D, FF, G, bid, E); }
        GSYNC();
        { pg8::EpiH<1> E{nullptr, hbc, (i == 3) ? out : nullptr, nullptr, 0, PPB, SS + (size_t)(3 * i + 2) * T, (i < 3) ? hbo : nullptr, (i < 3) ? SS + (size_t)(3 * i + 3) * T : nullptr};
          gemm_run(lds, hbc, D, (const bf16_t*)(ws + WS_PGT + (size_t)i * 8 * MiB), D, T, D, D, G, bid, E); }
        if (i < 3) { GSYNC(); bf16_t* tsw = hbc; hbc = hbo; hbo = tsw; }
    }
}

extern "C" void kernel_launch(void* const* d_in, const int* in_sizes, int n_in, void* d_out, int out_size, void* d_ws, size_t ws_size, hipStream_t stream) {
    static int grid = 0;
    if (grid == 0) {
        if (n_in != 29 || out_size != T * D || ws_size < WS_END) { fprintf(stderr, "kernel_launch: unexpected problem (n_in %d, out %d, ws %zu)\n", n_in, out_size, ws_size); grid = -1; return; }
        int dev = 0, cus = 0, per_cu = 0;
        hipGetDevice(&dev);
        hipDeviceGetAttribute(&cus, hipDeviceAttributeMultiprocessorCount, dev);
        hipFuncSetAttribute((const void*)trunk_fwd, hipFuncAttributeMaxDynamicSharedMemorySize, LDS_BYTES);
        hipOccupancyMaxActiveBlocksPerMultiprocessor(&per_cu, (const void*)trunk_fwd, NTHREADS, LDS_BYTES);
        (void)hipGetLastError();
        if (per_cu < 1) { fprintf(stderr, "kernel_launch: occupancy query says %d blocks per CU\n", per_cu); per_cu = 1; }
        grid = cus;
        fprintf(stderr, "kernel_launch: cus %d per_cu %d grid %d\n", cus, per_cu, grid);
    }
    if (grid < 0) return;
    if (hipMemsetAsync((char*)d_ws + WS_CTL, 0, 1048576, stream) != hipSuccess) { fprintf(stderr, "kernel_launch: memset failed\n"); return; }
    Params p{};
    for (int i = 0; i < 29; ++i) p.in[i] = d_in[i];
    p.out = (float*)d_out; p.ws = (unsigned char*)d_ws;
    void* args[] = {&p};
    hipError_t e = hipLaunchCooperativeKernel((const void*)trunk_fwd, dim3(grid), dim3(NTHREADS), args, LDS_BYTES, stream);
    if (e != hipSuccess) fprintf(stderr, "cooperative launch failed: %s (grid %d)\n", hipGetErrorString(e), grid);
}
```
